# Optimizing an MI355X kernel written in HIP

```python
import math
import jax, jax.numpy as jnp
from jax import lax
import numpy as np

D_MODEL = 1024
BATCH = 8
SEQ = 2048
DEPTH = 2

HEAD_DIM = 64
SB_HEADS = 8
SB_WIDTH = SB_HEADS * HEAD_DIM
CONV_CH = 512
CONV_WIDTH = 3
ATT_HEADS = 16
KV_HEADS = 4
GQA_REP = ATT_HEADS // KV_HEADS
ATT_WIDTH = ATT_HEADS * HEAD_DIM
KV_WIDTH = KV_HEADS * HEAD_DIM
IDX_HEADS = 8
IDX_DIM = 64
TOPK_MAX = 256
REL_BUCKETS = 32
REL_MAX_DIST = 128
FFN_HIDDEN = ((-(-8 * D_MODEL // 3) + 255) // 256) * 256
QBLOCK = 128
EPS = 1e-6
N_EVEN = (DEPTH + 1) // 2
N_ODD = DEPTH // 2
EVEN_IN = 3 * SB_WIDTH + 3 * CONV_CH
ODD_IN = ATT_WIDTH + 2 * KV_WIDTH + IDX_HEADS * IDX_DIM + IDX_DIM + IDX_HEADS

kernel_name = "hybrid_stickbreak_shortconv_dsa_block"


def rms_norm(x, g):
    xf = x.astype(jnp.float32)
    y = xf * lax.rsqrt(jnp.mean(xf * xf, axis=-1, keepdims=True) + EPS)
    return (y * g.astype(jnp.float32)).astype(x.dtype)


def offsets(widths):
    out, acc = [], 0
    for w in widths[:-1]:
        acc += w
        out.append(acc)
    return out


def to_blocks(a):
    b, s = a.shape[:2]
    a = a.reshape((b, s // QBLOCK, QBLOCK) + a.shape[2:])
    return jnp.moveaxis(a, 1, 0)


def from_blocks(a):
    a = jnp.moveaxis(a, 0, 1)
    return a.reshape((a.shape[0], a.shape[1] * a.shape[2]) + a.shape[3:])


def stick_breaking_attention(q, k, v):
    s = q.shape[1]
    scale = HEAD_DIM ** -0.5
    kpos = jnp.arange(s)

    def block(args):
        qb, qpos = args
        z = jnp.einsum('bqhd,bkhd->bhqk', qb, k).astype(jnp.float32) * scale
        mask = kpos[None, :] < qpos[:, None]
        log_beta = jax.nn.log_sigmoid(z)
        log_1m_beta = jnp.where(mask, log_beta - z, 0.0)
        after = lax.cumsum(log_1m_beta, axis=3, reverse=True) - log_1m_beta
        w = jnp.where(mask, jnp.exp(log_beta + after), 0.0)
        return jnp.einsum('bhqk,bkhd->bqhd', w.astype(v.dtype), v)

    qpos = jnp.arange(s).reshape(-1, QBLOCK)
    return from_blocks(lax.map(block, (to_blocks(q), qpos)))


def short_conv_mixer(b_gate, c_gate, u, conv_w):
    g = c_gate * u
    y = lax.conv_general_dilated(
        g, conv_w[:, None, :], window_strides=(1,),
        padding=[(CONV_WIDTH - 1, 0)],
        dimension_numbers=('NWC', 'WIO', 'NWC'),
        feature_group_count=CONV_CH)
    return b_gate * y


def rel_bucket(dist):
    exact = REL_BUCKETS // 2
    d_f = jnp.maximum(dist, 1).astype(jnp.float32)
    large = exact + (jnp.log(d_f / exact) / math.log(REL_MAX_DIST / exact)
                     * (REL_BUCKETS - exact)).astype(jnp.int32)
    large = jnp.minimum(large, REL_BUCKETS - 1)
    return jnp.where(dist < exact, dist, large)


def dsa_attention(q, k, v, q_idx, k_idx, w_idx, rel_bias):
    s = q.shape[1]
    topk = min(TOPK_MAX, s // 4)
    kpos = jnp.arange(s)
    gather = jax.vmap(lambda a, i: a[i])

    def block(args):
        qb, qib, wb, qpos = args
        dots = jnp.einsum('bqhd,bkd->bqhk', qib, k_idx).astype(jnp.float32) * IDX_DIM ** -0.5
        score = jnp.einsum('bqh,bqhk->bqk', wb.astype(jnp.float32) * IDX_HEADS ** -0.5,
                           jax.nn.relu(dots))
        causal = kpos[None, :] <= qpos[:, None]
        score = jnp.where(causal[None], score, -jnp.inf)
        _, idx = lax.top_k(score, topk)
        valid = idx <= qpos[None, :, None]
        k_sel = gather(k, idx)
        v_sel = gather(v, idx)
        bucket = rel_bucket(jnp.maximum(qpos[None, :, None] - idx, 0))
        bias = rel_bias[bucket].reshape(idx.shape + (KV_HEADS, GQA_REP))
        bias = jnp.moveaxis(bias, 2, -1)
        logits = (jnp.einsum('bqgrd,bqkgd->bqgrk', qb, k_sel).astype(jnp.float32)
                  * HEAD_DIM ** -0.5 + bias.astype(jnp.float32))
        logits = jnp.where(valid[:, :, None, None, :], logits, -jnp.inf)
        p = jax.nn.softmax(logits, axis=-1)
        return jnp.einsum('bqgrk,bqkgd->bqgrd', p.astype(v.dtype), v_sel)

    qpos = jnp.arange(s).reshape(-1, QBLOCK)
    out = lax.map(block, (to_blocks(q), to_blocks(q_idx), to_blocks(w_idx), qpos))
    return from_blocks(out)


def even_mixer(h, w_in, conv_w, w_out):
    b, s, _ = h.shape
    proj = h @ w_in
    q, k, v, bg, cg, u = jnp.split(
        proj, offsets([SB_WIDTH, SB_WIDTH, SB_WIDTH, CONV_CH, CONV_CH, CONV_CH]), axis=-1)
    heads = lambda a: a.reshape(b, s, SB_HEADS, HEAD_DIM)
    a_out = stick_breaking_attention(heads(q), heads(k), heads(v)).reshape(b, s, SB_WIDTH)
    b_out = short_conv_mixer(bg, cg, u, conv_w)
    return jnp.concatenate([a_out, b_out], axis=-1) @ w_out


def odd_mixer(h, w_in, q_gain, k_gain, w_out, rel_bias):
    b, s, _ = h.shape
    proj = h @ w_in
    q, k, v, qi, ki, wi = jnp.split(
        proj, offsets([ATT_WIDTH, KV_WIDTH, KV_WIDTH, IDX_HEADS * IDX_DIM, IDX_DIM, IDX_HEADS]),
        axis=-1)
    q = rms_norm(q.reshape(b, s, ATT_HEADS, HEAD_DIM), q_gain)
    q = q.reshape(b, s, KV_HEADS, GQA_REP, HEAD_DIM)
    k = rms_norm(k.reshape(b, s, KV_HEADS, HEAD_DIM), k_gain)
    v = v.reshape(b, s, KV_HEADS, HEAD_DIM)
    qi = qi.reshape(b, s, IDX_HEADS, IDX_DIM)
    out = dsa_attention(q, k, v, qi, ki, wi, rel_bias).reshape(b, s, ATT_WIDTH)
    return out @ w_out


def swiglu(h, w_gate, w_up, w_down):
    return (jax.nn.silu(h @ w_gate) * (h @ w_up)) @ w_down


def setup_inputs(seed: int = 0) -> dict:
    key = jax.random.key(seed)
    ks = jax.random.split(key, 14)
    f32 = jnp.float32
    nrm = lambda k, shape, fan_in: jax.random.normal(k, shape, f32) * fan_in ** -0.5
    return {
        'x': jax.random.normal(ks[0], (BATCH, SEQ, D_MODEL), f32),
        'norm_mix': 1.0 + 0.01 * jax.random.normal(ks[1], (DEPTH, D_MODEL), f32),
        'norm_ffn': 1.0 + 0.01 * jax.random.normal(ks[2], (DEPTH, D_MODEL), f32),
        'ev_w_in': nrm(ks[3], (N_EVEN, D_MODEL, EVEN_IN), D_MODEL),
        'ev_conv_w': nrm(ks[4], (N_EVEN, CONV_WIDTH, CONV_CH), CONV_WIDTH),
        'ev_w_out': nrm(ks[5], (N_EVEN, SB_WIDTH + CONV_CH, D_MODEL), SB_WIDTH + CONV_CH),
        'od_w_in': nrm(ks[6], (N_ODD, D_MODEL, ODD_IN), D_MODEL),
        'od_q_gain': 1.0 + 0.01 * jax.random.normal(ks[7], (N_ODD, HEAD_DIM), f32),
        'od_k_gain': 1.0 + 0.01 * jax.random.normal(ks[8], (N_ODD, HEAD_DIM), f32),
        'od_w_out': nrm(ks[9], (N_ODD, ATT_WIDTH, D_MODEL), ATT_WIDTH),
        'rel_bias': 0.5 * jax.random.normal(ks[10], (REL_BUCKETS, ATT_HEADS), f32),
        'ffn_w_gate': nrm(ks[11], (DEPTH, D_MODEL, FFN_HIDDEN), D_MODEL),
        'ffn_w_up': nrm(ks[12], (DEPTH, D_MODEL, FFN_HIDDEN), D_MODEL),
        'ffn_w_down': nrm(ks[13], (DEPTH, FFN_HIDDEN, D_MODEL), FFN_HIDDEN),
    }


def reference(x, norm_mix, norm_ffn, ev_w_in, ev_conv_w, ev_w_out, od_w_in, od_q_gain,
              od_k_gain, od_w_out, rel_bias, ffn_w_gate, ffn_w_up, ffn_w_down):
    for layer in range(DEPTH):
        i = layer // 2
        h = rms_norm(x, norm_mix[layer])
        if layer % 2 == 0:
            x = x + even_mixer(h, ev_w_in[i], ev_conv_w[i], ev_w_out[i])
        else:
            x = x + odd_mixer(h, od_w_in[i], od_q_gain[i], od_k_gain[i], od_w_out[i], rel_bias)
        h = rms_norm(x, norm_ffn[layer])
        x = x + swiglu(h, ffn_w_gate[layer], ffn_w_up[layer], ffn_w_down[layer])
    return x
```

```cpp
#include <hip/hip_runtime.h>
#include <cstdio>
#include <cstdint>
#include <cmath>
namespace pg8 {
#define PG8_LAS __attribute__((address_space(3)))
typedef unsigned short bf16_t;
typedef short bf16x8 __attribute__((ext_vector_type(8)));
typedef float f32x4 __attribute__((ext_vector_type(4)));
typedef unsigned u32x4 __attribute__((ext_vector_type(4)));
constexpr int BM = 256, BK = 64, HALF = 128, HTB = HALF * BK * 2  , STAGE_BYTES = 8 * HTB, NXCD = 8, WGM = 8;

__host__ __device__ __forceinline__ int lds_byte(int r, int c) { const int st = (r >> 4) * 2 + (c >> 5), rr = r & 15, cc = c & 31, ob = rr * 64 + cc * 2; return st * 1024 + (ob ^ (((ob >> 9) & 1) << 5)); }
__host__ __device__ __forceinline__ void stage_rc(int b, int& R, int& C) { const int st = b / 1024, sb = b % 1024, swz = sb ^ (((sb >> 9) & 1) << 5); R = (st >> 1) * 16 + swz / 64; C = (st & 1) * 32 + (swz % 64) / 2; }
__host__ __device__ __forceinline__ int perm32(int rho) { const int n = rho >> 4, i = rho & 15; return 8 * (i >> 2) + 4 * n + (i & 3); }

struct Unit { int pm, pn; };
struct Gemm { const bf16_t* A; const bf16_t* Bt; int M, N, K; };

struct StaticOrder {
    int nM, nN, nwg, G, c;
    __host__ __device__ void init(int M, int N, int G_, int c_) { nM = M / BM; nN = N / BM; nwg = nM * nN; G = G_; c = c_; }
    __host__ __device__ bool next(int i, Unit& u) const {
        const long L = (long)i * G + c; if (L >= nwg) return false;
        int wgid = (int)L; { const int q = nwg / NXCD, r = nwg % NXCD, xcd = wgid % NXCD, off = wgid / NXCD; wgid = (xcd < r ? xcd * (q + 1) : r * (q + 1) + (xcd - r) * q) + off; }
        const int nig = WGM * nN, gid = wgid / nig, fm = gid * WGM, gsz = (nM - fm) < WGM ? (nM - fm) : WGM;
        u.pm = fm + ((wgid % nig) % gsz); u.pn = (wgid % nig) / gsz; return true;
    }
    __device__ __forceinline__ void a_ready(const Unit&) const {}
    __device__ __forceinline__ void done(const Unit&) const {}
};
__device__ __forceinline__ unsigned cvt_pk_bf16(float lo, float hi) { unsigned r; asm volatile("v_cvt_pk_bf16_f32 %0, %1, %2" : "=v"(r) : "v"(lo), "v"(hi)); return r; }
typedef float f32x2 __attribute__((ext_vector_type(2)));
constexpr float NORM_EPS = 1e-6f, LOG2E = 1.4426950408889634f;
__device__ __forceinline__ u32x4 pack8(const f32x4 a, const f32x4 b) { u32x4 w; w.x = cvt_pk_bf16(a[0], a[1]); w.y = cvt_pk_bf16(a[2], a[3]); w.z = cvt_pk_bf16(b[0], b[1]); w.w = cvt_pk_bf16(b[2], b[3]); return w; }
__device__ __forceinline__ float row_rstd(const float* ss, int row) { return __builtin_amdgcn_rsqf(ss[row] * (1.0f / 1024.0f) + NORM_EPS); }
__device__ __forceinline__ float dot4(const f32x4 a) { return (a[0] * a[0] + a[1] * a[1]) + (a[2] * a[2] + a[3] * a[3]); }

struct EpiIn0 {
    static constexpr bool PERM = true, AFTER_DRAIN = false;
    bf16_t* O; const float* ss; float c2;
    __device__ __forceinline__ void operator()(const f32x4 (&acc)[2][2][4][2], const Unit& u, int wr, int wc, int fr, int fq) const {
        const int row0 = u.pm * BM + wr * 64 + fr, col0 = u.pn * BM + wc * 32 + 8 * fq; const float cs = (u.pn < 2) ? c2 : 1.f;
#pragma unroll
        for (int ai = 0; ai < 2; ++ai)
#pragma unroll
            for (int m = 0; m < 4; ++m) { const int row = row0 + ai * HALF + m * 16; const float s = row_rstd(ss, row) * cs; bf16_t* rowp = O + (size_t)row * 3072 + col0;
#pragma unroll
                for (int bj = 0; bj < 2; ++bj) *(u32x4*)(rowp + bj * HALF) = pack8(acc[ai][bj][m][0] * s, acc[ai][bj][m][1] * s); }
    }
};
struct EpiRes {
    static constexpr bool PERM = true, AFTER_DRAIN = false;
    const float* base; float* out; bf16_t* xb; float* ssn;
    __device__ __forceinline__ void operator()(const f32x4 (&acc)[2][2][4][2], const Unit& u, int wr, int wc, int fr, int fq) const {
        const int row0 = u.pm * BM + wr * 64 + fr, col0 = u.pn * BM + wc * 32 + 8 * fq;
#pragma unroll
        for (int ai = 0; ai < 2; ++ai)
#pragma unroll
            for (int m = 0; m < 4; ++m) { const int row = row0 + ai * HALF + m * 16; const size_t off = (size_t)row * 1024 + col0; float q = 0.f;
#pragma unroll
                for (int bj = 0; bj < 2; ++bj) { const f32x4 b0 = *(const f32x4*)(base + off + bj * HALF), b1 = *(const f32x4*)(base + off + bj * HALF + 4);
                    const f32x4 o0 = b0 + acc[ai][bj][m][0], o1 = b1 + acc[ai][bj][m][1];
                    *(f32x4*)(out + off + bj * HALF) = o0; *(f32x4*)(out + off + bj * HALF + 4) = o1;
                    if (xb) *(u32x4*)(xb + off + bj * HALF) = pack8(o0, o1);
                    q += dot4(o0) + dot4(o1); }
                if (ssn) { q += __shfl_xor(q, 16); q += __shfl_xor(q, 32); if (fq == 0) unsafeAtomicAdd(ssn + row, q); } }
    }
};
struct EpiGU {
    static constexpr bool PERM = true, AFTER_DRAIN = false;
    bf16_t* H; const float* ss;
    __device__ __forceinline__ void operator()(const f32x4 (&acc)[2][2][4][2], const Unit& u, int wr, int wc, int fr, int fq) const {
        const int row0 = u.pm * BM + wr * 64 + fr, col0 = u.pn * HALF + wc * 32 + 8 * fq;
#pragma unroll
        for (int ai = 0; ai < 2; ++ai)
#pragma unroll
            for (int m = 0; m < 4; ++m) { const int row = row0 + ai * HALF + m * 16; const float s = row_rstd(ss, row); f32x4 h[2];
#pragma unroll
                for (int n = 0; n < 2; ++n) { const f32x4 g = acc[ai][0][m][n] * s, uu = acc[ai][1][m][n] * s;
#pragma unroll
                    for (int i = 0; i < 4; ++i) { const float e = __builtin_amdgcn_exp2f(g[i] * (-LOG2E)); h[n][i] = g[i] * uu[i] * __builtin_amdgcn_rcpf(1.0f + e); } }
                *(u32x4*)(H + (size_t)row * 2816 + col0) = pack8(h[0], h[1]); }
    }
};
struct EpiIn1 {
    static constexpr bool PERM = true, AFTER_DRAIN = false;
    bf16_t *Q, *Kk, *V, *QI, *KI; float* WI; const float* ss; const float* qg; const float* kg; float c2;
    __device__ __forceinline__ void operator()(const f32x4 (&acc)[2][2][4][2], const Unit& u, int wr, int wc, int fr, int fq) const {
        const int row0 = u.pm * BM + wr * 64 + fr, pn = u.pn;
        if (pn <= 4) {
            const float* gs = (pn < 4) ? qg : kg; const float gm = (pn < 4) ? c2 : 1.f; f32x4 gv[2][2];
#pragma unroll
            for (int bj = 0; bj < 2; ++bj)
#pragma unroll
                for (int n = 0; n < 2; ++n) gv[bj][n] = *(const f32x4*)(gs + 32 * bj + 8 * fq + 4 * n) * gm;
#pragma unroll
            for (int ai = 0; ai < 2; ++ai)
#pragma unroll
                for (int m = 0; m < 4; ++m) { const int row = row0 + ai * HALF + m * 16; const float s = row_rstd(ss, row); f32x4 v[2][2]; float q = 0.f;
#pragma unroll
                    for (int bj = 0; bj < 2; ++bj)
#pragma unroll
                        for (int n = 0; n < 2; ++n) { v[bj][n] = acc[ai][bj][m][n] * s; q += dot4(v[bj][n]); }
                    q += __shfl_xor(q, 16); q += __shfl_xor(q, 32);
                    const float rn = __builtin_amdgcn_rsqf(q * (1.0f / 64.0f) + NORM_EPS);
                    bf16_t* dst = (pn < 4) ? Q + (size_t)row * 1024 + pn * 256 + wc * 64 + 8 * fq : Kk + (size_t)row * 256 + wc * 64 + 8 * fq;
#pragma unroll
                    for (int bj = 0; bj < 2; ++bj) *(u32x4*)(dst + bj * 32) = pack8(v[bj][0] * rn * gv[bj][0], v[bj][1] * rn * gv[bj][1]); }
        } else {
#pragma unroll
            for (int ai = 0; ai < 2; ++ai)
#pragma unroll
                for (int m = 0; m < 4; ++m) { const int row = row0 + ai * HALF + m * 16; const float s = row_rstd(ss, row);
                    if (pn == 8) {
                        if (wc == 0) {
#pragma unroll
                            for (int bj = 0; bj < 2; ++bj) *(u32x4*)(KI + (size_t)row * 64 + bj * 32 + 8 * fq) = pack8(acc[ai][bj][m][0] * s, acc[ai][bj][m][1] * s);
                        } else if (wc == 1 && fq == 0) { *(f32x4*)(WI + (size_t)row * 8) = acc[ai][0][m][0] * s; *(f32x4*)(WI + (size_t)row * 8 + 4) = acc[ai][0][m][1] * s; }
                    } else {
                        bf16_t* dst = (pn == 5) ? V + (size_t)row * 256 + wc * 64 + 8 * fq : QI + (size_t)row * 512 + (pn - 6) * 256 + wc * 64 + 8 * fq;
#pragma unroll
                        for (int bj = 0; bj < 2; ++bj) *(u32x4*)(dst + bj * 32) = pack8(acc[ai][bj][m][0] * s, acc[ai][bj][m][1] * s);
                    } }
        }
    }
};
template <class Epi, class Sched, bool ALIGN_EPI = false, bool SP2 = false>
__device__ __forceinline__ void gemm_phase(PG8_LAS unsigned char* lds, const Gemm g, const Sched& S, const Epi& E) {
    const int tid = threadIdx.x, wid = __builtin_amdgcn_readfirstlane(tid >> 6), lane = tid & 63, wr = wid >> 2, wc = wid & 3, fr = lane & 15, fq = lane >> 4;
    const int K = g.K, nt = K / BK;
    unsigned voffA[2], voffB[2];
#pragma unroll
    for (int i = 0; i < 2; ++i) { int R, C; stage_rc(tid * 16 + i * 8192, R, C); const int Rb = Epi::PERM ? ((R & ~31) + perm32(R & 31)) : R;
        voffA[i] = (unsigned)(R * K + C) * 2u; voffB[i] = (unsigned)(Rb * K + C) * 2u; }
    const size_t kstep = (size_t)(BK * 2);
    const size_t hstep = (size_t)HALF * K * 2;
    const size_t tstep = 2 * hstep;
    const unsigned ldsw = (unsigned)wid * 1024u;
    const int aoff = lds_byte(wr * 64 + fr, fq * 8), boff = lds_byte(wc * 32 + fr, fq * 8);
#define PG8_SA(b, h) (((b) * 2 + (h)) * HTB)
#define PG8_SB(b, h) ((4 + (b) * 2 + (h)) * HTB)
#define PG8_STAGE(bufoff, gbase, voff) do { _Pragma("unroll") for (int _i = 0; _i < 2; ++_i) \
        __builtin_amdgcn_global_load_lds((const unsigned*)((const char*)(gbase) + (voff)[_i]), (PG8_LAS unsigned*)(lds + (bufoff) + ldsw + _i * 8192), 16, 0, 0); } while (0)
#define PG8_LDA(dst, b, h) do { _Pragma("unroll") for (int m = 0; m < 4; ++m) _Pragma("unroll") for (int k = 0; k < 2; ++k) dst[m][k] = *(const PG8_LAS bf16x8*)(lds + PG8_SA(b, h) + aoff + m * 2048 + k * 1024); } while (0)
#define PG8_LDB(dst, b, h) do { _Pragma("unroll") for (int n = 0; n < 2; ++n) _Pragma("unroll") for (int k = 0; k < 2; ++k) dst[n][k] = *(const PG8_LAS bf16x8*)(lds + PG8_SB(b, h) + boff + n * 2048 + k * 1024); } while (0)
#define PG8_MMA(ai, bj, At, Bt) do { __builtin_amdgcn_s_setprio(1); _Pragma("unroll") for (int m = 0; m < 4; ++m) _Pragma("unroll") for (int n = 0; n < 2; ++n) _Pragma("unroll") for (int k = 0; k < 2; ++k) \
        acc[ai][bj][m][n] = __builtin_amdgcn_mfma_f32_16x16x32_bf16(Bt[n][k], At[m][k], acc[ai][bj][m][n], 0, 0, 0); __builtin_amdgcn_s_setprio(0); } while (0)
#define PG8_WAIT_V(n) asm volatile("s_waitcnt vmcnt(" #n ")" ::: "memory")
#define PG8_WAIT_L(n) asm volatile("s_waitcnt lgkmcnt(" #n ")" ::: "memory")
#define PG8_BAR __builtin_amdgcn_s_barrier()
#define PG8_SCHED __builtin_amdgcn_sched_barrier(0)
    Unit cur, nxt; int ui = 0;
    if (!S.next(0, cur)) return;
    f32x4 acc[2][2][4][2];
#pragma unroll
    for (int a = 0; a < 2; ++a)
#pragma unroll
        for (int b = 0; b < 2; ++b)
#pragma unroll
            for (int m = 0; m < 4; ++m)
#pragma unroll
                for (int n = 0; n < 2; ++n) acc[a][b][m][n] = (f32x4){0.f, 0.f, 0.f, 0.f};
    bf16x8 At[4][2], B0[2][2], B1[2][2];
    const char* cA = (const char*)g.A + (size_t)cur.pm * tstep; const char* cB = (const char*)g.Bt + (size_t)cur.pn * tstep;
    S.a_ready(cur);
    if constexpr (SP2) {
        PG8_STAGE(PG8_SB(0, 0), cB, voffB); PG8_STAGE(PG8_SB(0, 1), cB + hstep, voffB); PG8_STAGE(PG8_SA(0, 0), cA, voffA); PG8_STAGE(PG8_SA(0, 1), cA + hstep, voffA);
        if (wr == 1) PG8_BAR;
        PG8_WAIT_V(2); PG8_BAR;
        PG8_STAGE(PG8_SB(1, 0), cB + kstep, voffB); PG8_STAGE(PG8_SA(1, 0), cA + kstep, voffA); PG8_STAGE(PG8_SB(1, 1), cB + hstep + kstep, voffB);
        PG8_WAIT_V(6); PG8_BAR;
    } else {
        PG8_STAGE(PG8_SB(0, 0), cB, voffB); PG8_STAGE(PG8_SA(0, 0), cA, voffA); PG8_STAGE(PG8_SB(0, 1), cB + hstep, voffB); PG8_STAGE(PG8_SA(0, 1), cA + hstep, voffA);
        if (wr == 1) PG8_BAR;
        PG8_WAIT_V(4); PG8_BAR;
        PG8_STAGE(PG8_SB(1, 0), cB + kstep, voffB); PG8_STAGE(PG8_SA(1, 0), cA + kstep, voffA); PG8_STAGE(PG8_SB(1, 1), cB + hstep + kstep, voffB);
        PG8_WAIT_V(6); PG8_BAR;
    }
    for (;;) {
        const bool has_next = S.next(ui + 1, nxt);
        const char* nA = has_next ? (const char*)g.A + (size_t)nxt.pm * tstep : cA; const char* nB = has_next ? (const char*)g.Bt + (size_t)nxt.pn * tstep : cB;
        for (int t = 0; t < nt; t += 2) {
            const bool last = (t == nt - 2);
            const char* a1 = cA + (size_t)(t + 1) * kstep;
            const char* a2 = last ? nA : cA + (size_t)(t + 2) * kstep; const char* b2 = last ? nB : cB + (size_t)(t + 2) * kstep;
            const char* a3 = a2 + kstep; const char* b3 = b2 + kstep;
            if (last && has_next) S.a_ready(nxt);
            if constexpr (SP2) {
            PG8_LDB(B0, 0, 0); PG8_LDB(B1, 0, 1); PG8_SCHED; PG8_LDA(At, 0, 0); PG8_STAGE(PG8_SA(1, 1), a1 + hstep, voffA);
            PG8_WAIT_V(8); PG8_WAIT_L(0); PG8_BAR; PG8_MMA(0, 0, At, B0); PG8_MMA(0, 1, At, B1); PG8_BAR; PG8_SCHED;
            PG8_LDA(At, 0, 1); PG8_STAGE(PG8_SB(0, 0), b2, voffB); PG8_STAGE(PG8_SB(0, 1), b2 + hstep, voffB); PG8_STAGE(PG8_SA(0, 0), a2, voffA);
            PG8_WAIT_V(8); PG8_WAIT_L(0); PG8_BAR; PG8_MMA(1, 0, At, B0); PG8_MMA(1, 1, At, B1); PG8_BAR; PG8_SCHED;
            PG8_LDB(B0, 1, 0); PG8_LDB(B1, 1, 1); PG8_SCHED; PG8_LDA(At, 1, 0); PG8_STAGE(PG8_SA(0, 1), a2 + hstep, voffA);
            PG8_WAIT_V(8); PG8_WAIT_L(0); PG8_BAR; PG8_MMA(0, 0, At, B0); PG8_MMA(0, 1, At, B1); PG8_BAR; PG8_SCHED;
            PG8_LDA(At, 1, 1); PG8_STAGE(PG8_SB(1, 0), b3, voffB); PG8_STAGE(PG8_SB(1, 1), b3 + hstep, voffB); PG8_STAGE(PG8_SA(1, 0), a3, voffA);
            PG8_WAIT_V(8); PG8_WAIT_L(0); PG8_BAR; PG8_MMA(1, 0, At, B0); PG8_MMA(1, 1, At, B1); PG8_BAR; PG8_SCHED;
            } else {
            PG8_LDB(B0, 0, 0); PG8_SCHED; PG8_LDA(At, 0, 0); PG8_STAGE(PG8_SA(1, 1), a1 + hstep, voffA);
            PG8_WAIT_L(8); PG8_BAR; PG8_WAIT_L(0); PG8_MMA(0, 0, At, B0); PG8_BAR; PG8_SCHED;
            PG8_LDB(B1, 0, 1); PG8_STAGE(PG8_SB(0, 0), b2, voffB);
            PG8_BAR; PG8_WAIT_L(0); PG8_MMA(0, 1, At, B1); PG8_BAR;
            PG8_LDA(At, 0, 1); PG8_STAGE(PG8_SA(0, 0), a2, voffA);
            PG8_BAR; PG8_WAIT_L(0); PG8_MMA(1, 0, At, B0); PG8_BAR; PG8_SCHED;
            PG8_STAGE(PG8_SB(0, 1), b2 + hstep, voffB);
            PG8_WAIT_V(6); PG8_BAR; PG8_MMA(1, 1, At, B1); PG8_BAR;
            PG8_LDB(B0, 1, 0); PG8_SCHED; PG8_LDA(At, 1, 0); PG8_STAGE(PG8_SA(0, 1), a2 + hstep, voffA);
            PG8_WAIT_L(8); PG8_BAR; PG8_WAIT_L(0); PG8_MMA(0, 0, At, B0); PG8_BAR; PG8_SCHED;
            PG8_LDB(B1, 1, 1); PG8_STAGE(PG8_SB(1, 0), b3, voffB);
            PG8_BAR; PG8_WAIT_L(0); PG8_MMA(0, 1, At, B1); PG8_BAR;
            PG8_LDA(At, 1, 1); PG8_STAGE(PG8_SA(1, 0), a3, voffA);
            PG8_BAR; PG8_WAIT_L(0); PG8_MMA(1, 0, At, B0); PG8_BAR; PG8_SCHED;
            PG8_STAGE(PG8_SB(1, 1), b3 + hstep, voffB);
            PG8_WAIT_V(6); PG8_BAR; PG8_MMA(1, 1, At, B1); PG8_BAR;
            }
        }
        if constexpr (ALIGN_EPI) { if (wr == 0) PG8_BAR; }
        if constexpr (!Epi::AFTER_DRAIN) { E(acc, cur, wr, wc, fr, fq); S.done(cur); }
        if (!has_next) break;
#pragma unroll
        for (int a = 0; a < 2; ++a)
#pragma unroll
            for (int b = 0; b < 2; ++b)
#pragma unroll
                for (int m = 0; m < 4; ++m)
#pragma unroll
                    for (int n = 0; n < 2; ++n) acc[a][b][m][n] = (f32x4){0.f, 0.f, 0.f, 0.f};
        cur = nxt; cA = nA; cB = nB; ++ui;
        if constexpr (ALIGN_EPI) { if (wr == 1) PG8_BAR; }
    }
    PG8_WAIT_V(0);
    if constexpr (!ALIGN_EPI) { if (wr == 0) PG8_BAR; }
    PG8_BAR;
    if constexpr (Epi::AFTER_DRAIN) { E.fused(acc, cur, wr, wc, fr, fq, lds, wid, lane); S.done(cur); }
#undef PG8_SA
#undef PG8_SB
#undef PG8_STAGE
#undef PG8_LDA
#undef PG8_LDB
#undef PG8_MMA
#undef PG8_WAIT_V
#undef PG8_WAIT_L
#undef PG8_BAR
#undef PG8_SCHED
}
}
#ifndef PG8_SP2
#define PG8_SP2 true
#endif
#ifndef PG8_ALIGN
#define PG8_ALIGN true
#endif
constexpr int NWAVES = 8;
#ifndef MK_ONE_LAUNCH
#define MK_ONE_LAUNCH 0
#endif
constexpr int NPH = 12;

constexpr int BATCH = 8, S = 2048, D = 1024, M = BATCH * S;
constexpr int EVEN_IN = 3072, ODD_IN = 2120, ODD_PAD = 2304, FF = 2816, GU = 2 * FF;
constexpr int TOPK = 256;
constexpr float C2 = 0.125f * 1.4426950408889634f;

constexpr size_t MiB = 1u << 20;
constexpr size_t WS_CTL = 0, CTL_ZERO_BYTES = 1 * MiB;
constexpr size_t WS_W_IN0 = 1 * MiB, WS_W_OUT0 = 7 * MiB, WS_W_GU0 = 9 * MiB, WS_W_DN0 = 20 * MiB, WS_W_IN1 = 26 * MiB, WS_W_OUT1 = 31 * MiB, WS_W_GU1 = 33 * MiB, WS_W_DN1 = 44 * MiB;
constexpr size_t WS_XB = 50 * MiB;
constexpr size_t WS_ATT = 82 * MiB;
constexpr size_t WS_BIG = 114 * MiB;
constexpr size_t WS_PROJ0 = WS_BIG;
constexpr size_t WS_H = WS_BIG;
constexpr size_t WS_Q1 = WS_BIG, WS_K1 = WS_BIG + 32 * MiB, WS_V1 = WS_BIG + 40 * MiB, WS_QI = WS_BIG + 48 * MiB, WS_KI = WS_BIG + 64 * MiB, WS_WI = WS_BIG + 66 * MiB, WS_MASK = WS_BIG + 68 * MiB;
constexpr size_t WS_END = 256 * MiB;
static_assert(WS_W_DN1 + (size_t)D * FF * 2 <= WS_XB && WS_PROJ0 + (size_t)M * EVEN_IN * 2 <= WS_END && WS_MASK + (size_t)M * 256 <= WS_END, "d_ws map");
constexpr int CW_BAR = 4096;
constexpr int CW_SS = 65536;

#define GAS __attribute__((address_space(1)))
#define LAS __attribute__((address_space(3)))
typedef unsigned short bf16;
typedef unsigned v4u __attribute__((ext_vector_type(4)));
typedef float f32x4 __attribute__((ext_vector_type(4)));
typedef short bf16x8 __attribute__((ext_vector_type(8)));
typedef GAS unsigned gu32;
#define RLX_AGENT __ATOMIC_RELAXED, __HIP_MEMORY_SCOPE_AGENT
#define LDS_WAIT() asm volatile("s_waitcnt lgkmcnt(0)" ::: "memory")
#define VM_WAIT() asm volatile("s_waitcnt vmcnt(0)" ::: "memory")
__device__ __forceinline__ unsigned f2bf(float f) { unsigned u = __builtin_bit_cast(unsigned, f); return (u + 0x7fffu + ((u >> 16) & 1u)) >> 16; }
__device__ __forceinline__ unsigned pk2(float lo, float hi) { return f2bf(lo) | (f2bf(hi) << 16); }
__device__ __forceinline__ float bf2f(unsigned short b) { return __builtin_bit_cast(float, (unsigned)b << 16); }
__device__ __forceinline__ float bflo(unsigned w) { return __builtin_bit_cast(float, w << 16); }
__device__ __forceinline__ float bfhi(unsigned w) { return __builtin_bit_cast(float, w & 0xffff0000u); }
#define XB_TMO      128
#define XB_XCNT(j)  (256  + 64 * (j))
#define XB_XSUB(j)  (1280 + 64 * (j))
#define XB_XGEN(j)  (2304 + 64 * (j))
#define XB_TOP      3328
#define XB_TOPGEN   3392
#define XCD_BAR_WORDS 3456
#define XB_SPIN_CAP (1u << 18)

__device__ __forceinline__ unsigned xb_ld(unsigned* p)              { return __hip_atomic_load(p, __ATOMIC_RELAXED, __HIP_MEMORY_SCOPE_AGENT); }
__device__ __forceinline__ unsigned xb_add(unsigned* p, unsigned v) { return __hip_atomic_fetch_add(p, v, __ATOMIC_RELAXED, __HIP_MEMORY_SCOPE_AGENT); }
__device__ __forceinline__ unsigned xb_xcc_id() { return (unsigned)__builtin_amdgcn_s_getreg((3 << 11) | 20) & 0xFu; }
#define XB_SPIN(cond, bar) do { unsigned _sp = 0; while (cond) { __builtin_amdgcn_s_sleep(1); \
    if ((++_sp & 255u) == 0u) { if (xb_ld(&(bar)[XB_TMO])) break; if (_sp > XB_SPIN_CAP) { atomicAdd(&(bar)[XB_TMO], 1u); break; } } } } while (0)

struct XcdBarrier {
    unsigned* bar; unsigned x;
    volatile LAS unsigned* st;
};

__device__ __forceinline__ XcdBarrier xcd_barrier_post(unsigned* bar, volatile LAS unsigned* st) {
    XcdBarrier b; b.bar = bar; b.x = xb_xcc_id(); b.st = st;
    if (threadIdx.x == 0) (void)xb_add(&bar[XB_XCNT(b.x)], 1u);
    return b;
}
__device__ __forceinline__ void xcd_barrier_complete(unsigned* bar, unsigned x, unsigned& nloc, unsigned& nx) {
    const unsigned G = gridDim.x * gridDim.y * gridDim.z;
    unsigned sum, cnt, mine, sp = 0u;
    for (;;) {
        sum = 0u; cnt = 0u; mine = 0u;
#pragma unroll
        for (unsigned j = 0; j < 16; ++j) { const unsigned c = xb_ld(&bar[XB_XCNT(j)]); sum += c; cnt += (c > 0u) ? 1u : 0u; mine = (j == x) ? c : mine; }
        if (sum == G) break;
        __builtin_amdgcn_s_sleep(1);
        if ((++sp & 255u) == 0u) { if (xb_ld(&bar[XB_TMO])) break; if (sp > XB_SPIN_CAP) { atomicAdd(&bar[XB_TMO], 1u); break; } }
    }
    nloc = mine > 0u ? mine : 1u; nx = cnt > 0u ? cnt : 1u;
}

__device__ __forceinline__ void xcd_barrier(const XcdBarrier& b) {
    asm volatile("s_waitcnt vmcnt(0)" ::: "memory");
    __syncthreads();
    if (threadIdx.x == 0) {
        unsigned* bar = b.bar;
        __builtin_amdgcn_s_waitcnt(0);
        unsigned nloc = b.st[0], nx = b.st[1];
        if (nloc == 0u) { xcd_barrier_complete(bar, b.x, nloc, nx); b.st[0] = nloc; b.st[1] = nx; }
        const unsigned old = xb_add(&bar[XB_XSUB(b.x)], 1u);
        const unsigned gen = old / nloc;
        if (old + 1u == (gen + 1u) * nloc) {
            __builtin_amdgcn_fence(__ATOMIC_RELEASE, "agent");
            asm volatile("s_waitcnt vmcnt(0)" ::: "memory");
            const unsigned og = xb_add(&bar[XB_TOP], 1u);
            const unsigned tg = og / nx;
            if (og + 1u == (tg + 1u) * nx) xb_add(&bar[XB_TOPGEN], 1u);
            else XB_SPIN(xb_ld(&bar[XB_TOPGEN]) == tg, bar);
            __builtin_amdgcn_fence(__ATOMIC_ACQUIRE, "agent");
            xb_add(&bar[XB_XGEN(b.x)], 1u);
            asm volatile("s_waitcnt vmcnt(0)" ::: "memory");
        } else {
            XB_SPIN(xb_ld(&bar[XB_XGEN(b.x)]) == gen, bar);
            __builtin_amdgcn_fence(__ATOMIC_ACQUIRE, "agent");
            asm volatile("s_waitcnt vmcnt(0)" ::: "memory");
        }
    }
    __syncthreads();
}
constexpr int RING_OFF = 0, RING_BYTES = 131072;
constexpr int MISC_OFF = RING_BYTES;
constexpr int LDS_BYTES = 160 * 1024;
struct Frame {
    LAS unsigned char* lds; volatile LAS unsigned* MISC; gu32* ctl;
    int tid, lane, wave, vcu, G;
    const float *x, *norm_mix, *norm_ffn, *ev_w_in, *ev_conv_w, *ev_w_out, *od_w_in, *od_q_gain, *od_k_gain, *od_w_out, *rel_bias, *w_gate, *w_up, *w_down;
    float* out; float* SS;
    bf16 *W_in0, *W_out0, *W_gu0, *W_dn0, *W_in1, *W_out1, *W_gu1, *W_dn1;
    bf16 *XB, *ATT, *PROJ0, *H, *Q1, *K1, *V1, *QI, *KI; float* WI; unsigned long long* MASK;
};
__device__ __forceinline__ float wave_sum(float v) {
#pragma unroll
    for (int o = 1; o < 64; o <<= 1) v += __shfl_xor(v, o);
    return v;
}
__device__ __forceinline__ float wave_max(float v) {
#pragma unroll
    for (int o = 1; o < 64; o <<= 1) v = fmaxf(v, __shfl_xor(v, o));
    return v;
}
__device__ __forceinline__ void tr_item(const float* W, int ldw, int sc0, int nvalid, const float* gain, int K, bf16* WT, int drow0, LAS float* scr, int kb, int lane) {
    const int k0 = 64 * kb, c = sc0 + (lane & 31); const bool ok = c < nvalid;
#pragma unroll 8
    for (int i = 0; i < 32; ++i) { const int kk = 2 * i + (lane >> 5); float v = ok ? W[(size_t)(k0 + kk) * ldw + c] : 0.f; if (gain) v *= gain[k0 + kk]; scr[kk * 33 + (lane & 31)] = v; }
    LDS_WAIT(); asm volatile("" ::: "memory");
    const int ch = lane & 7;
#pragma unroll
    for (int j = 0; j < 4; ++j) { const int n = (lane >> 3) + 8 * j; const LAS float* s = scr + (8 * ch) * 33 + n;
        v4u o; o.x = pk2(s[0 * 33], s[1 * 33]); o.y = pk2(s[2 * 33], s[3 * 33]); o.z = pk2(s[4 * 33], s[5 * 33]); o.w = pk2(s[6 * 33], s[7 * 33]);
        *(GAS v4u*)(WT + (size_t)(drow0 + n) * K + k0 + 8 * ch) = o; }
    LDS_WAIT(); asm volatile("" ::: "memory");
}
__device__ __forceinline__ void p0_prologue(Frame& F) {
    LAS float* scr = (LAS float*)(F.lds + RING_OFF + F.wave * 16384);
    const int gw = F.vcu * NWAVES + F.wave, NGW = F.G * NWAVES;
    constexpr int I_IN0 = 16 * (EVEN_IN / 32), I_OUT = 16 * 32, I_GU = 16 * (GU / 32), I_DN = (FF / 64) * 32, I_IN1 = 16 * (ODD_PAD / 32);
    constexpr int NITEMS = I_IN0 + 2 * I_OUT + 2 * I_GU + 2 * I_DN + I_IN1;
    for (int it = gw; it < NITEMS; it += NGW) {
        int r = it;
        if (r < I_IN0) { const int nb = EVEN_IN / 32, kb = r / nb, db = r % nb; tr_item(F.ev_w_in, EVEN_IN, 32 * db, EVEN_IN, F.norm_mix, D, F.W_in0, 32 * db, scr, kb, F.lane); continue; } r -= I_IN0;
        if (r < I_OUT) { const int kb = r / 32, db = r % 32; tr_item(F.ev_w_out, D, 32 * db, D, nullptr, D, F.W_out0, 32 * db, scr, kb, F.lane); continue; } r -= I_OUT;
        if (r < I_OUT) { const int kb = r / 32, db = r % 32; tr_item(F.od_w_out, D, 32 * db, D, nullptr, D, F.W_out1, 32 * db, scr, kb, F.lane); continue; } r -= I_OUT;
        if (r < 2 * I_GU) { const int L = r / I_GU; r -= L * I_GU; const int nb = GU / 32, kb = r / nb, db = r % nb, pn = db >> 3, j = db & 7;
            const float* W = ((j < 4) ? F.w_gate : F.w_up) + (size_t)L * D * FF;
            tr_item(W, FF, 128 * pn + 32 * (j & 3), FF, F.norm_ffn + L * D, D, L ? F.W_gu1 : F.W_gu0, 32 * db, scr, kb, F.lane); continue; } r -= 2 * I_GU;
        if (r < 2 * I_DN) { const int L = r / I_DN; r -= L * I_DN; const int kb = r / 32, db = r % 32; tr_item(F.w_down + (size_t)L * FF * D, D, 32 * db, D, nullptr, FF, L ? F.W_dn1 : F.W_dn0, 32 * db, scr, kb, F.lane); continue; } r -= 2 * I_DN;
        { const int nb = ODD_PAD / 32, kb = r / nb, db = r % nb, pn = db >> 3, bj = (db >> 2) & 1, wc = db & 3;
          tr_item(F.od_w_in, ODD_IN, 256 * pn + 64 * wc + 32 * bj, ODD_IN, F.norm_mix + D, D, F.W_in1, 32 * db, scr, kb, F.lane); }
    }
    for (int m = gw; m < M; m += NGW) {
        const GAS f32x4* xr = (const GAS f32x4*)(F.x + (size_t)m * D) + F.lane; GAS unsigned long long* o8 = (GAS unsigned long long*)(F.XB + (size_t)m * D) + F.lane; float s = 0.f;
#pragma unroll
        for (int j = 0; j < 4; ++j) { const f32x4 v = xr[64 * j]; s += (v.x * v.x + v.y * v.y) + (v.z * v.z + v.w * v.w); o8[64 * j] = (unsigned long long)pk2(v.x, v.y) | ((unsigned long long)pk2(v.z, v.w) << 32); }
        s = wave_sum(s); if (F.lane == 0) F.SS[m] = s;
    }
}
__device__ __forceinline__ void ld8(const bf16* p, float (&f)[8]) { const v4u w = *(const v4u*)p; f[0] = bflo(w.x); f[1] = bfhi(w.x); f[2] = bflo(w.y); f[3] = bfhi(w.y); f[4] = bflo(w.z); f[5] = bfhi(w.z); f[6] = bflo(w.w); f[7] = bfhi(w.w); }
__device__ __forceinline__ int rel_bucket(int dist) { if (dist < 16) return dist; const int l = 16 + (int)(logf((float)dist * (1.0f / 16.0f)) / logf(8.0f) * 16.0f); return l < 31 ? l : 31; }
__device__ __forceinline__ unsigned ord_key(float f) { unsigned u = __builtin_bit_cast(unsigned, f); if (u == 0x80000000u) u = 0u; return (u & 0x80000000u) ? ~u : (u | 0x80000000u); }
__device__ __forceinline__ void conv_part(Frame& F) {
    const int gt = (F.vcu * NWAVES + F.wave) * 64 + F.lane, NT = F.G * NWAVES * 64;
    for (int it = gt; it < M * 64; it += NT) { const int row = it >> 6, c8 = (it & 63) * 8, t = row & (S - 1);
        float bg[8], y[8]; ld8(F.PROJ0 + (size_t)row * EVEN_IN + 1536 + c8, bg);
#pragma unroll
        for (int i = 0; i < 8; ++i) y[i] = 0.f;
#pragma unroll
        for (int j = 0; j < 3; ++j) { if (t - 2 + j >= 0) { float cg[8], uu[8]; const bf16* p = F.PROJ0 + (size_t)(row - 2 + j) * EVEN_IN; ld8(p + 2048 + c8, cg); ld8(p + 2560 + c8, uu);
#pragma unroll
                for (int i = 0; i < 8; ++i) y[i] += F.ev_conv_w[j * 512 + c8 + i] * (cg[i] * uu[i]); } }
        v4u o; o.x = pk2(bg[0] * y[0], bg[1] * y[1]); o.y = pk2(bg[2] * y[2], bg[3] * y[3]); o.z = pk2(bg[4] * y[4], bg[5] * y[5]); o.w = pk2(bg[6] * y[6], bg[7] * y[7]);
        *(v4u*)(F.ATT + (size_t)row * D + 512 + c8) = o; }
}
__device__ __forceinline__ void sb_naive(Frame& F) {
    const int gw = F.vcu * NWAVES + F.wave, NGW = F.G * NWAVES;
    for (int idx = gw; idx < M * 8; idx += NGW) { const int h = idx & 7, row = idx >> 3, t = row & (S - 1);
        const float qd = bf2f(F.PROJ0[(size_t)row * EVEN_IN + h * 64 + F.lane]); float o = 0.f, carry = 1.f;
        for (int s = t - 1; s >= 0; --s) { const bf16* p = F.PROJ0 + (size_t)(row - t + s) * EVEN_IN + h * 64 + F.lane;
            const float z2 = wave_sum(qd * bf2f(p[512])), e = __builtin_amdgcn_exp2f(z2), a = __builtin_amdgcn_rcpf(1.0f + e), beta = 1.0f - a;
            o += beta * carry * bf2f(p[1024]); carry *= a; if (carry < 7.8886091e-31f) break; }
        F.ATT[(size_t)row * D + h * 64 + F.lane] = (bf16)f2bf(o); }
}
__device__ __forceinline__ void topk_row(const LAS float* sc, int n, unsigned long long* mrow, int lane) {
    unsigned long long myword = 0ull;
    if (n <= TOPK) {
#pragma unroll
        for (int i = 0; i < 32; ++i) { const unsigned long long w = __ballot(64 * i + lane < n); if (lane == i) myword = w; }
    } else {
        unsigned key[32];
#pragma unroll
        for (int i = 0; i < 32; ++i) { const int s = 64 * i + lane; key[i] = (s < n) ? ord_key(sc[s]) : 0u; }
        unsigned prefix = 0u; bool exact = false;
        for (int bit = 31; bit >= 0; --bit) { const unsigned cand = prefix | (1u << bit); int cnt = 0;
#pragma unroll
            for (int i = 0; i < 32; ++i) cnt += __popcll(__ballot(key[i] >= cand));
            if (cnt >= TOPK) { prefix = cand; if (cnt == TOPK) { exact = true; break; } } }
        if (exact) {
#pragma unroll
            for (int i = 0; i < 32; ++i) { const unsigned long long w = __ballot(key[i] >= prefix); if (lane == i) myword = w; }
        } else {
            int gt = 0;
#pragma unroll
            for (int i = 0; i < 32; ++i) gt += __popcll(__ballot(key[i] > prefix));
            const int need = TOPK - gt; int base = 0; const unsigned long long lt = (1ull << lane) - 1ull;
#pragma unroll
            for (int i = 0; i < 32; ++i) { const bool eq = key[i] == prefix; const unsigned long long be = __ballot(eq); const int rank = base + __popcll(be & lt); base += __popcll(be);
                const unsigned long long w = __ballot(key[i] > prefix || (eq && rank < need)); if (lane == i) myword = w; }
        }
    }
    if (lane < 32) mrow[lane] = myword;
}
__device__ __forceinline__ void idx_naive(Frame& F) {
    LAS float* qs = (LAS float*)(F.lds + RING_OFF);
    LAS float* ws = qs + 512;
    LAS float* sc = qs + 1024;
    for (int row = blockIdx.x; row < M; row += F.G) { const int t = row & (S - 1), n = t + 1;
        if (n > TOPK) {
            qs[F.tid] = bf2f(F.QI[(size_t)row * 512 + F.tid]); if (F.tid < 8) ws[F.tid] = F.WI[(size_t)row * 8 + F.tid] * (0.125f * 0.35355339059327373f);
            __syncthreads();
            for (int s = F.tid; s < n; s += NWAVES * 64) { asm volatile("" ::: "memory"); const bf16* kp = F.KI + (size_t)(row - t + s) * 64; float kf[64];
#pragma unroll
                for (int c = 0; c < 8; ++c) { float f[8]; ld8(kp + 8 * c, f);
#pragma unroll
                    for (int i = 0; i < 8; ++i) kf[8 * c + i] = f[i]; }
                float acc = 0.f;
#pragma unroll
                for (int h = 0; h < 8; ++h) { float d = 0.f;
#pragma unroll
                    for (int i = 0; i < 64; ++i) d += qs[h * 64 + i] * kf[i];
                    acc += ws[h] * fmaxf(d, 0.f); }
                sc[s] = acc; }
            __syncthreads();
        }
        if (F.wave == 0) topk_row(sc, n, F.MASK + (size_t)row * 32, F.lane);
        __syncthreads();
    }
}
__device__ __forceinline__ void dsa_naive(Frame& F) {
    LAS int* idx = (LAS int*)(F.lds + RING_OFF);
    LAS float* qf = (LAS float*)(F.lds + RING_OFF + 1024);
    LAS float* pl = (LAS float*)(F.lds + RING_OFF + 8192) + F.wave * 256;
    LAS int* cntp = (LAS int*)(F.lds + RING_OFF + 6144);
    for (int row = blockIdx.x; row < M; row += F.G) { const int t = row & (S - 1);
        for (int i = F.tid; i < 1024; i += NWAVES * 64) qf[i] = bf2f(F.Q1[(size_t)row * 1024 + i]);
        if (F.wave == 0) { int base = 0; const unsigned long long lt = (1ull << F.lane) - 1ull;
            for (int w = 0; w < 32; ++w) { const unsigned long long word = F.MASK[(size_t)row * 32 + w]; if ((word >> F.lane) & 1ull) idx[base + __popcll(word & lt)] = 64 * w + F.lane; base += __popcll(word); }
            if (F.lane == 0) cntp[0] = base; }
        __syncthreads();
        const int cnt = cntp[0];
        for (int hd = F.wave; hd < 16; hd += NWAVES) { const int g = hd >> 2; float lg[4]; float mx = -INFINITY;
#pragma unroll
            for (int j = 0; j < 4; ++j) { asm volatile("" ::: "memory"); const int ki = j * 64 + F.lane; lg[j] = -INFINITY;
                if (ki < cnt) { const int s = idx[ki]; const bf16* kp = F.K1 + (size_t)(row - t + s) * 256 + g * 64; float d = 0.f;
#pragma unroll
                    for (int c = 0; c < 8; ++c) { float f[8]; ld8(kp + 8 * c, f);
#pragma unroll
                        for (int i = 0; i < 8; ++i) d += qf[hd * 64 + 8 * c + i] * f[i]; }
                    lg[j] = d + F.rel_bias[rel_bucket(t - s) * 16 + hd] * 1.4426950408889634f; }
                mx = fmaxf(mx, lg[j]); }
            mx = wave_max(mx); float l = 0.f;
#pragma unroll
            for (int j = 0; j < 4; ++j) { const float p = __builtin_amdgcn_exp2f(lg[j] - mx); l += p; pl[j * 64 + F.lane] = p; }
            l = wave_sum(l); LDS_WAIT(); asm volatile("" ::: "memory");
            float o = 0.f;
            for (int i = 0; i < cnt; ++i) o += pl[i] * bf2f(F.V1[(size_t)(row - t + idx[i]) * 256 + g * 64 + F.lane]);
            F.ATT[(size_t)row * D + hd * 64 + F.lane] = (bf16)f2bf(o / l);
            LDS_WAIT(); asm volatile("" ::: "memory"); }
        __syncthreads();
    }
}
struct Args { const float* in[14]; float* out; unsigned char* ws; int ph_lo, ph_hi, li, pad; };
__global__ void __launch_bounds__(NWAVES * 64, 2) hybrid_fwd(Args args) {
    extern __shared__ __attribute__((aligned(16))) unsigned char lds[];
    Frame F;
    F.lds = (LAS unsigned char*)lds;
    F.MISC = (volatile LAS unsigned*)(F.lds + MISC_OFF);
    F.tid = threadIdx.x; F.lane = F.tid & 63; F.wave = __builtin_amdgcn_readfirstlane(F.tid >> 6);
    F.G = gridDim.x; { const int bx = blockIdx.x; F.vcu = (F.G % 8 == 0) ? (bx % 8) * (F.G / 8) + bx / 8 : bx; }
    unsigned char* ws = args.ws;
    F.ctl = (gu32*)(ws + WS_CTL);
    F.x = args.in[0]; F.norm_mix = args.in[1]; F.norm_ffn = args.in[2]; F.ev_w_in = args.in[3]; F.ev_conv_w = args.in[4]; F.ev_w_out = args.in[5]; F.od_w_in = args.in[6];
    F.od_q_gain = args.in[7]; F.od_k_gain = args.in[8]; F.od_w_out = args.in[9]; F.rel_bias = args.in[10]; F.w_gate = args.in[11]; F.w_up = args.in[12]; F.w_down = args.in[13];
    F.out = args.out; F.SS = (float*)(ws + WS_CTL) + CW_SS;
    F.W_in0 = (bf16*)(ws + WS_W_IN0); F.W_out0 = (bf16*)(ws + WS_W_OUT0); F.W_gu0 = (bf16*)(ws + WS_W_GU0); F.W_dn0 = (bf16*)(ws + WS_W_DN0);
    F.W_in1 = (bf16*)(ws + WS_W_IN1); F.W_out1 = (bf16*)(ws + WS_W_OUT1); F.W_gu1 = (bf16*)(ws + WS_W_GU1); F.W_dn1 = (bf16*)(ws + WS_W_DN1);
    F.XB = (bf16*)(ws + WS_XB); F.ATT = (bf16*)(ws + WS_ATT); F.PROJ0 = (bf16*)(ws + WS_PROJ0); F.H = (bf16*)(ws + WS_H);
    F.Q1 = (bf16*)(ws + WS_Q1); F.K1 = (bf16*)(ws + WS_K1); F.V1 = (bf16*)(ws + WS_V1); F.QI = (bf16*)(ws + WS_QI); F.KI = (bf16*)(ws + WS_KI); F.WI = (float*)(ws + WS_WI); F.MASK = (unsigned long long*)(ws + WS_MASK);
    if (F.tid < 64) ((LAS unsigned*)(F.lds + MISC_OFF))[F.tid] = 0u;
    __syncthreads();
    const int lo = args.ph_lo, hi = args.ph_hi;
    const bool use_bar = (hi - lo) > 1;
    XcdBarrier bar; bar.bar = (unsigned*)(F.ctl + CW_BAR) + args.li * XCD_BAR_WORDS; bar.x = 0; bar.st = nullptr;
    if (use_bar) bar = xcd_barrier_post((unsigned*)(F.ctl + CW_BAR) + args.li * XCD_BAR_WORDS, F.MISC + 8);
#define IN(k) (lo <= (k) && (k) < hi)
#define SEAM(k) do { if (IN(k) && IN((k) + 1)) xcd_barrier(bar); } while (0)
#define GEMM_PHASE(EPI, A_, B_, N_, K_, E_) do { pg8::Gemm g{A_, B_, M, N_, K_}; pg8::StaticOrder So; So.init(M, N_, F.G, (int)blockIdx.x); \
        pg8::gemm_phase<EPI, pg8::StaticOrder, PG8_ALIGN, PG8_SP2>(F.lds + RING_OFF, g, So, E_); } while (0)

    if (IN(0)) { p0_prologue(F); } SEAM(0);
    if (IN(1)) { pg8::EpiIn0 E{F.PROJ0, F.SS, C2}; GEMM_PHASE(pg8::EpiIn0, F.XB, F.W_in0, EVEN_IN, D, E); } SEAM(1);
    if (IN(2)) { conv_part(F); sb_naive(F); } SEAM(2);
    if (IN(3)) { pg8::EpiRes E{F.x, F.out, F.XB, F.SS + M}; GEMM_PHASE(pg8::EpiRes, F.ATT, F.W_out0, D, D, E); } SEAM(3);
    if (IN(4)) { pg8::EpiGU E{F.H, F.SS + M}; GEMM_PHASE(pg8::EpiGU, F.XB, F.W_gu0, GU, D, E); } SEAM(4);
    if (IN(5)) { pg8::EpiRes E{F.out, F.out, F.XB, F.SS + 2 * M}; GEMM_PHASE(pg8::EpiRes, F.H, F.W_dn0, D, FF, E); } SEAM(5);
    if (IN(6)) { pg8::EpiIn1 E{F.Q1, F.K1, F.V1, F.QI, F.KI, F.WI, F.SS + 2 * M, F.od_q_gain, F.od_k_gain, C2}; GEMM_PHASE(pg8::EpiIn1, F.XB, F.W_in1, ODD_PAD, D, E); } SEAM(6);
    if (IN(7)) { idx_naive(F); } SEAM(7);
    if (IN(8)) { dsa_naive(F); } SEAM(8);
    if (IN(9)) { pg8::EpiRes E{F.out, F.out, F.XB, F.SS + 3 * M}; GEMM_PHASE(pg8::EpiRes, F.ATT, F.W_out1, D, D, E); } SEAM(9);
    if (IN(10)) { pg8::EpiGU E{F.H, F.SS + 3 * M}; GEMM_PHASE(pg8::EpiGU, F.XB, F.W_gu1, GU, D, E); } SEAM(10);
    if (IN(11)) { pg8::EpiRes E{F.out, F.out, nullptr, nullptr}; GEMM_PHASE(pg8::EpiRes, F.H, F.W_dn1, D, FF, E); }
#undef IN
#undef SEAM
#undef GEMM_PHASE
}

extern "C" void kernel_launch(void* const* d_in, const int* in_sizes, int n_in, void* d_out, int out_size, void* d_ws, size_t ws_size, hipStream_t stream) {
    static int grid = 0;
    if (grid == 0) {
        if (n_in != 14 || in_sizes[0] != M * D || out_size != M * D || ws_size < WS_END) { fprintf(stderr, "kernel_launch: unexpected shapes (n_in %d, in0 %d, out %d, ws %zu); nothing launched\n", n_in, n_in > 0 ? in_sizes[0] : -1, out_size, ws_size); grid = -1; return; }
        int dev = 0, cus = 0, per_cu = 0;
        if (hipGetDevice(&dev) != hipSuccess || hipDeviceGetAttribute(&cus, hipDeviceAttributeMultiprocessorCount, dev) != hipSuccess) { grid = -1; return; }
        if (hipFuncSetAttribute((const void*)hybrid_fwd, hipFuncAttributeMaxDynamicSharedMemorySize, LDS_BYTES) != hipSuccess) { fprintf(stderr, "kernel_launch: hipFuncSetAttribute failed\n"); grid = -1; return; }
        if (hipOccupancyMaxActiveBlocksPerMultiprocessor(&per_cu, (const void*)hybrid_fwd, NWAVES * 64, LDS_BYTES) != hipSuccess || per_cu < 1) fprintf(stderr, "kernel_launch: note: occupancy query reports %d workgroups per CU\n", per_cu);
        (void)hipGetLastError();
        grid = cus;
    }
    if (grid < 0) return;
    if (hipMemsetAsync((char*)d_ws + WS_CTL, 0, CTL_ZERO_BYTES, stream) != hipSuccess) return;
    Args a{};
    for (int i = 0; i < 14; ++i) a.in[i] = (const float*)d_in[i];
    a.out = (float*)d_out; a.ws = (unsigned char*)d_ws;
#if MK_ONE_LAUNCH
    a.ph_lo = 0; a.ph_hi = NPH; a.li = 0;
    hipLaunchKernelGGL(hybrid_fwd, dim3(grid), dim3(NWAVES * 64), LDS_BYTES, stream, a);
#else
    for (int p = 0; p < NPH; ++p) { a.ph_lo = p; a.ph_hi = p + 1; a.li = p; hipLaunchKernelGGL(hybrid_fwd, dim3(grid), dim3(NWAVES * 64), LDS_BYTES, stream, a); }
#endif
}
```

```cpp
#include <hip/hip_runtime.h>
#include <cstdio>
#include <cstdint>
#include <cmath>
namespace pg8 {
#define PG8_LAS __attribute__((address_space(3)))
typedef unsigned short bf16_t;
typedef short bf16x8 __attribute__((ext_vector_type(8)));
typedef float f32x4 __attribute__((ext_vector_type(4)));
typedef unsigned u32x4 __attribute__((ext_vector_type(4)));
constexpr int BM = 256, BK = 64, HALF = 128, HTB = HALF * BK * 2  , STAGE_BYTES = 8 * HTB, NXCD = 8, WGM = 8;

__host__ __device__ __forceinline__ int lds_byte(int r, int c) { const int st = (r >> 4) * 2 + (c >> 5), rr = r & 15, cc = c & 31, ob = rr * 64 + cc * 2; return st * 1024 + (ob ^ (((ob >> 9) & 1) << 5)); }
__host__ __device__ __forceinline__ void stage_rc(int b, int& R, int& C) { const int st = b / 1024, sb = b % 1024, swz = sb ^ (((sb >> 9) & 1) << 5); R = (st >> 1) * 16 + swz / 64; C = (st & 1) * 32 + (swz % 64) / 2; }
__host__ __device__ __forceinline__ int perm32(int rho) { const int n = rho >> 4, i = rho & 15; return 8 * (i >> 2) + 4 * n + (i & 3); }

struct Unit { int pm, pn, half; };
struct Gemm { const bf16_t* A; const bf16_t* Bt; int M, N, K; };

struct StaticOrder {
    static constexpr bool HAS_HALF = false;
    int nM, nN, nwg, G, c;
    __host__ __device__ void init(int M, int N, int G_, int c_) { nM = M / BM; nN = N / BM; nwg = nM * nN; G = G_; c = c_; }
    __host__ __device__ __forceinline__ bool next(int i, Unit& u) const { return at((long)i * G + c, u); }
    __host__ __device__ __forceinline__ bool at(long L, Unit& u) const {
        if (L >= nwg) return false;
        int wgid = (int)L; { const int q = nwg / NXCD, r = nwg % NXCD, xcd = wgid % NXCD, off = wgid / NXCD; wgid = (xcd < r ? xcd * (q + 1) : r * (q + 1) + (xcd - r) * q) + off; }
        const int nig = WGM * nN, gid = wgid / nig, fm = gid * WGM, gsz = (nM - fm) < WGM ? (nM - fm) : WGM;
        u.pm = fm + ((wgid % nig) % gsz); u.pn = (wgid % nig) / gsz; u.half = 0; return true;
    }
    __device__ __forceinline__ void a_ready(const Unit&) const {}
    __device__ __forceinline__ void done(const Unit&) const {}
};
struct TailOrder {
    static constexpr bool HAS_HALF = true;
    StaticOrder so; int R, rem;
    __host__ __device__ __forceinline__ void init(int M, int N, int G_, int c_) { so.init(M, N, G_, c_); R = so.nwg / G_; rem = so.nwg % G_; if (2 * rem > G_) { R += 1; rem = 0; } }
    __host__ __device__ __forceinline__ bool next(int i, Unit& u) const {
        if (i < R) return so.next(i, u);
        if (i > R || so.c >= 2 * rem) return false;
        if (!so.at((long)R * so.G + (so.c >> 1), u)) return false; u.half = 1 + (so.c & 1); return true;
    }
    __device__ __forceinline__ void a_ready(const Unit&) const {}
    __device__ __forceinline__ void done(const Unit&) const {}
};
__device__ __forceinline__ unsigned cvt_pk_bf16(float lo, float hi) { unsigned r; asm volatile("v_cvt_pk_bf16_f32 %0, %1, %2" : "=v"(r) : "v"(lo), "v"(hi)); return r; }
typedef float f32x2 __attribute__((ext_vector_type(2)));
constexpr float NORM_EPS = 1e-6f, LOG2E = 1.4426950408889634f;
__device__ __forceinline__ u32x4 pack8(const f32x4 a, const f32x4 b) { u32x4 w; w.x = cvt_pk_bf16(a[0], a[1]); w.y = cvt_pk_bf16(a[2], a[3]); w.z = cvt_pk_bf16(b[0], b[1]); w.w = cvt_pk_bf16(b[2], b[3]); return w; }
__device__ __forceinline__ float row_rstd(const float* ss, int row) { return __builtin_amdgcn_rsqf(ss[row] * (1.0f / 1024.0f) + NORM_EPS); }
__device__ __forceinline__ float dot4(const f32x4 a) { return (a[0] * a[0] + a[1] * a[1]) + (a[2] * a[2] + a[3] * a[3]); }

struct EpiIn0 {
    static constexpr bool PERM = true, AFTER_DRAIN = false, PRE = true;
    bf16_t* O; const float* ss; float c2;
    __device__ __forceinline__ void pre(const Unit& u, int wr, int fr, float (&rs)[8]) const { const int row0 = u.pm * BM + wr * 64 + fr;
#pragma unroll
        for (int i = 0; i < 8; ++i) rs[i] = ss[row0 + (i >> 2) * HALF + (i & 3) * 16]; }
    __device__ __forceinline__ void operator()(const f32x4 (&acc)[2][2][4][2], const Unit& u, int wr, int wc, int fr, int fq, const float (&rs)[8]) const {
        const int row0 = u.pm * BM + wr * 64 + fr, col0 = u.pn * BM + wc * 32 + 8 * fq; const float cs = (u.pn < 2) ? c2 : 1.f;
#pragma unroll
        for (int ai = 0; ai < 2; ++ai)
#pragma unroll
            for (int m = 0; m < 4; ++m) { const int row = row0 + ai * HALF + m * 16; const float s = __builtin_amdgcn_rsqf(rs[ai * 4 + m] * (1.0f / 1024.0f) + NORM_EPS) * cs; bf16_t* rowp = O + (size_t)row * 3072 + col0;
#pragma unroll
                for (int bj = 0; bj < 2; ++bj) *(u32x4*)(rowp + bj * HALF) = pack8(acc[ai][bj][m][0] * s, acc[ai][bj][m][1] * s); }
    }
};
__device__ __forceinline__ f32x4 bf4lo(const u32x4 w) { f32x4 r; r[0] = __builtin_bit_cast(float, w.x << 16); r[1] = __builtin_bit_cast(float, w.x & 0xffff0000u); r[2] = __builtin_bit_cast(float, w.y << 16); r[3] = __builtin_bit_cast(float, w.y & 0xffff0000u); return r; }
__device__ __forceinline__ f32x4 bf4hi(const u32x4 w) { f32x4 r; r[0] = __builtin_bit_cast(float, w.z << 16); r[1] = __builtin_bit_cast(float, w.z & 0xffff0000u); r[2] = __builtin_bit_cast(float, w.w << 16); r[3] = __builtin_bit_cast(float, w.w & 0xffff0000u); return r; }
struct EpiRes {
    static constexpr bool PERM = true, AFTER_DRAIN = false, PRE = false;
    bf16_t* xb; float* out; float* ssn;
    __device__ __forceinline__ void operator()(const f32x4 (&acc)[2][2][4][2], const Unit& u, int wr, int wc, int fr, int fq) const {
        const int row0 = u.pm * BM + wr * 64 + fr, col0 = u.pn * BM + wc * 32 + 8 * fq;
#pragma unroll
        for (int ai = 0; ai < 2; ++ai)
#pragma unroll
            for (int m = 0; m < 4; ++m) { const int row = row0 + ai * HALF + m * 16; const size_t off = (size_t)row * 1024 + col0; float q = 0.f;
#pragma unroll
                for (int bj = 0; bj < 2; ++bj) { const u32x4 bw = *(const u32x4*)(xb + off + bj * HALF);
                    const f32x4 o0 = bf4lo(bw) + acc[ai][bj][m][0], o1 = bf4hi(bw) + acc[ai][bj][m][1];
                    if (out) { *(f32x4*)(out + off + bj * HALF) = o0; *(f32x4*)(out + off + bj * HALF + 4) = o1; }
                    else *(u32x4*)(xb + off + bj * HALF) = pack8(o0, o1);
                    q += dot4(o0) + dot4(o1); }
                if (ssn) { q += __shfl_xor(q, 16); q += __shfl_xor(q, 32); if (fq == 0) unsafeAtomicAdd(ssn + row, q); } }
    }
};
struct EpiGU {
    static constexpr bool PERM = true, AFTER_DRAIN = false, PRE = true;
    bf16_t* H; const float* ss;
    __device__ __forceinline__ void pre(const Unit& u, int wr, int fr, float (&rs)[8]) const { const int row0 = u.pm * BM + (u.half == 2 ? HALF : 0) + wr * 64 + fr;
#pragma unroll
        for (int i = 0; i < 8; ++i) rs[i] = ss[row0 + ((i >> 2) && !u.half ? HALF : 0) + (i & 3) * 16]; }
    __device__ __forceinline__ void operator()(const f32x4 (&acc)[2][2][4][2], const Unit& u, int wr, int wc, int fr, int fq, const float (&rs)[8]) const {
        const int row0 = u.pm * BM + (u.half == 2 ? HALF : 0) + wr * 64 + fr, col0 = u.pn * HALF + wc * 32 + 8 * fq;
#pragma unroll
        for (int ai = 0; ai < 2; ++ai)
#pragma unroll
            for (int m = 0; m < 4; ++m) { if (ai == 1 && u.half) continue; const int row = row0 + ai * HALF + m * 16; const float s = __builtin_amdgcn_rsqf(rs[ai * 4 + m] * (1.0f / 1024.0f) + NORM_EPS); f32x4 h[2];
#pragma unroll
                for (int n = 0; n < 2; ++n) { const f32x4 g = acc[ai][0][m][n] * s, uu = acc[ai][1][m][n] * s;
#pragma unroll
                    for (int i = 0; i < 4; ++i) { const float e = __builtin_amdgcn_exp2f(g[i] * (-LOG2E)); h[n][i] = g[i] * uu[i] * __builtin_amdgcn_rcpf(1.0f + e); } }
                *(u32x4*)(H + (size_t)row * 2816 + col0) = pack8(h[0], h[1]); }
    }
};
struct EpiIn1 {
    static constexpr bool PERM = true, AFTER_DRAIN = false, PRE = true;
    bf16_t *Q, *Kk, *V, *QI, *KI; float* WI; const float* ss; const PG8_LAS float* qg; const PG8_LAS float* kg; float c2;
    __device__ __forceinline__ void pre(const Unit& u, int wr, int fr, float (&rs)[8]) const { const int row0 = u.pm * BM + (u.half == 2 ? HALF : 0) + wr * 64 + fr;
#pragma unroll
        for (int i = 0; i < 8; ++i) rs[i] = ss[row0 + ((i >> 2) && !u.half ? HALF : 0) + (i & 3) * 16]; }
    __device__ __forceinline__ void operator()(const f32x4 (&acc)[2][2][4][2], const Unit& u, int wr, int wc, int fr, int fq, const float (&rs)[8]) const {
        const int row0 = u.pm * BM + (u.half == 2 ? HALF : 0) + wr * 64 + fr, pn = u.pn;
        if (pn <= 4) {
            const PG8_LAS float* gs = (pn < 4) ? qg : kg; const float gm = (pn < 4) ? c2 : 1.f; f32x4 gv[2][2];
#pragma unroll
            for (int bj = 0; bj < 2; ++bj)
#pragma unroll
                for (int n = 0; n < 2; ++n) gv[bj][n] = *(const PG8_LAS f32x4*)(gs + 32 * bj + 8 * fq + 4 * n) * gm;
#pragma unroll
            for (int ai = 0; ai < 2; ++ai)
#pragma unroll
                for (int m = 0; m < 4; ++m) { if (ai == 1 && u.half) continue; const int row = row0 + ai * HALF + m * 16; const float s = __builtin_amdgcn_rsqf(rs[ai * 4 + m] * (1.0f / 1024.0f) + NORM_EPS); f32x4 v[2][2]; float q = 0.f;
#pragma unroll
                    for (int bj = 0; bj < 2; ++bj)
#pragma unroll
                        for (int n = 0; n < 2; ++n) { v[bj][n] = acc[ai][bj][m][n] * s; q += dot4(v[bj][n]); }
                    q += __shfl_xor(q, 16); q += __shfl_xor(q, 32);
                    const float rn = __builtin_amdgcn_rsqf(q * (1.0f / 64.0f) + NORM_EPS);
                    bf16_t* dst = (pn < 4) ? Q + (size_t)row * 1024 + pn * 256 + wc * 64 + 8 * fq : Kk + (size_t)row * 256 + wc * 64 + 8 * fq;
#pragma unroll
                    for (int bj = 0; bj < 2; ++bj) *(u32x4*)(dst + bj * 32) = pack8(v[bj][0] * rn * gv[bj][0], v[bj][1] * rn * gv[bj][1]); }
        } else {
#pragma unroll
            for (int ai = 0; ai < 2; ++ai)
#pragma unroll
                for (int m = 0; m < 4; ++m) { if (ai == 1 && u.half) continue; const int row = row0 + ai * HALF + m * 16; const float s = __builtin_amdgcn_rsqf(rs[ai * 4 + m] * (1.0f / 1024.0f) + NORM_EPS);
                    if (pn == 8) {
                        if (wc == 0) {
#pragma unroll
                            for (int bj = 0; bj < 2; ++bj) *(u32x4*)(KI + (size_t)row * 64 + bj * 32 + 8 * fq) = pack8(acc[ai][bj][m][0] * s, acc[ai][bj][m][1] * s);
                        } else if (wc == 1 && fq == 0) { *(f32x4*)(WI + (size_t)row * 8) = acc[ai][0][m][0] * s; *(f32x4*)(WI + (size_t)row * 8 + 4) = acc[ai][0][m][1] * s; }
                    } else {
                        bf16_t* dst = (pn == 5) ? V + (size_t)row * 256 + wc * 64 + 8 * fq : QI + (size_t)row * 512 + (pn - 6) * 256 + wc * 64 + 8 * fq;
#pragma unroll
                        for (int bj = 0; bj < 2; ++bj) *(u32x4*)(dst + bj * 32) = pack8(acc[ai][bj][m][0] * s, acc[ai][bj][m][1] * s);
                    } }
        }
    }
};
template <class Epi, class Sched, bool ALIGN_EPI = false, bool SP2 = false>
__device__ __forceinline__ void gemm_phase(PG8_LAS unsigned char* lds, const Gemm g, const Sched& S, const Epi& E) {
    const int tid = threadIdx.x, wid = __builtin_amdgcn_readfirstlane(tid >> 6), lane = tid & 63, wr = wid >> 2, wc = wid & 3, fr = lane & 15, fq = lane >> 4;
    const int K = g.K, nt = K / BK;
    unsigned voffA[2], voffB[2];
#pragma unroll
    for (int i = 0; i < 2; ++i) { int R, C; stage_rc(tid * 16 + i * 8192, R, C); const int Rb = Epi::PERM ? ((R & ~31) + perm32(R & 31)) : R;
        voffA[i] = (unsigned)(R * K + C) * 2u; voffB[i] = (unsigned)(Rb * K + C) * 2u; }
    const size_t kstep = (size_t)(BK * 2);
    const size_t hstep = (size_t)HALF * K * 2;
    const size_t tstep = 2 * hstep;
    const unsigned ldsw = (unsigned)wid * 1024u;
    const int aoff = lds_byte(wr * 64 + fr, fq * 8), boff = lds_byte(wc * 32 + fr, fq * 8);
#define PG8_SA(b, h) (((b) * 2 + (h)) * HTB)
#define PG8_SB(b, h) ((4 + (b) * 2 + (h)) * HTB)
#define PG8_STAGE(bufoff, gbase, voff) do { _Pragma("unroll") for (int _i = 0; _i < 2; ++_i) \
        __builtin_amdgcn_global_load_lds((const unsigned*)((const char*)(gbase) + (voff)[_i]), (PG8_LAS unsigned*)(lds + (bufoff) + ldsw + _i * 8192), 16, 0, 0); } while (0)
#define PG8_LDA(dst, b, h) do { _Pragma("unroll") for (int m = 0; m < 4; ++m) _Pragma("unroll") for (int k = 0; k < 2; ++k) dst[m][k] = *(const PG8_LAS bf16x8*)(lds + PG8_SA(b, h) + aoff + m * 2048 + k * 1024); } while (0)
#define PG8_LDB(dst, b, h) do { _Pragma("unroll") for (int n = 0; n < 2; ++n) _Pragma("unroll") for (int k = 0; k < 2; ++k) dst[n][k] = *(const PG8_LAS bf16x8*)(lds + PG8_SB(b, h) + boff + n * 2048 + k * 1024); } while (0)
#define PG8_MMA(ai, bj, At, Bt) do { __builtin_amdgcn_s_setprio(1); _Pragma("unroll") for (int m = 0; m < 4; ++m) _Pragma("unroll") for (int n = 0; n < 2; ++n) _Pragma("unroll") for (int k = 0; k < 2; ++k) \
        acc[ai][bj][m][n] = __builtin_amdgcn_mfma_f32_16x16x32_bf16(Bt[n][k], At[m][k], acc[ai][bj][m][n], 0, 0, 0); __builtin_amdgcn_s_setprio(0); } while (0)
#define PG8_WAIT_V(n) asm volatile("s_waitcnt vmcnt(" #n ")" ::: "memory")
#define PG8_WAIT_L(n) asm volatile("s_waitcnt lgkmcnt(" #n ")" ::: "memory")
#define PG8_BAR __builtin_amdgcn_s_barrier()
#define PG8_SCHED __builtin_amdgcn_sched_barrier(0)
    Unit cur, nxt; int ui = 0;
    if (!S.next(0, cur)) return;
    f32x4 acc[2][2][4][2];
#pragma unroll
    for (int a = 0; a < 2; ++a)
#pragma unroll
        for (int b = 0; b < 2; ++b)
#pragma unroll
            for (int m = 0; m < 4; ++m)
#pragma unroll
                for (int n = 0; n < 2; ++n) acc[a][b][m][n] = (f32x4){0.f, 0.f, 0.f, 0.f};
    bf16x8 At[4][2], B0[2][2], B1[2][2];
    const char* cA = (const char*)g.A + (size_t)cur.pm * tstep + ((Sched::HAS_HALF && cur.half == 2) ? hstep : 0); const char* cB = (const char*)g.Bt + (size_t)cur.pn * tstep;
    unsigned cHs = (Sched::HAS_HALF && cur.half) ? 0u : (unsigned)hstep;
    S.a_ready(cur);
    float rs8[8];
    if constexpr (Epi::PRE) E.pre(cur, wr, fr, rs8);
    if constexpr (SP2) {
        PG8_STAGE(PG8_SB(0, 0), cB, voffB); PG8_STAGE(PG8_SB(0, 1), cB + hstep, voffB); PG8_STAGE(PG8_SA(0, 0), cA, voffA); PG8_STAGE(PG8_SA(0, 1), cA + cHs, voffA);
        if (wr == 1) PG8_BAR;
        PG8_WAIT_V(2); PG8_BAR;
        PG8_STAGE(PG8_SB(1, 0), cB + kstep, voffB); PG8_STAGE(PG8_SA(1, 0), cA + kstep, voffA); PG8_STAGE(PG8_SB(1, 1), cB + hstep + kstep, voffB);
        PG8_WAIT_V(6); PG8_BAR;
    } else {
        PG8_STAGE(PG8_SB(0, 0), cB, voffB); PG8_STAGE(PG8_SA(0, 0), cA, voffA); PG8_STAGE(PG8_SB(0, 1), cB + hstep, voffB); PG8_STAGE(PG8_SA(0, 1), cA + hstep, voffA);
        if (wr == 1) PG8_BAR;
        PG8_WAIT_V(4); PG8_BAR;
        PG8_STAGE(PG8_SB(1, 0), cB + kstep, voffB); PG8_STAGE(PG8_SA(1, 0), cA + kstep, voffA); PG8_STAGE(PG8_SB(1, 1), cB + hstep + kstep, voffB);
        PG8_WAIT_V(6); PG8_BAR;
    }
    for (;;) {
        const bool has_next = S.next(ui + 1, nxt);
        const char* nA = has_next ? (const char*)g.A + (size_t)nxt.pm * tstep + ((Sched::HAS_HALF && nxt.half == 2) ? hstep : 0) : cA; const char* nB = has_next ? (const char*)g.Bt + (size_t)nxt.pn * tstep : cB;
        const unsigned nHs = has_next ? ((Sched::HAS_HALF && nxt.half) ? 0u : (unsigned)hstep) : cHs;
        for (int t = 0; t < nt; t += 2) {
            const bool last = (t == nt - 2);
            const char* a1 = cA + (size_t)(t + 1) * kstep;
            const char* a2 = last ? nA : cA + (size_t)(t + 2) * kstep; const char* b2 = last ? nB : cB + (size_t)(t + 2) * kstep;
            const char* a3 = a2 + kstep; const char* b3 = b2 + kstep;
            const unsigned hs2 = last ? nHs : cHs;
            if (last && has_next) S.a_ready(nxt);
            if constexpr (SP2) {
            PG8_LDB(B0, 0, 0); PG8_LDB(B1, 0, 1); PG8_SCHED; PG8_LDA(At, 0, 0); PG8_STAGE(PG8_SA(1, 1), a1 + cHs, voffA);
            PG8_WAIT_V(8); PG8_WAIT_L(0); PG8_BAR; PG8_MMA(0, 0, At, B0); PG8_MMA(0, 1, At, B1); PG8_BAR; PG8_SCHED;
            PG8_LDA(At, 0, 1); PG8_STAGE(PG8_SB(0, 0), b2, voffB); PG8_STAGE(PG8_SB(0, 1), b2 + hstep, voffB); PG8_STAGE(PG8_SA(0, 0), a2, voffA);
            PG8_WAIT_V(8); PG8_WAIT_L(0); PG8_BAR; if (!(Sched::HAS_HALF && cur.half)) { PG8_MMA(1, 0, At, B0); PG8_MMA(1, 1, At, B1); } PG8_BAR; PG8_SCHED;
            PG8_LDB(B0, 1, 0); PG8_LDB(B1, 1, 1); PG8_SCHED; PG8_LDA(At, 1, 0); PG8_STAGE(PG8_SA(0, 1), a2 + hs2, voffA);
            PG8_WAIT_V(8); PG8_WAIT_L(0); PG8_BAR; PG8_MMA(0, 0, At, B0); PG8_MMA(0, 1, At, B1); PG8_BAR; PG8_SCHED;
            PG8_LDA(At, 1, 1); PG8_STAGE(PG8_SB(1, 0), b3, voffB); PG8_STAGE(PG8_SB(1, 1), b3 + hstep, voffB); PG8_STAGE(PG8_SA(1, 0), a3, voffA);
            PG8_WAIT_V(8); PG8_WAIT_L(0); PG8_BAR; if (!(Sched::HAS_HALF && cur.half)) { PG8_MMA(1, 0, At, B0); PG8_MMA(1, 1, At, B1); } PG8_BAR; PG8_SCHED;
            } else {
            PG8_LDB(B0, 0, 0); PG8_SCHED; PG8_LDA(At, 0, 0); PG8_STAGE(PG8_SA(1, 1), a1 + hstep, voffA);
            PG8_WAIT_L(8); PG8_BAR; PG8_WAIT_L(0); PG8_MMA(0, 0, At, B0); PG8_BAR; PG8_SCHED;
            PG8_LDB(B1, 0, 1); PG8_STAGE(PG8_SB(0, 0), b2, voffB);
            PG8_BAR; PG8_WAIT_L(0); PG8_MMA(0, 1, At, B1); PG8_BAR;
            PG8_LDA(At, 0, 1); PG8_STAGE(PG8_SA(0, 0), a2, voffA);
            PG8_BAR; PG8_WAIT_L(0); PG8_MMA(1, 0, At, B0); PG8_BAR; PG8_SCHED;
            PG8_STAGE(PG8_SB(0, 1), b2 + hstep, voffB);
            PG8_WAIT_V(6); PG8_BAR; PG8_MMA(1, 1, At, B1); PG8_BAR;
            PG8_LDB(B0, 1, 0); PG8_SCHED; PG8_LDA(At, 1, 0); PG8_STAGE(PG8_SA(0, 1), a2 + hstep, voffA);
            PG8_WAIT_L(8); PG8_BAR; PG8_WAIT_L(0); PG8_MMA(0, 0, At, B0); PG8_BAR; PG8_SCHED;
            PG8_LDB(B1, 1, 1); PG8_STAGE(PG8_SB(1, 0), b3, voffB);
            PG8_BAR; PG8_WAIT_L(0); PG8_MMA(0, 1, At, B1); PG8_BAR;
            PG8_LDA(At, 1, 1); PG8_STAGE(PG8_SA(1, 0), a3, voffA);
            PG8_BAR; PG8_WAIT_L(0); PG8_MMA(1, 0, At, B0); PG8_BAR; PG8_SCHED;
            PG8_STAGE(PG8_SB(1, 1), b3 + hstep, voffB);
            PG8_WAIT_V(6); PG8_BAR; PG8_MMA(1, 1, At, B1); PG8_BAR;
            }
        }
        if constexpr (ALIGN_EPI) { if (wr == 0) PG8_BAR; }
        if constexpr (!Epi::AFTER_DRAIN) { if constexpr (Epi::PRE) E(acc, cur, wr, wc, fr, fq, rs8); else E(acc, cur, wr, wc, fr, fq); S.done(cur); }
        if (!has_next) break;
#pragma unroll
        for (int a = 0; a < 2; ++a)
#pragma unroll
            for (int b = 0; b < 2; ++b)
#pragma unroll
                for (int m = 0; m < 4; ++m)
#pragma unroll
                    for (int n = 0; n < 2; ++n) acc[a][b][m][n] = (f32x4){0.f, 0.f, 0.f, 0.f};
        cur = nxt; cA = nA; cB = nB; cHs = nHs; ++ui;
        if constexpr (Epi::PRE) E.pre(cur, wr, fr, rs8);
        if constexpr (ALIGN_EPI) { if (wr == 1) PG8_BAR; }
    }
    PG8_WAIT_V(0);
    if constexpr (!ALIGN_EPI) { if (wr == 0) PG8_BAR; }
    PG8_BAR;
    if constexpr (Epi::AFTER_DRAIN) { E.fused(acc, cur, wr, wc, fr, fq, lds, wid, lane); S.done(cur); }
#undef PG8_SA
#undef PG8_SB
#undef PG8_STAGE
#undef PG8_LDA
#undef PG8_LDB
#undef PG8_MMA
#undef PG8_WAIT_V
#undef PG8_WAIT_L
#undef PG8_BAR
#undef PG8_SCHED
}
}
#ifndef PG8_SP2
#define PG8_SP2 true
#endif
#ifndef PG8_ALIGN
#define PG8_ALIGN true
#endif
constexpr int NWAVES = 8;
#ifndef MK_ONE_LAUNCH
#define MK_ONE_LAUNCH 1
#endif
#ifndef SB_FAST
#define SB_FAST 1
#endif
#ifndef IDX_FAST
#define IDX_FAST 1
#endif
#ifndef DSA_FAST
#define DSA_FAST 2
#endif
#ifndef P6_MINI
#define P6_MINI 0
#endif
#ifndef PROBE_IDX
#define PROBE_IDX 0
#endif
#ifndef PROBE_DSA
#define PROBE_DSA 0
#endif
#ifndef PROBE_REP
#define PROBE_REP -1
#endif
constexpr int NPH = 12;

constexpr int BATCH = 8, S = 2048, D = 1024, M = BATCH * S;
constexpr int EVEN_IN = 3072, ODD_IN = 2120, ODD_PAD = 2304, FF = 2816, GU = 2 * FF;
constexpr int TOPK = 256;
constexpr float C2 = 0.125f * 1.4426950408889634f;

constexpr size_t MiB = 1u << 20;
constexpr size_t WS_CTL = 0, CTL_ZERO_BYTES = MiB / 2;
constexpr size_t WS_W_IN0 = 1 * MiB, WS_W_OUT0 = 7 * MiB, WS_W_GU0 = 9 * MiB, WS_W_DN0 = 20 * MiB, WS_W_IN1 = 26 * MiB, WS_W_OUT1 = 31 * MiB, WS_W_GU1 = 33 * MiB, WS_W_DN1 = 44 * MiB;
constexpr size_t WS_XB = 50 * MiB;
constexpr size_t WS_ATT = 82 * MiB;
constexpr size_t WS_BIG = 114 * MiB;
constexpr size_t WS_PROJ0 = WS_BIG;
constexpr size_t WS_H = WS_BIG;
constexpr size_t WS_Q1 = WS_BIG, WS_K1 = WS_BIG + 32 * MiB, WS_V1 = WS_BIG + 40 * MiB, WS_QI = WS_BIG + 48 * MiB, WS_KI = WS_BIG + 64 * MiB, WS_WI = WS_BIG + 66 * MiB, WS_MASK = WS_BIG + 68 * MiB;
constexpr size_t WS_END = 256 * MiB;
static_assert(WS_W_DN1 + (size_t)D * FF * 2 <= WS_XB && WS_PROJ0 + (size_t)M * EVEN_IN * 2 <= WS_END && WS_MASK + (size_t)M * 256 <= WS_END, "d_ws map");
constexpr int CW_BAR = 4096;
constexpr int CW_SS = 65536;

#define GAS __attribute__((address_space(1)))
#define LAS __attribute__((address_space(3)))
typedef unsigned short bf16;
typedef unsigned v4u __attribute__((ext_vector_type(4)));
typedef float f32x4 __attribute__((ext_vector_type(4)));
typedef short bf16x8 __attribute__((ext_vector_type(8)));
typedef GAS unsigned gu32;
#define RLX_AGENT __ATOMIC_RELAXED, __HIP_MEMORY_SCOPE_AGENT
#define LDS_WAIT() asm volatile("s_waitcnt lgkmcnt(0)" ::: "memory")
#define VM_WAIT() asm volatile("s_waitcnt vmcnt(0)" ::: "memory")
__device__ __forceinline__ unsigned f2bf(float f) { unsigned u = __builtin_bit_cast(unsigned, f); return (u + 0x7fffu + ((u >> 16) & 1u)) >> 16; }
__device__ __forceinline__ unsigned pk2(float lo, float hi) { return f2bf(lo) | (f2bf(hi) << 16); }
__device__ __forceinline__ float bf2f(unsigned short b) { return __builtin_bit_cast(float, (unsigned)b << 16); }
__device__ __forceinline__ float bflo(unsigned w) { return __builtin_bit_cast(float, w << 16); }
__device__ __forceinline__ float bfhi(unsigned w) { return __builtin_bit_cast(float, w & 0xffff0000u); }
#define XB_TMO      128
#define XB_XCNT(j)  (256  + 64 * (j))
#define XB_XSUB(j)  (1280 + 64 * (j))
#define XB_XGEN(j)  (2304 + 64 * (j))
#define XB_TOP      3328
#define XB_TOPGEN   3392
#define XCD_BAR_WORDS 3456
#define XB_SPIN_CAP (1u << 18)

__device__ __forceinline__ unsigned xb_ld(unsigned* p)              { return __hip_atomic_load(p, __ATOMIC_RELAXED, __HIP_MEMORY_SCOPE_AGENT); }
__device__ __forceinline__ unsigned xb_add(unsigned* p, unsigned v) { return __hip_atomic_fetch_add(p, v, __ATOMIC_RELAXED, __HIP_MEMORY_SCOPE_AGENT); }
__device__ __forceinline__ unsigned xb_xcc_id() { return (unsigned)__builtin_amdgcn_s_getreg((3 << 11) | 20) & 0xFu; }
#define XB_SPIN(cond, bar) do { unsigned _sp = 0; while (cond) { __builtin_amdgcn_s_sleep(1); \
    if ((++_sp & 255u) == 0u) { if (xb_ld(&(bar)[XB_TMO])) break; if (_sp > XB_SPIN_CAP) { atomicAdd(&(bar)[XB_TMO], 1u); break; } } } } while (0)

struct XcdBarrier {
    unsigned* bar; unsigned x;
    volatile LAS unsigned* st;
};

__device__ __forceinline__ XcdBarrier xcd_barrier_post(unsigned* bar, volatile LAS unsigned* st) {
    XcdBarrier b; b.bar = bar; b.x = xb_xcc_id(); b.st = st;
    if (threadIdx.x == 0) (void)xb_add(&bar[XB_XCNT(b.x)], 1u);
    return b;
}
__device__ __forceinline__ void xcd_barrier_complete(unsigned* bar, unsigned x, unsigned& nloc, unsigned& nx) {
    const unsigned G = gridDim.x * gridDim.y * gridDim.z;
    unsigned sum, cnt, mine, sp = 0u;
    for (;;) {
        sum = 0u; cnt = 0u; mine = 0u;
#pragma unroll
        for (unsigned j = 0; j < 16; ++j) { const unsigned c = xb_ld(&bar[XB_XCNT(j)]); sum += c; cnt += (c > 0u) ? 1u : 0u; mine = (j == x) ? c : mine; }
        if (sum == G) break;
        __builtin_amdgcn_s_sleep(1);
        if ((++sp & 255u) == 0u) { if (xb_ld(&bar[XB_TMO])) break; if (sp > XB_SPIN_CAP) { atomicAdd(&bar[XB_TMO], 1u); break; } }
    }
    nloc = mine > 0u ? mine : 1u; nx = cnt > 0u ? cnt : 1u;
}

__device__ __forceinline__ void xcd_barrier(const XcdBarrier& b) {
    asm volatile("s_waitcnt vmcnt(0)" ::: "memory");
    __syncthreads();
    if (threadIdx.x == 0) {
        unsigned* bar = b.bar;
        __builtin_amdgcn_s_waitcnt(0);
        unsigned nloc = b.st[0], nx = b.st[1];
        if (nloc == 0u) { xcd_barrier_complete(bar, b.x, nloc, nx); b.st[0] = nloc; b.st[1] = nx; }
        const unsigned old = xb_add(&bar[XB_XSUB(b.x)], 1u);
        const unsigned gen = old / nloc;
        if (old + 1u == (gen + 1u) * nloc) {
            __builtin_amdgcn_fence(__ATOMIC_RELEASE, "agent");
            asm volatile("s_waitcnt vmcnt(0)" ::: "memory");
            const unsigned og = xb_add(&bar[XB_TOP], 1u);
            const unsigned tg = og / nx;
            if (og + 1u == (tg + 1u) * nx) xb_add(&bar[XB_TOPGEN], 1u);
            else XB_SPIN(xb_ld(&bar[XB_TOPGEN]) == tg, bar);
            __builtin_amdgcn_fence(__ATOMIC_ACQUIRE, "agent");
            xb_add(&bar[XB_XGEN(b.x)], 1u);
            asm volatile("s_waitcnt vmcnt(0)" ::: "memory");
        } else {
            XB_SPIN(xb_ld(&bar[XB_XGEN(b.x)]) == gen, bar);
            __builtin_amdgcn_fence(__ATOMIC_ACQUIRE, "agent");
            asm volatile("s_waitcnt vmcnt(0)" ::: "memory");
        }
    }
    __syncthreads();
}
constexpr int RING_OFF = 0, RING_BYTES = 160 * 1024 - 256;
constexpr int MISC_OFF = 160 * 1024 - 256;
constexpr int LDS_BYTES = 160 * 1024;
struct Frame {
    LAS unsigned char* lds; volatile LAS unsigned* MISC; gu32* ctl;
    int tid, lane, wave, vcu, G;
    const float *x, *norm_mix, *norm_ffn, *ev_w_in, *ev_conv_w, *ev_w_out, *od_w_in, *od_q_gain, *od_k_gain, *od_w_out, *rel_bias, *w_gate, *w_up, *w_down;
    float* out; float* SS;
    bf16 *W_in0, *W_out0, *W_gu0, *W_dn0, *W_in1, *W_out1, *W_gu1, *W_dn1;
    bf16 *XB, *ATT, *PROJ0, *H, *Q1, *K1, *V1, *QI, *KI; float* WI; unsigned long long* MASK;
};
__device__ __forceinline__ float wave_sum(float v) {
#pragma unroll
    for (int o = 1; o < 64; o <<= 1) v += __shfl_xor(v, o);
    return v;
}
__device__ __forceinline__ float wave_max(float v) {
#pragma unroll
    for (int o = 1; o < 64; o <<= 1) v = fmaxf(v, __shfl_xor(v, o));
    return v;
}
__device__ __forceinline__ void tr_item(const float* W, int ldw, int sc0, int nvalid, const float* gain, int K, bf16* WT, int drow0, LAS float* scr, int kb, int lane) {
    const int k0 = 64 * kb, c = sc0 + (lane & 31); const bool ok = c < nvalid;
    float v[32];
#pragma unroll
    for (int i = 0; i < 32; ++i) v[i] = ok ? W[(size_t)(k0 + 2 * i + (lane >> 5)) * ldw + c] : 0.f;
    const int ch = lane & 7;
    f32x4 g0 = {1.f, 1.f, 1.f, 1.f}, g1 = g0;
    if (gain) { g0 = *(const f32x4*)(gain + k0 + 8 * ch); g1 = *(const f32x4*)(gain + k0 + 8 * ch + 4); }
#pragma unroll
    for (int i = 0; i < 32; ++i) scr[(2 * i + (lane >> 5)) * 33 + (lane & 31)] = v[i];
    LDS_WAIT(); asm volatile("" ::: "memory");
#pragma unroll
    for (int j = 0; j < 4; ++j) { const int n = (lane >> 3) + 8 * j; const LAS float* s = scr + (8 * ch) * 33 + n;
        v4u o; o.x = pk2(s[0 * 33] * g0[0], s[1 * 33] * g0[1]); o.y = pk2(s[2 * 33] * g0[2], s[3 * 33] * g0[3]); o.z = pk2(s[4 * 33] * g1[0], s[5 * 33] * g1[1]); o.w = pk2(s[6 * 33] * g1[2], s[7 * 33] * g1[3]);
        *(GAS v4u*)(WT + (size_t)(drow0 + n) * K + k0 + 8 * ch) = o; }
    LDS_WAIT(); asm volatile("" ::: "memory");
}
constexpr int I_IN0 = 16 * (EVEN_IN / 32), I_OUT = 16 * 32, I_GU = 16 * (GU / 32), I_DN = (FF / 64) * 32, I_IN1 = 16 * (ODD_PAD / 32);
constexpr int N_P0 = I_IN0 + I_OUT;
constexpr int N_EARLY = I_IN0 + I_OUT + I_GU, NITEMS = N_EARLY + I_DN + I_IN1 + I_OUT + I_GU + I_DN;
__device__ __forceinline__ void gu_item(Frame& F, int L, int r, LAS float* scr) { const int nb = GU / 32, kb = r / nb, db = r % nb, pn = db >> 3, j = db & 7;
    const float* W = ((j < 4) ? F.w_gate : F.w_up) + (size_t)L * D * FF;
    tr_item(W, FF, 128 * pn + 32 * (j & 3), FF, F.norm_ffn + L * D, D, L ? F.W_gu1 : F.W_gu0, 32 * db, scr, kb, F.lane); }
__device__ __forceinline__ void weight_item(Frame& F, int r, LAS float* scr) {
    if (r < I_IN0) { const int nb = EVEN_IN / 32, kb = r / nb, db = r % nb; tr_item(F.ev_w_in, EVEN_IN, 32 * db, EVEN_IN, F.norm_mix, D, F.W_in0, 32 * db, scr, kb, F.lane); return; } r -= I_IN0;
    if (r < I_OUT) { const int kb = r / 32, db = r % 32; tr_item(F.ev_w_out, D, 32 * db, D, nullptr, D, F.W_out0, 32 * db, scr, kb, F.lane); return; } r -= I_OUT;
    if (r < I_GU) { gu_item(F, 0, r, scr); return; } r -= I_GU;
    if (r < I_DN) { const int kb = r / 32, db = r % 32; tr_item(F.w_down, D, 32 * db, D, nullptr, FF, F.W_dn0, 32 * db, scr, kb, F.lane); return; } r -= I_DN;
    if (r < I_IN1) { const int nb = ODD_PAD / 32, kb = r / nb, db = r % nb, pn = db >> 3, bj = (db >> 2) & 1, wc = db & 3;
        tr_item(F.od_w_in, ODD_IN, 256 * pn + 64 * wc + 32 * bj, ODD_IN, F.norm_mix + D, D, F.W_in1, 32 * db, scr, kb, F.lane); return; } r -= I_IN1;
    if (r < I_OUT) { const int kb = r / 32, db = r % 32; tr_item(F.od_w_out, D, 32 * db, D, nullptr, D, F.W_out1, 32 * db, scr, kb, F.lane); return; } r -= I_OUT;
    if (r < I_GU) { gu_item(F, 1, r, scr); return; } r -= I_GU;
    { const int kb = r / 32, db = r % 32; tr_item(F.w_down + (size_t)FF * D, D, 32 * db, D, nullptr, FF, F.W_dn1, 32 * db, scr, kb, F.lane); }
}
__device__ __forceinline__ void late_weights(Frame& F) {
    if (F.G != 256 || (int)blockIdx.x < 128) return;
    LAS float* scr = (LAS float*)(F.lds + RING_OFF + F.wave * 16384);
    for (int it = N_EARLY + ((int)blockIdx.x - 128) * NWAVES + F.wave; it < NITEMS; it += 128 * NWAVES) weight_item(F, it, scr);
}
__device__ __forceinline__ void p2_weights(Frame& F) {
    if (F.G != 256) return;
    LAS float* scr = (LAS float*)(F.lds + RING_OFF + F.wave * 16384);
    for (int it = N_P0 + F.vcu * NWAVES + F.wave; it < N_EARLY; it += F.G * NWAVES) weight_item(F, it, scr);
}
__device__ __forceinline__ void p0_prologue(Frame& F) {
    LAS float* scr = (LAS float*)(F.lds + RING_OFF + F.wave * 16384);
    const int gw = F.vcu * NWAVES + F.wave, NGW = F.G * NWAVES;
    const int nit = (F.G == 256) ? N_P0 : NITEMS;
    for (int it = gw; it < nit; it += NGW) weight_item(F, it, scr);
    for (int m = gw; m < M; m += 2 * NGW) {
        const int m2 = m + NGW; const bool has2 = m2 < M;
        const GAS f32x4* xa = (const GAS f32x4*)(F.x + (size_t)m * D) + F.lane; const GAS f32x4* xb = (const GAS f32x4*)(F.x + (size_t)(has2 ? m2 : m) * D) + F.lane;
        f32x4 va[4], vb[4];
#pragma unroll
        for (int j = 0; j < 4; ++j) { va[j] = xa[64 * j]; vb[j] = xb[64 * j]; }
        GAS unsigned long long* oa = (GAS unsigned long long*)(F.XB + (size_t)m * D) + F.lane; GAS unsigned long long* ob = (GAS unsigned long long*)(F.XB + (size_t)m2 * D) + F.lane; float sa = 0.f, sb = 0.f;
#pragma unroll
        for (int j = 0; j < 4; ++j) { const f32x4 a = va[j], c = vb[j]; sa += (a.x * a.x + a.y * a.y) + (a.z * a.z + a.w * a.w); sb += (c.x * c.x + c.y * c.y) + (c.z * c.z + c.w * c.w);
            oa[64 * j] = (unsigned long long)pk2(a.x, a.y) | ((unsigned long long)pk2(a.z, a.w) << 32); if (has2) ob[64 * j] = (unsigned long long)pk2(c.x, c.y) | ((unsigned long long)pk2(c.z, c.w) << 32); }
        sa = wave_sum(sa); sb = wave_sum(sb); if (F.lane == 0) { F.SS[m] = sa; if (has2) F.SS[m2] = sb; }
    }
}
__device__ __forceinline__ void ld8(const bf16* p, float (&f)[8]) { const v4u w = *(const v4u*)p; f[0] = bflo(w.x); f[1] = bfhi(w.x); f[2] = bflo(w.y); f[3] = bfhi(w.y); f[4] = bflo(w.z); f[5] = bfhi(w.z); f[6] = bflo(w.w); f[7] = bfhi(w.w); }
__device__ __forceinline__ int rel_bucket(int dist) { if (dist < 16) return dist; const int l = 16 + (int)(logf((float)dist * (1.0f / 16.0f)) / logf(8.0f) * 16.0f); return l < 31 ? l : 31; }
__device__ __forceinline__ unsigned ord_key(float f) { unsigned u = __builtin_bit_cast(unsigned, f); if (u == 0x80000000u) u = 0u; return (u & 0x80000000u) ? ~u : (u | 0x80000000u); }
__device__ __forceinline__ void conv_part(Frame& F) {
    const int gt = (F.vcu * NWAVES + F.wave) * 64 + F.lane, NT = F.G * NWAVES * 64;
    for (int it = gt; it < M * 64; it += NT) { const int row = it >> 6, c8 = (it & 63) * 8, t = row & (S - 1);
        float bg[8], y[8]; ld8(F.PROJ0 + (size_t)row * EVEN_IN + 1536 + c8, bg);
#pragma unroll
        for (int i = 0; i < 8; ++i) y[i] = 0.f;
#pragma unroll
        for (int j = 0; j < 3; ++j) { if (t - 2 + j >= 0) { float cg[8], uu[8]; const bf16* p = F.PROJ0 + (size_t)(row - 2 + j) * EVEN_IN; ld8(p + 2048 + c8, cg); ld8(p + 2560 + c8, uu);
#pragma unroll
                for (int i = 0; i < 8; ++i) y[i] += F.ev_conv_w[j * 512 + c8 + i] * (cg[i] * uu[i]); } }
        v4u o; o.x = pk2(bg[0] * y[0], bg[1] * y[1]); o.y = pk2(bg[2] * y[2], bg[3] * y[3]); o.z = pk2(bg[4] * y[4], bg[5] * y[5]); o.w = pk2(bg[6] * y[6], bg[7] * y[7]);
        *(v4u*)(F.ATT + (size_t)row * D + 512 + c8) = o; }
}
__device__ __forceinline__ void sb_naive(Frame& F) {
    const int gw = F.vcu * NWAVES + F.wave, NGW = F.G * NWAVES;
    for (int idx = gw; idx < M * 8; idx += NGW) { const int h = idx & 7, row = idx >> 3, t = row & (S - 1);
        const float qd = bf2f(F.PROJ0[(size_t)row * EVEN_IN + h * 64 + F.lane]); float o = 0.f, carry = 1.f;
        for (int s = t - 1; s >= 0; --s) { const bf16* p = F.PROJ0 + (size_t)(row - t + s) * EVEN_IN + h * 64 + F.lane;
            const float z2 = wave_sum(qd * bf2f(p[512])), e = __builtin_amdgcn_exp2f(z2), a = __builtin_amdgcn_rcpf(1.0f + e), beta = 1.0f - a;
            o += beta * carry * bf2f(p[1024]); carry *= a; if (carry < 7.8886091e-31f) break; }
        F.ATT[(size_t)row * D + h * 64 + F.lane] = (bf16)f2bf(o); }
}
#define TK_CNT8(ACC, B, OP, X) do { unsigned long long q0 = __ballot(key[(B) + 0] OP (X)), q1 = __ballot(key[(B) + 1] OP (X)), q2 = __ballot(key[(B) + 2] OP (X)), q3 = __ballot(key[(B) + 3] OP (X)), \
        q4 = __ballot(key[(B) + 4] OP (X)), q5 = __ballot(key[(B) + 5] OP (X)), q6 = __ballot(key[(B) + 6] OP (X)), q7 = __ballot(key[(B) + 7] OP (X)); \
        asm volatile("" : "+s"(q0), "+s"(q1), "+s"(q2), "+s"(q3), "+s"(q4), "+s"(q5), "+s"(q6), "+s"(q7)); \
        ACC += (__popcll(q0) + __popcll(q1)) + (__popcll(q2) + __popcll(q3)) + (__popcll(q4) + __popcll(q5)) + (__popcll(q6) + __popcll(q7)); } while (0)
#define tk_put(lo, hi, w, i) do { const unsigned long long w_ = (w); if (lane == (i)) { lo = (unsigned)w_; hi = (unsigned)(w_ >> 32); } } while (0)
__device__ __forceinline__ void topk_row(const LAS float* sc, int n, unsigned long long* mrow, int lane) {
    unsigned wlo = 0u, whi = 0u;
    if (n <= TOPK) {
#pragma unroll
        for (int i = 0; i < 4; ++i) tk_put(wlo, whi, __ballot(64 * i + lane < n), i);
    } else {
        unsigned key[32];
        const int noct = (n + 511) >> 9;
#pragma unroll
        for (int c = 0; c < 4; ++c) {
            if (c < noct) {
#pragma unroll
                for (int i = 8 * c; i < 8 * c + 8; ++i) { const float f = sc[64 * i + lane]; key[i] = (64 * i + lane < n) ? ord_key(f) : 0u; }
            } else {
#pragma unroll
                for (int i = 8 * c; i < 8 * c + 8; ++i) key[i] = 0u; } }
        unsigned prefix = 0u; bool exact = false;
        for (int bit = 31; bit >= 0; --bit) { const unsigned cand = prefix | (1u << bit); int lc = 0;
#pragma unroll
            for (int i = 0; i < 8; ++i) lc += (key[i] >= cand) ? 1 : 0;
            if (noct > 1) {
#pragma unroll
                for (int i = 8; i < 16; ++i) lc += (key[i] >= cand) ? 1 : 0; }
            if (noct > 2) {
#pragma unroll
                for (int i = 16; i < 24; ++i) lc += (key[i] >= cand) ? 1 : 0; }
            if (noct > 3) {
#pragma unroll
                for (int i = 24; i < 32; ++i) lc += (key[i] >= cand) ? 1 : 0; }
            lc += __builtin_amdgcn_update_dpp(0, lc, 0xB1, 0xf, 0xf, true); lc += __builtin_amdgcn_update_dpp(0, lc, 0x4E, 0xf, 0xf, true);
            lc += __builtin_amdgcn_update_dpp(0, lc, 0x141, 0xf, 0xf, true); lc += __builtin_amdgcn_update_dpp(0, lc, 0x140, 0xf, 0xf, true);
            const int cnt = (__builtin_amdgcn_readlane(lc, 0) + __builtin_amdgcn_readlane(lc, 16)) + (__builtin_amdgcn_readlane(lc, 32) + __builtin_amdgcn_readlane(lc, 48));
            if (cnt >= TOPK) { prefix = cand; if (cnt == TOPK) { exact = true; break; } } }
        if (exact) {
#pragma unroll
            for (int c = 0; c < 4; ++c) { if (c < noct) {
#pragma unroll
                for (int i = 8 * c; i < 8 * c + 8; ++i) tk_put(wlo, whi, __ballot(key[i] >= prefix), i); } }
        } else {
            int gt = 0;
            TK_CNT8(gt, 0, >, prefix); TK_CNT8(gt, 8, >, prefix); TK_CNT8(gt, 16, >, prefix); TK_CNT8(gt, 24, >, prefix);
            const int need = TOPK - gt; int base = 0; const unsigned long long lt = (1ull << lane) - 1ull;
#pragma unroll
            for (int i = 0; i < 32; ++i) { const bool eq = key[i] == prefix; const unsigned long long be = __ballot(eq); const int rank = base + __popcll(be & lt); base += __popcll(be);
                tk_put(wlo, whi, __ballot(key[i] > prefix || (eq && rank < need)), i); }
        }
    }
    if (lane < 32) mrow[lane] = ((unsigned long long)whi << 32) | wlo;
}
#define TK_LOADKEYS(KEY, SC, N) do { _Pragma("unroll") for (int c = 0; c < 4; ++c) { if (c < noct) { _Pragma("unroll") for (int i = 8 * c; i < 8 * c + 8; ++i) { const float f = (SC)[64 * i + lane]; KEY[i] = (64 * i + lane < (N)) ? ord_key(f) : 0u; } } \
        else { _Pragma("unroll") for (int i = 8 * c; i < 8 * c + 8; ++i) KEY[i] = 0u; } } } while (0)
#define TK_FINAL(KEY, PREFIX, EXACT, MROW) do { unsigned wlo = 0u, whi = 0u; \
        if (EXACT) { _Pragma("unroll") for (int c = 0; c < 4; ++c) { if (c < noct) { _Pragma("unroll") for (int i = 8 * c; i < 8 * c + 8; ++i) tk_put(wlo, whi, __ballot(KEY[i] >= (PREFIX)), i); } } } \
        else { const unsigned* key = KEY; int gt = 0; TK_CNT8(gt, 0, >, (PREFIX)); TK_CNT8(gt, 8, >, (PREFIX)); TK_CNT8(gt, 16, >, (PREFIX)); TK_CNT8(gt, 24, >, (PREFIX)); \
            const int need = TOPK - gt; int base = 0; const unsigned long long lt = (1ull << lane) - 1ull; \
            _Pragma("unroll") for (int i = 0; i < 32; ++i) { const bool eq = KEY[i] == (PREFIX); const unsigned long long be = __ballot(eq); const int rank = base + __popcll(be & lt); base += __popcll(be); \
                tk_put(wlo, whi, __ballot(KEY[i] > (PREFIX) || (eq && rank < need)), i); } } \
        if (lane < 32) (MROW)[lane] = ((unsigned long long)whi << 32) | wlo; } while (0)
#define TK_WSUM(X) do { X += __builtin_amdgcn_update_dpp(0, X, 0xB1, 0xf, 0xf, true); X += __builtin_amdgcn_update_dpp(0, X, 0x4E, 0xf, 0xf, true); \
        X += __builtin_amdgcn_update_dpp(0, X, 0x141, 0xf, 0xf, true); X += __builtin_amdgcn_update_dpp(0, X, 0x140, 0xf, 0xf, true); } while (0)
__device__ __forceinline__ unsigned pk_lt1(unsigned candp, unsigned x, unsigned one) { unsigned d, t; asm("v_pk_sub_u16 %0, %1, %2 clamp" : "=v"(d) : "v"(candp), "v"(x)); asm("v_pk_min_u16 %0, %1, %2" : "=v"(t) : "v"(d), "v"(one)); return t; }
__device__ __forceinline__ unsigned pk_add16(unsigned a, unsigned b2) { unsigned r; asm("v_pk_add_u16 %0, %1, %2" : "=v"(r) : "v"(a), "v"(b2)); return r; }
__device__ __forceinline__ unsigned pk_mul16(unsigned a, unsigned b2) { unsigned r; asm("v_pk_mul_lo_u16 %0, %1, %2" : "=v"(r) : "v"(a), "v"(b2)); return r; }
#define TK_PKCOUNT(PA, PB, CA, CB, CNTA, CNTB) do { const unsigned cpa_ = (CA) * 0x10001u, cpb_ = (CB) * 0x10001u; unsigned a0_ = 0u, a1_ = 0u, b0_ = 0u, b1_ = 0u; \
        _Pragma("unroll") for (int c_ = 0; c_ < 4; ++c_) { if (c_ < noct) { \
            a0_ = pk_add16(a0_, pk_lt1(cpa_, PA[4 * c_], one)); b0_ = pk_add16(b0_, pk_lt1(cpb_, PB[4 * c_], one)); a1_ = pk_add16(a1_, pk_lt1(cpa_, PA[4 * c_ + 1], one)); b1_ = pk_add16(b1_, pk_lt1(cpb_, PB[4 * c_ + 1], one)); \
            a0_ = pk_add16(a0_, pk_lt1(cpa_, PA[4 * c_ + 2], one)); b0_ = pk_add16(b0_, pk_lt1(cpb_, PB[4 * c_ + 2], one)); a1_ = pk_add16(a1_, pk_lt1(cpa_, PA[4 * c_ + 3], one)); b1_ = pk_add16(b1_, pk_lt1(cpb_, PB[4 * c_ + 3], one)); } } \
        a0_ = pk_add16(a0_, a1_); b0_ = pk_add16(b0_, b1_); int la_ = (int)((a0_ & 0xffffu) + (a0_ >> 16)), lb_ = (int)((b0_ & 0xffffu) + (b0_ >> 16)); TK_WSUM(la_); TK_WSUM(lb_); \
        CNTA = 512 * noct - ((__builtin_amdgcn_readlane(la_, 0) + __builtin_amdgcn_readlane(la_, 16)) + (__builtin_amdgcn_readlane(la_, 32) + __builtin_amdgcn_readlane(la_, 48))); \
        CNTB = 512 * noct - ((__builtin_amdgcn_readlane(lb_, 0) + __builtin_amdgcn_readlane(lb_, 16)) + (__builtin_amdgcn_readlane(lb_, 32) + __builtin_amdgcn_readlane(lb_, 48))); } while (0)
__device__ __forceinline__ void topk_pair(const LAS float* scA, int nA, unsigned long long* mrowA, const LAS float* scB, int nB, unsigned long long* mrowB, int lane) {
    if (nB <= TOPK) { topk_row(scA, nA, mrowA, lane); topk_row(scB, nB, mrowB, lane); return; }
    const int noct = (nB + 511) >> 9;
    unsigned keyA[32], keyB[32];
    TK_LOADKEYS(keyA, scA, nA); TK_LOADKEYS(keyB, scB, nB);
    const unsigned one = 0x00010001u;
    unsigned PA[16], PB[16];
#pragma unroll
    for (int j = 0; j < 16; ++j) { PA[j] = (keyA[2 * j] >> 16) | (keyA[2 * j + 1] & 0xffff0000u); PB[j] = (keyB[2 * j] >> 16) | (keyB[2 * j + 1] & 0xffff0000u); }
    unsigned hA = 0u, hB = 0u, prefA = 0u, prefB = 0u; bool exA = false, exB = false, doneA = false, doneB = false;
    for (int bit = 15; bit >= 0; --bit) { const unsigned candA = hA | (1u << bit), candB = hB | (1u << bit); int cntA, cntB;
        TK_PKCOUNT(PA, PB, candA, candB, cntA, cntB);
        if (!doneA && cntA >= TOPK) { hA = candA; if (cntA == TOPK) { exA = true; doneA = true; prefA = candA << 16; } }
        if (!doneB && cntB >= TOPK) { hB = candB; if (cntB == TOPK) { exB = true; doneB = true; prefB = candB << 16; } }
        if (doneA && doneB) break; }
    if (!(doneA && doneB)) {
        { const unsigned ppa = hA * 0x10001u, ppb = hB * 0x10001u;
#pragma unroll
          for (int j = 0; j < 16; ++j) { unsigned gt_, lt_, lo_;
              { unsigned d_; asm("v_pk_sub_u16 %0, %1, %2 clamp" : "=v"(d_) : "v"(PA[j]), "v"(ppa)); asm("v_pk_min_u16 %0, %1, %2" : "=v"(gt_) : "v"(d_), "v"(one)); } lt_ = pk_lt1(ppa, PA[j], one);
              lo_ = (keyA[2 * j] & 0xffffu) | (keyA[2 * j + 1] << 16); PA[j] = (lo_ | pk_mul16(gt_, 0xffffffffu)) & ~pk_mul16(lt_, 0xffffffffu);
              { unsigned d_; asm("v_pk_sub_u16 %0, %1, %2 clamp" : "=v"(d_) : "v"(PB[j]), "v"(ppb)); asm("v_pk_min_u16 %0, %1, %2" : "=v"(gt_) : "v"(d_), "v"(one)); } lt_ = pk_lt1(ppb, PB[j], one);
              lo_ = (keyB[2 * j] & 0xffffu) | (keyB[2 * j + 1] << 16); PB[j] = (lo_ | pk_mul16(gt_, 0xffffffffu)) & ~pk_mul16(lt_, 0xffffffffu); } }
        unsigned lA = 0u, lB = 0u;
        for (int bit = 15; bit >= 0; --bit) { const unsigned candA = lA | (1u << bit), candB = lB | (1u << bit); int cntA, cntB;
            TK_PKCOUNT(PA, PB, candA, candB, cntA, cntB);
            if (!doneA && cntA >= TOPK) { lA = candA; if (cntA == TOPK) { exA = true; doneA = true; prefA = (hA << 16) | candA; } }
            if (!doneB && cntB >= TOPK) { lB = candB; if (cntB == TOPK) { exB = true; doneB = true; prefB = (hB << 16) | candB; } }
            if (doneA && doneB) break; }
        if (!doneA) prefA = (hA << 16) | lA;
        if (!doneB) prefB = (hB << 16) | lB;
    }
    TK_FINAL(keyA, prefA, exA, mrowA); TK_FINAL(keyB, prefB, exB, mrowB);
}
#undef TK_PKCOUNT
#undef TK_LOADKEYS
#undef TK_FINAL
#undef TK_WSUM
__device__ __forceinline__ void idx_naive(Frame& F) {
    LAS float* qs = (LAS float*)(F.lds + RING_OFF);
    LAS float* ws = qs + 512;
    LAS float* sc = qs + 1024;
    for (int row = blockIdx.x; row < M; row += F.G) { const int t = row & (S - 1), n = t + 1;
        if (n > TOPK) {
            qs[F.tid] = bf2f(F.QI[(size_t)row * 512 + F.tid]); if (F.tid < 8) ws[F.tid] = F.WI[(size_t)row * 8 + F.tid] * (0.125f * 0.35355339059327373f);
            __syncthreads();
            for (int s = F.tid; s < n; s += NWAVES * 64) { asm volatile("" ::: "memory"); const bf16* kp = F.KI + (size_t)(row - t + s) * 64; float kf[64];
#pragma unroll
                for (int c = 0; c < 8; ++c) { float f[8]; ld8(kp + 8 * c, f);
#pragma unroll
                    for (int i = 0; i < 8; ++i) kf[8 * c + i] = f[i]; }
                float acc = 0.f;
#pragma unroll
                for (int h = 0; h < 8; ++h) { float d = 0.f;
#pragma unroll
                    for (int i = 0; i < 64; ++i) d += qs[h * 64 + i] * kf[i];
                    acc += ws[h] * fmaxf(d, 0.f); }
                sc[s] = acc; }
            __syncthreads();
        }
        if (F.wave == 0) topk_row(sc, n, F.MASK + (size_t)row * 32, F.lane);
        __syncthreads();
    }
}
__device__ __forceinline__ void dsa_naive(Frame& F) {
    LAS int* idx = (LAS int*)(F.lds + RING_OFF);
    LAS float* qf = (LAS float*)(F.lds + RING_OFF + 1024);
    LAS float* pl = (LAS float*)(F.lds + RING_OFF + 8192) + F.wave * 256;
    LAS int* cntp = (LAS int*)(F.lds + RING_OFF + 6144);
    for (int row = blockIdx.x; row < M; row += F.G) { const int t = row & (S - 1);
        for (int i = F.tid; i < 1024; i += NWAVES * 64) qf[i] = bf2f(F.Q1[(size_t)row * 1024 + i]);
        if (F.wave == 0) { int base = 0; const unsigned long long lt = (1ull << F.lane) - 1ull;
            for (int w = 0; w < 32; ++w) { const unsigned long long word = F.MASK[(size_t)row * 32 + w]; if ((word >> F.lane) & 1ull) idx[base + __popcll(word & lt)] = 64 * w + F.lane; base += __popcll(word); }
            if (F.lane == 0) cntp[0] = base; }
        __syncthreads();
        const int cnt = cntp[0];
        for (int hd = F.wave; hd < 16; hd += NWAVES) { const int g = hd >> 2; float lg[4]; float mx = -INFINITY;
#pragma unroll
            for (int j = 0; j < 4; ++j) { asm volatile("" ::: "memory"); const int ki = j * 64 + F.lane; lg[j] = -INFINITY;
                if (ki < cnt) { const int s = idx[ki]; const bf16* kp = F.K1 + (size_t)(row - t + s) * 256 + g * 64; float d = 0.f;
#pragma unroll
                    for (int c = 0; c < 8; ++c) { float f[8]; ld8(kp + 8 * c, f);
#pragma unroll
                        for (int i = 0; i < 8; ++i) d += qf[hd * 64 + 8 * c + i] * f[i]; }
                    lg[j] = d + F.rel_bias[rel_bucket(t - s) * 16 + hd] * 1.4426950408889634f; }
                mx = fmaxf(mx, lg[j]); }
            mx = wave_max(mx); float l = 0.f;
#pragma unroll
            for (int j = 0; j < 4; ++j) { const float p = __builtin_amdgcn_exp2f(lg[j] - mx); l += p; pl[j * 64 + F.lane] = p; }
            l = wave_sum(l); LDS_WAIT(); asm volatile("" ::: "memory");
            float o = 0.f;
            for (int i = 0; i < cnt; ++i) o += pl[i] * bf2f(F.V1[(size_t)(row - t + idx[i]) * 256 + g * 64 + F.lane]);
            F.ATT[(size_t)row * D + hd * 64 + F.lane] = (bf16)f2bf(o / l);
            LDS_WAIT(); asm volatile("" ::: "memory"); }
        __syncthreads();
    }
}
typedef float f32x16 __attribute__((ext_vector_type(16)));
typedef short s16x4 __attribute__((ext_vector_type(4)));
typedef float f32x2_t __attribute__((ext_vector_type(2))); typedef __bf16 bf16x2_t __attribute__((ext_vector_type(2)));
__device__ __forceinline__ unsigned cvtpk(float lo, float hi) { f32x2_t v = {lo, hi}; bf16x2_t b = __builtin_convertvector(v, bf16x2_t); return __builtin_bit_cast(unsigned, b); }
__device__ __forceinline__ s16x4 vtr(const LAS unsigned char* p) { return __builtin_bit_cast(s16x4, __builtin_amdgcn_ds_read_tr16_b64_v4i16((LAS s16x4*)p)); }
__device__ __forceinline__ void load_kfrags(bf16x8 (&kf)[2][4], const bf16* kb, size_t pitch) {
#pragma unroll
    for (int kh = 0; kh < 2; ++kh)
#pragma unroll
        for (int d0 = 0; d0 < 4; ++d0) kf[kh][d0] = *(const bf16x8*)(kb + (size_t)kh * 32 * pitch + d0 * 16);
}
__device__ __forceinline__ void load_vpieces(v4u (&vv)[8], const bf16* vbase, size_t pitch, int lane) {
#pragma unroll
    for (int p = 0; p < 8; ++p) vv[p] = *(const v4u*)(vbase + (size_t)(16 * (p & 3) + (lane >> 2)) * pitch + 32 * (p >> 2) + (lane & 3) * 8);
}
__device__ __forceinline__ void store_vpieces(LAS unsigned char* vl, const v4u (&vv)[8], int lane) {
#pragma unroll
    for (int p = 0; p < 8; ++p) *(LAS v4u*)(vl + p * 1024 + lane * 16) = vv[p];
}
__device__ __forceinline__ void pv_mma(f32x16& o0, f32x16& o1, const LAS unsigned char* vb, const f32x16& p0, const f32x16& p1) {
    bf16x8 pa[4];
#pragma unroll
    for (int ks = 0; ks < 4; ++ks) { const f32x16& P = (ks < 2) ? p0 : p1; const int b = (ks & 1) * 8; v4u w; w.x = cvtpk(P[b], P[b + 1]); w.y = cvtpk(P[b + 2], P[b + 3]); w.z = cvtpk(P[b + 4], P[b + 5]); w.w = cvtpk(P[b + 6], P[b + 7]); pa[ks] = __builtin_bit_cast(bf16x8, w); }
#pragma unroll
    for (int ks = 0; ks < 4; ++ks) {
        const s16x4 l0 = vtr(vb + ks * 1024), h0 = vtr(vb + ks * 1024 + 512), l1 = vtr(vb + 4096 + ks * 1024), h1 = vtr(vb + 4096 + ks * 1024 + 512);
        o0 = __builtin_amdgcn_mfma_f32_32x32x16_bf16(pa[ks], (bf16x8){l0[0], l0[1], l0[2], l0[3], h0[0], h0[1], h0[2], h0[3]}, o0, 0, 0, 0);
        o1 = __builtin_amdgcn_mfma_f32_32x32x16_bf16(pa[ks], (bf16x8){l1[0], l1[1], l1[2], l1[3], h1[0], h1[1], h1[2], h1[3]}, o1, 0, 0, 0); }
}
__device__ __forceinline__ void store_o(LAS unsigned char* stg, const f32x16& o0, const f32x16& o1, const float (&sc)[16], bf16* dst, size_t pitch, int lane) {
    const int r32 = lane & 31, hi = lane >> 5; LAS unsigned short* s16 = (LAS unsigned short*)stg;
#pragma unroll
    for (int r = 0; r < 16; ++r) { const int orow = (r & 3) + 8 * (r >> 2) + 4 * hi; s16[orow * 64 + r32] = (unsigned short)f2bf(o0[r] * sc[r]); s16[orow * 64 + 32 + r32] = (unsigned short)f2bf(o1[r] * sc[r]); }
    LDS_WAIT(); asm volatile("" ::: "memory");
#pragma unroll
    for (int i = 0; i < 4; ++i) { const int row = i * 8 + (lane >> 3), ch = lane & 7; const v4u v = *(const LAS v4u*)(stg + row * 128 + ch * 16); *(v4u*)(dst + (size_t)row * pitch + ch * 8) = v; }
    LDS_WAIT(); asm volatile("" ::: "memory");
}
constexpr int MIX_WAVE_LDS = 12544;
__device__ __forceinline__ void sb_fast(Frame& F) {
    const int lane = F.lane, r32 = lane & 31, hi = lane >> 5;
    LAS unsigned char* vl = F.lds + RING_OFF + F.wave * MIX_WAVE_LDS; LAS unsigned char* stg = vl + 8192;
    const LAS unsigned char* vb = vl + ((lane >> 4) & 1) * 32 + (lane & 3) * 8 + (4 * hi + ((lane & 15) >> 2)) * 64;
    const int gw = F.vcu * NWAVES + F.wave, NGW = F.G * NWAVES;
    for (int u = gw; u < BATCH * 8 * 64; u += NGW) {
        const int qb = u & 63, h = (u >> 6) & 7, b = u >> 9, q0 = qb * 32; const size_t rowbase = (size_t)b * S;
        const bf16* Pq = F.PROJ0 + (rowbase + q0 + r32) * EVEN_IN + h * 64 + hi * 8;
        bf16x8 qr[4];
#pragma unroll
        for (int d0 = 0; d0 < 4; ++d0) qr[d0] = *(const bf16x8*)(Pq + d0 * 16);
        f32x16 o0 = {}, o1 = {}; float C = 1.f; const int ktmax = (q0 + 30) >> 6, qpos = q0 + r32;
        for (int kt = ktmax; kt >= 0; --kt) {
            bf16x8 kf[2][4]; v4u vv[8];
            load_kfrags(kf, F.PROJ0 + (rowbase + 64 * kt + r32) * EVEN_IN + 512 + h * 64 + hi * 8, EVEN_IN);
            load_vpieces(vv, F.PROJ0 + (rowbase + 64 * kt) * EVEN_IN + 1024 + h * 64, EVEN_IN, lane);
            f32x16 p0 = {}, p1 = {};
#pragma unroll
            for (int d0 = 0; d0 < 4; ++d0) { p0 = __builtin_amdgcn_mfma_f32_32x32x16_bf16(kf[0][d0], qr[d0], p0, 0, 0, 0); p1 = __builtin_amdgcn_mfma_f32_32x32x16_bf16(kf[1][d0], qr[d0], p1, 0, 0, 0); }
            store_vpieces(vl, vv, lane);
#pragma unroll
            for (int r = 0; r < 16; ++r) { p0[r] = __builtin_amdgcn_rcpf(1.0f + __builtin_amdgcn_exp2f(p0[r])); p1[r] = __builtin_amdgcn_rcpf(1.0f + __builtin_amdgcn_exp2f(p1[r])); }
            if (kt == ktmax) {
                const int kb = 64 * kt + 4 * hi;
#pragma unroll
                for (int r = 0; r < 16; ++r) { const int key = kb + (r & 3) + 8 * (r >> 2); if (key >= qpos) p0[r] = 1.0f; if (key + 32 >= qpos) p1[r] = 1.0f; }
            }
            float TL[8], TU[8];
#pragma unroll
            for (int blk = 0; blk < 8; ++blk) { const f32x16& P = (blk < 4) ? p0 : p1; const int c = (blk & 3) * 4; const float T = (P[c] * P[c + 1]) * (P[c + 2] * P[c + 3]);
                auto rr = __builtin_amdgcn_permlane32_swap(__float_as_uint(T), __float_as_uint(T), false, false); TL[blk] = __uint_as_float(rr[0]); TU[blk] = __uint_as_float(rr[1]); }
#pragma unroll
            for (int blk = 7; blk >= 0; --blk) { f32x16& P = (blk < 4) ? p0 : p1; const int c = (blk & 3) * 4;
                const float cu = C * TU[blk]; float s = hi ? C : cu; C = cu * TL[blk];
                const float a3 = P[c + 3], a2 = P[c + 2], a1 = P[c + 1], a0 = P[c];
                P[c + 3] = (1.0f - a3) * s; s *= a3; P[c + 2] = (1.0f - a2) * s; s *= a2; P[c + 1] = (1.0f - a1) * s; s *= a1; P[c] = (1.0f - a0) * s; }
            pv_mma(o0, o1, vb, p0, p1);
            if (__all(C < 7.8886091e-31f)) break;
        }
        float one[16];
#pragma unroll
        for (int r = 0; r < 16; ++r) one[r] = 1.0f;
        store_o(stg, o0, o1, one, F.ATT + (rowbase + q0) * D + h * 64, D, lane);
    }
}
constexpr int SC_PITCH = 2052;
template <int PMODE> __device__ __forceinline__ void idx_fast(Frame& F, unsigned long long* MOUT) {
    const int lane = F.lane, c16 = lane & 15, kq = lane >> 4;
    LAS float* scb = (LAS float*)(F.lds + RING_OFF);
    const int cb = (int)blockIdx.x, s6 = cb & 63;
    const int pitA = 16 * (s6 + 1) + 4, pitB = 16 * (128 - s6) + 4;
    LAS float* scA = scb; LAS float* scB = scb + 16 * pitA;
    for (int pi = 0; pi < 2; ++pi) {
        const int b = 2 * ((cb >> 6) & 3) + pi; const size_t rowbase = (size_t)b * S;
        if (PMODE != 2) {
#pragma unroll 1
            for (int un = 0; un < 2; ++un) {
                const int qb = un ? 127 - s6 : s6, q0 = qb * 16; LAS float* sc = un ? scB : scA; const int pit = un ? pitB : pitA;
                if (q0 + 16 <= TOPK) continue;
                const int w0 = un ? ((F.wave - (s6 + 1)) & 7) : F.wave;
                if (w0 > qb) continue;
                bf16x8 bq[8][2]; float w[8];
#pragma unroll
                for (int h = 0; h < 8; ++h) { const bf16* qp = F.QI + (rowbase + q0 + c16) * 512 + h * 64 + 8 * kq; bq[h][0] = *(const bf16x8*)qp; bq[h][1] = *(const bf16x8*)(qp + 32);
                    w[h] = F.WI[(rowbase + q0 + c16) * 8 + h] * (0.125f * 0.35355339059327373f); }
                const bf16* kp0 = F.KI + (rowbase + c16) * 64 + 8 * kq;
                bf16x8 na0 = *(const bf16x8*)(kp0 + (size_t)(16 * w0) * 64), na1 = *(const bf16x8*)(kp0 + (size_t)(16 * w0) * 64 + 32);
                for (int j = w0; j <= qb; j += NWAVES) {
                    const bf16x8 a0 = na0, a1 = na1;
                    { const int jn = (j + NWAVES <= qb) ? j + NWAVES : j; na0 = *(const bf16x8*)(kp0 + (size_t)(16 * jn) * 64); na1 = *(const bf16x8*)(kp0 + (size_t)(16 * jn) * 64 + 32); }
                    f32x4 s4 = {0.f, 0.f, 0.f, 0.f}, dd[8];
#pragma unroll
                    for (int h = 0; h < 8; ++h) { const f32x4 z = {0.f, 0.f, 0.f, 0.f}; dd[h] = __builtin_amdgcn_mfma_f32_16x16x32_bf16(a0, bq[h][0], z, 0, 0, 0); }
#pragma unroll
                    for (int h = 0; h < 8; ++h) dd[h] = __builtin_amdgcn_mfma_f32_16x16x32_bf16(a1, bq[h][1], dd[h], 0, 0, 0);
                    __builtin_amdgcn_sched_barrier(0);
#pragma unroll
                    for (int h = 0; h < 8; ++h)
#pragma unroll
                        for (int i = 0; i < 4; ++i) s4[i] += w[h] * __builtin_amdgcn_fmed3f(dd[h][i], 0.f, __builtin_inff());
                    *(LAS f32x4*)(sc + c16 * pit + 16 * j + 4 * kq) = s4; }
            }
        }
        __syncthreads();
        if (PMODE != 1) {
            { const int q0 = s6 * 16; topk_pair(scA + F.wave * pitA, q0 + F.wave + 1, MOUT + (rowbase + q0 + F.wave) * 32, scA + (F.wave + 8) * pitA, q0 + F.wave + 9, MOUT + (rowbase + q0 + F.wave + 8) * 32, lane); }
            { const int q0 = (127 - s6) * 16; topk_pair(scB + F.wave * pitB, q0 + F.wave + 1, MOUT + (rowbase + q0 + F.wave) * 32, scB + (F.wave + 8) * pitB, q0 + F.wave + 9, MOUT + (rowbase + q0 + F.wave + 8) * 32, lane); }
        }
        __syncthreads();
    }
}
__device__ __forceinline__ void dsa_fast(Frame& F) {
    const int lane = F.lane, r32 = lane & 31, hi = lane >> 5;
    LAS unsigned char* vl = F.lds + RING_OFF + F.wave * MIX_WAVE_LDS; LAS unsigned char* stg = vl + 8192; LAS float* wsf = (LAS float*)(vl + 12288);
    LAS float* tb = (LAS float*)(F.lds + RING_OFF + NWAVES * MIX_WAVE_LDS);
    const LAS unsigned char* vb = vl + ((lane >> 4) & 1) * 32 + (lane & 3) * 8 + (4 * hi + ((lane & 15) >> 2)) * 64;
    { float mq = fabsf(F.od_q_gain[lane]), mk = fabsf(F.od_k_gain[lane]), mb = 0.f;
#pragma unroll
      for (int i = 0; i < 8; ++i) mb = fmaxf(mb, fabsf(F.rel_bias[64 * i + lane]));
      mq = wave_max(mq); mk = wave_max(mk); mb = wave_max(mb);
      const float shift2 = (8.0f * mq * mk + mb) * 1.4426950408889634f;
      for (int i = F.tid; i < 2048; i += NWAVES * 64) tb[i] = F.rel_bias[rel_bucket(i & 127) * 16 + (i >> 7)] * 1.4426950408889634f - shift2; }
    __syncthreads();
    const int v = F.vcu, hd = 8 * (v & 1) + F.wave, g = hd >> 2, s4 = (v >> 1) & 15, b = v >> 5; const size_t rowbase = (size_t)b * S;
    const LAS float* tbh = tb + hd * 128; const float cfar = tbh[127];
    for (int ui = 0; ui < 4; ++ui) {
        const int qb = (ui == 0) ? s4 : (ui == 1) ? 31 - s4 : (ui == 2) ? 32 + s4 : 63 - s4, q0 = qb * 32, qpos = q0 + r32;
        const bf16* Pq = F.Q1 + (rowbase + q0 + r32) * 1024 + hd * 64 + hi * 8;
        bf16x8 qr[4];
#pragma unroll
        for (int d0 = 0; d0 < 4; ++d0) qr[d0] = *(const bf16x8*)(Pq + d0 * 16);
        f32x16 o0 = {}, o1 = {}; float l = 0.f; const int ktmax = (q0 + 31) >> 6;
        for (int kt = 0; kt <= ktmax; ++kt) {
            bf16x8 kf[2][4]; v4u vv[8];
            load_kfrags(kf, F.K1 + (rowbase + 64 * kt + r32) * 256 + g * 64 + hi * 8, 256);
            load_vpieces(vv, F.V1 + (rowbase + 64 * kt) * 256 + g * 64, 256, lane);
            const unsigned long long mw = F.MASK[(rowbase + qpos) * 32 + kt];
            const bool far = (q0 - (64 * kt + 63)) >= 113;
            f32x16 p0, p1;
#pragma unroll
            for (int r = 0; r < 16; ++r) { p0[r] = far ? cfar : 0.f; p1[r] = far ? cfar : 0.f; }
#pragma unroll
            for (int d0 = 0; d0 < 4; ++d0) { p0 = __builtin_amdgcn_mfma_f32_32x32x16_bf16(kf[0][d0], qr[d0], p0, 0, 0, 0); p1 = __builtin_amdgcn_mfma_f32_32x32x16_bf16(kf[1][d0], qr[d0], p1, 0, 0, 0); }
            store_vpieces(vl, vv, lane);
            if (!far) {
                const int d00 = qpos - 64 * kt - 4 * hi;
#pragma unroll
                for (int r = 0; r < 16; ++r) { const int d = d00 - ((r & 3) + 8 * (r >> 2)); p0[r] += tbh[min(max(d, 0), 127)]; p1[r] += tbh[min(max(d - 32, 0), 127)]; }
            }
            const unsigned m0 = (unsigned)mw >> (4 * hi), m1 = (unsigned)(mw >> 32) >> (4 * hi);
#pragma unroll
            for (int r = 0; r < 16; ++r) { const int bit = (r & 3) + 8 * (r >> 2);
                const float e0 = ((m0 >> bit) & 1u) ? __builtin_amdgcn_exp2f(p0[r]) : 0.f, e1 = ((m1 >> bit) & 1u) ? __builtin_amdgcn_exp2f(p1[r]) : 0.f;
                l += e0 + e1; p0[r] = e0; p1[r] = e1; }
            pv_mma(o0, o1, vb, p0, p1);
        }
        { auto rr = __builtin_amdgcn_permlane32_swap(__float_as_uint(l), __float_as_uint(l), false, false); l = __uint_as_float(rr[0]) + __uint_as_float(rr[1]); }
        if (hi == 0) wsf[r32] = l;
        LDS_WAIT(); asm volatile("" ::: "memory");
        float rl[16];
#pragma unroll
        for (int r = 0; r < 16; ++r) rl[r] = __builtin_amdgcn_rcpf(wsf[(r & 3) + 8 * (r >> 2) + 4 * hi]);
        store_o(stg, o0, o1, rl, F.ATT + (rowbase + q0) * D + hd * 64, D, lane);
    }
}
__device__ __forceinline__ void glds16(const void* gsrc, unsigned lds_dst) { unsigned keep;
    asm volatile("s_mov_b32 %0, m0\n\ts_mov_b32 m0, %2\n\ts_nop 0\n\tglobal_load_lds_dwordx4 %1, off\n\ts_mov_b32 m0, %0" : "=&s"(keep) : "v"(gsrc), "s"(lds_dst) : "memory"); }
#define WAIT_BAR(N) asm volatile("s_waitcnt vmcnt(" #N ") lgkmcnt(0)\n\ts_barrier" ::: "memory")
__device__ __forceinline__ void dsa_coop(Frame& F) {
    const int lane = F.lane, r32 = lane & 31, hi = lane >> 5, wave = F.wave;
    LAS unsigned char* L = F.lds + RING_OFF;
    LAS unsigned char* stg = L + 32768 + wave * 4096; LAS float* wsf = (LAS float*)(L + 65536 + wave * 256); LAS float* tb = (LAS float*)(L + 69632); LAS unsigned long long* ml = (LAS unsigned long long*)(L + 77824 + wave * 8192);
    const unsigned l0 = (unsigned)(uintptr_t)L;
    for (int i = F.tid; i < 2048; i += NWAVES * 64) tb[i] = (F.rel_bias[rel_bucket(i & 127) * 16 + (i >> 7)] - F.rel_bias[31 * 16 + (i >> 7)]) * 1.4426950408889634f;
    __syncthreads();
    const int v = F.vcu, bg = v >> 3, b = bg >> 2, g = bg & 3, s3 = v & 7, hd = 4 * g + (wave & 3), qh = wave >> 2; const size_t rowbase = (size_t)b * S;
    const LAS float* tbh = tb + hd * 128;
    const bf16x8 ones8 = {0x3F80, 0x3F80, 0x3F80, 0x3F80, 0x3F80, 0x3F80, 0x3F80, 0x3F80};
    const bf16* ksrc = F.K1 + (rowbase + lane) * 256 + g * 64 + wave * 8;
    const bf16* vsrc = F.V1 + (rowbase + 16 * (wave & 3) + (lane >> 2)) * 256 + g * 64 + (wave >> 2) * 32 + (lane & 3) * 8;
    const unsigned kdst = (unsigned)__builtin_amdgcn_readfirstlane(l0 + wave * 1024), vdst = kdst + 16384;
    const LAS unsigned char* kp = L + hi * 1024 + r32 * 16;
    const LAS unsigned char* vb = L + 16384 + ((lane >> 4) & 1) * 32 + (lane & 3) * 8 + (4 * hi + ((lane & 15) >> 2)) * 64;
    bf16x8 qrn[4]; v4u mreg[8];
#define DSA_PREFETCH(UI) do { const int qb_ = ((UI) == 0) ? s3 : ((UI) == 1) ? 15 - s3 : ((UI) == 2) ? 16 + s3 : 31 - s3; const int qpos_ = qb_ * 64 + qh * 32 + r32; \
        glds16(ksrc, kdst); glds16(vsrc, vdst); \
        const bf16* Pq_ = F.Q1 + (rowbase + qpos_) * 1024 + hd * 64 + hi * 8; _Pragma("unroll") for (int d0 = 0; d0 < 4; ++d0) qrn[d0] = *(const bf16x8*)(Pq_ + d0 * 16); \
        const v4u* mrow_ = (const v4u*)(F.MASK + (rowbase + qpos_) * 32 + 16 * hi); _Pragma("unroll") for (int i = 0; i < 8; ++i) mreg[i] = mrow_[i]; } while (0)
    DSA_PREFETCH(0);
    for (int ui = 0; ui < 4; ++ui) {
        const int qb = (ui == 0) ? s3 : (ui == 1) ? 15 - s3 : (ui == 2) ? 16 + s3 : 31 - s3, q0 = qb * 64 + qh * 32, qpos = q0 + r32, nt = qb + 1;
        bf16x8 qr[4];
#pragma unroll
        for (int d0 = 0; d0 < 4; ++d0) qr[d0] = qrn[d0];
#pragma unroll
        for (int i = 0; i < 8; ++i) { const v4u w = mreg[i]; ml[(16 * hi + 2 * i) * 32 + r32] = ((unsigned long long)w.y << 32) | w.x; ml[(16 * hi + 2 * i + 1) * 32 + r32] = ((unsigned long long)w.w << 32) | w.z; }
        f32x16 o0 = {}, o1 = {}, o2 = {};
        WAIT_BAR(4);
        for (int kt = 0; kt < nt; ++kt) {
            const int cur = (kt & 1) * 8192; const unsigned long long mw = ml[kt * 32 + r32];
            if (kt + 1 < nt) { glds16(ksrc + (size_t)(kt + 1) * 64 * 256, kdst + (8192 - cur)); glds16(vsrc + (size_t)(kt + 1) * 64 * 256, vdst + (8192 - cur)); }
            const bool far = (q0 - (64 * kt + 63)) >= 113;
            const f32x16 z16 = {};
            f32x16 p0, p1;
#pragma unroll
            for (int d0 = 0; d0 < 4; ++d0) { const bf16x8 k0 = *(const LAS bf16x8*)(kp + cur + d0 * 2048), k1 = *(const LAS bf16x8*)(kp + cur + d0 * 2048 + 512);
                p0 = __builtin_amdgcn_mfma_f32_32x32x16_bf16(k0, qr[d0], d0 ? p0 : z16, 0, 0, 0); p1 = __builtin_amdgcn_mfma_f32_32x32x16_bf16(k1, qr[d0], d0 ? p1 : z16, 0, 0, 0); }
            if (!far) {
                const int d00 = qpos - 64 * kt - 4 * hi;
#pragma unroll
                for (int r = 0; r < 16; ++r) { const int d = d00 - ((r & 3) + 8 * (r >> 2)); p0[r] += tbh[min(max(d, 0), 127)]; p1[r] += tbh[min(max(d - 32, 0), 127)]; }
            }
            const unsigned m0 = (unsigned)mw >> (4 * hi), m1 = (unsigned)(mw >> 32) >> (4 * hi);
            bf16x8 pa[4];
#pragma unroll
            for (int ks = 0; ks < 4; ++ks) { const f32x16& P = (ks < 2) ? p0 : p1; const unsigned mm = (ks < 2) ? m0 : m1; const int bb = (ks & 1) * 8; v4u wv;
#pragma unroll
                for (int j = 0; j < 4; ++j) { const int r = bb + 2 * j, bit = (r & 3) + 8 * (r >> 2); unsigned n0, n1, m2;
                    asm("v_bfe_i32 %0, %1, %2, 1" : "=v"(n0) : "v"(mm), "n"(bit)); asm("v_bfe_i32 %0, %1, %2, 1" : "=v"(n1) : "v"(mm), "n"(bit + 1));
                    asm("v_bfi_b32 %0, %1, %2, %3" : "=v"(m2) : "v"(0xffffu), "v"(n0), "v"(n1));
                    wv[j] = cvtpk(__builtin_amdgcn_exp2f(P[r]), __builtin_amdgcn_exp2f(P[r + 1])) & m2; }
                pa[ks] = __builtin_bit_cast(bf16x8, wv); }
            { const LAS unsigned char* vq = vb + cur;
#pragma unroll
              for (int ks = 0; ks < 4; ++ks) {
                const s16x4 l0 = vtr(vq + ks * 1024), h0 = vtr(vq + ks * 1024 + 512), l1 = vtr(vq + 4096 + ks * 1024), h1 = vtr(vq + 4096 + ks * 1024 + 512);
                o0 = __builtin_amdgcn_mfma_f32_32x32x16_bf16(pa[ks], (bf16x8){l0[0], l0[1], l0[2], l0[3], h0[0], h0[1], h0[2], h0[3]}, o0, 0, 0, 0);
                o1 = __builtin_amdgcn_mfma_f32_32x32x16_bf16(pa[ks], (bf16x8){l1[0], l1[1], l1[2], l1[3], h1[0], h1[1], h1[2], h1[3]}, o1, 0, 0, 0);
                o2 = __builtin_amdgcn_mfma_f32_32x32x16_bf16(pa[ks], ones8, o2, 0, 0, 0); } }
            WAIT_BAR(0);
        }
        if (ui == 0) DSA_PREFETCH(1); else if (ui == 1) DSA_PREFETCH(2); else if (ui == 2) DSA_PREFETCH(3);
        float rl[16];
#pragma unroll
        for (int r = 0; r < 16; ++r) rl[r] = __builtin_amdgcn_rcpf(o2[r]);
        store_o(stg, o0, o1, rl, F.ATT + (rowbase + q0) * D + hd * 64, D, lane);
    }
#undef DSA_PREFETCH
}
__device__ __forceinline__ void dsa_pipe(Frame& F) {
    const int lane = F.lane, r32 = lane & 31, hi = lane >> 5, wave = F.wave;
    LAS unsigned char* L = F.lds + RING_OFF;
    LAS unsigned char* stg = L + 32768 + wave * 4096; LAS float* wsf = (LAS float*)(L + 65536 + wave * 256); LAS float* tb = (LAS float*)(L + 69632); LAS unsigned long long* ml = (LAS unsigned long long*)(L + 77824 + wave * 8192);
    const unsigned l0 = (unsigned)(uintptr_t)L;
    { float mq = fabsf(F.od_q_gain[lane]), mk = fabsf(F.od_k_gain[lane]), mb = 0.f;
#pragma unroll
      for (int i = 0; i < 8; ++i) mb = fmaxf(mb, fabsf(F.rel_bias[64 * i + lane]));
      mq = wave_max(mq); mk = wave_max(mk); mb = wave_max(mb);
      const float shift2 = (8.0f * mq * mk + mb) * 1.4426950408889634f;
      for (int i = F.tid; i < 2048; i += NWAVES * 64) tb[i] = F.rel_bias[rel_bucket(i & 127) * 16 + (i >> 7)] * 1.4426950408889634f - shift2; }
    __syncthreads();
    const int v = F.vcu, bg = v >> 3, b = bg >> 2, g = bg & 3, s3 = v & 7, hd = 4 * g + (wave & 3), qh = wave >> 2; const size_t rowbase = (size_t)b * S;
    const LAS float* tbh = tb + hd * 128; const float cfar = tbh[127];
    const bf16* ksrc = F.K1 + (rowbase + lane) * 256 + g * 64 + wave * 8;
    const bf16* vsrc = F.V1 + (rowbase + 16 * (wave & 3) + (lane >> 2)) * 256 + g * 64 + (wave >> 2) * 32 + (lane & 3) * 8;
    const unsigned kdst = (unsigned)__builtin_amdgcn_readfirstlane(l0 + wave * 1024), vdst = kdst + 16384;
    const LAS unsigned char* kp = L + hi * 1024 + r32 * 16;
    const LAS unsigned char* vb = L + 16384 + ((lane >> 4) & 1) * 32 + (lane & 3) * 8 + (4 * hi + ((lane & 15) >> 2)) * 64;
#define DSA_QK(N0, N1, KOFF) do { _Pragma("unroll") for (int d0 = 0; d0 < 4; ++d0) { const bf16x8 k0 = *(const LAS bf16x8*)(kp + (KOFF) + d0 * 2048), k1 = *(const LAS bf16x8*)(kp + (KOFF) + d0 * 2048 + 512); \
        N0 = __builtin_amdgcn_mfma_f32_32x32x16_bf16(k0, qr[d0], N0, 0, 0, 0); N1 = __builtin_amdgcn_mfma_f32_32x32x16_bf16(k1, qr[d0], N1, 0, 0, 0); } } while (0)
#define DSA_STEP(QKF, NEARF) do { const int cur = (kt & 1) * 8192; \
        if (kt + 2 < nt) glds16(ksrc + (size_t)(kt + 2) * 64 * 256, kdst + cur); \
        if (kt + 1 < nt) glds16(vsrc + (size_t)(kt + 1) * 64 * 256, vdst + (8192 - cur)); \
        const unsigned long long mw = ml[kt * 32 + r32]; \
        f32x16 N0 = {}, N1 = {}; \
        if (QKF) { const float ci = (kt + 1 < kt_near) ? cfar : 0.f; _Pragma("unroll") for (int r = 0; r < 16; ++r) { N0[r] = ci; N1[r] = ci; } DSA_QK(N0, N1, 8192 - cur); } \
        if (NEARF) { const int d00 = qpos - 64 * kt - 4 * hi; \
            _Pragma("unroll") for (int r = 0; r < 16; ++r) { const int d = d00 - ((r & 3) + 8 * (r >> 2)); S0[r] += tbh[min(max(d, 0), 127)]; S1[r] += tbh[min(max(d - 32, 0), 127)]; } } \
        { const unsigned m0 = (unsigned)mw >> (4 * hi), m1 = (unsigned)(mw >> 32) >> (4 * hi); \
          _Pragma("unroll") for (int r = 0; r < 16; ++r) { const int bit = (r & 3) + 8 * (r >> 2); unsigned k0, k1; \
              asm("v_bfe_i32 %0, %1, %2, 1" : "=v"(k0) : "v"(m0), "n"(bit)); asm("v_bfe_i32 %0, %1, %2, 1" : "=v"(k1) : "v"(m1), "n"(bit)); \
              const float e0 = __uint_as_float(__float_as_uint(__builtin_amdgcn_exp2f(S0[r])) & k0), e1 = __uint_as_float(__float_as_uint(__builtin_amdgcn_exp2f(S1[r])) & k1); \
              l += e0 + e1; S0[r] = e0; S1[r] = e1; } } \
        if (QKF) { _Pragma("unroll") for (int i = 0; i < 8; ++i) { __builtin_amdgcn_sched_group_barrier(0x100, 1, 0); __builtin_amdgcn_sched_group_barrier(0x008, 1, 0); __builtin_amdgcn_sched_group_barrier(0x402, 20, 0); } } \
        pv_mma(o0, o1, vb + cur, S0, S1); \
        WAIT_BAR(0); \
        S0 = N0; S1 = N1; } while (0)
    for (int ui = 0; ui < 4; ++ui) {
        const int qb = (ui == 0) ? s3 : (ui == 1) ? 15 - s3 : (ui == 2) ? 16 + s3 : 31 - s3, q0 = qb * 64 + qh * 32, qpos = q0 + r32, nt = qb + 1;
        int kt_near = (q0 - 175 + 63) >> 6; kt_near = kt_near < 0 ? 0 : kt_near;
        const bf16* Pq = F.Q1 + (rowbase + qpos) * 1024 + hd * 64 + hi * 8;
        bf16x8 qr[4];
#pragma unroll
        for (int d0 = 0; d0 < 4; ++d0) qr[d0] = *(const bf16x8*)(Pq + d0 * 16);
        glds16(ksrc, kdst); glds16(vsrc, vdst); if (nt > 1) glds16(ksrc + (size_t)64 * 256, kdst + 8192);
        { const v4u* mrow = (const v4u*)(F.MASK + (rowbase + qpos) * 32 + 16 * hi);
#pragma unroll
          for (int i = 0; i < 8; ++i) { const v4u w = mrow[i]; ml[(16 * hi + 2 * i) * 32 + r32] = ((unsigned long long)w.y << 32) | w.x; ml[(16 * hi + 2 * i + 1) * 32 + r32] = ((unsigned long long)w.w << 32) | w.z; } }
        f32x16 o0 = {}, o1 = {}, S0, S1; float l = 0.f;
        WAIT_BAR(0);
        { const float ci = (0 < kt_near) ? cfar : 0.f;
#pragma unroll
          for (int r = 0; r < 16; ++r) { S0[r] = ci; S1[r] = ci; }
          DSA_QK(S0, S1, 0); }
        WAIT_BAR(0);
        for (int kt = 0; kt < nt; ++kt) {
            const bool hasqk = kt + 1 < nt;
            if (kt >= kt_near) { if (hasqk) DSA_STEP(1, 1); else DSA_STEP(0, 1); }
            else DSA_STEP(1, 0);
        }
        { auto rr = __builtin_amdgcn_permlane32_swap(__float_as_uint(l), __float_as_uint(l), false, false); l = __uint_as_float(rr[0]) + __uint_as_float(rr[1]); }
        if (hi == 0) wsf[r32] = l;
        LDS_WAIT(); asm volatile("" ::: "memory");
        float rl[16];
#pragma unroll
        for (int r = 0; r < 16; ++r) rl[r] = __builtin_amdgcn_rcpf(wsf[(r & 3) + 8 * (r >> 2) + 4 * hi]);
        store_o(stg, o0, o1, rl, F.ATT + (rowbase + q0) * D + hd * 64, D, lane);
    }
#undef DSA_QK
#undef DSA_STEP
}
template <int PMODE> __device__ __forceinline__ void dsa_pp(Frame& F, bf16* OUT) {
    const int lane = F.lane, r32 = lane & 31, hi = lane >> 5, wave = F.wave;
    LAS unsigned char* L = F.lds + RING_OFF;
    LAS unsigned char* stg = L + 49152 + wave * 4096; LAS float* wsf = (LAS float*)(L + 81920 + wave * 256); LAS float* tb = (LAS float*)(L + 83968); LAS unsigned long long* ml = (LAS unsigned long long*)(L + 92160 + wave * 8192);
    const unsigned l0 = (unsigned)(uintptr_t)L;
    { float mq = fabsf(F.od_q_gain[lane]), mk = fabsf(F.od_k_gain[lane]), mb = 0.f;
#pragma unroll
      for (int i = 0; i < 8; ++i) mb = fmaxf(mb, fabsf(F.rel_bias[64 * i + lane]));
      mq = wave_max(mq); mk = wave_max(mk); mb = wave_max(mb);
      const float shift2 = (8.0f * mq * mk + mb) * 1.4426950408889634f;
      for (int i = F.tid; i < 2048; i += NWAVES * 64) tb[i] = F.rel_bias[rel_bucket(i & 127) * 16 + (i >> 7)] * 1.4426950408889634f - shift2; }
    __syncthreads();
    const int v = F.vcu, bg = v >> 3, b = bg >> 2, g = bg & 3, s3 = v & 7, hd = 4 * g + (wave & 3), role = wave >> 2, qh = role; const size_t rowbase = (size_t)b * S;
    const LAS float* tbh = tb + hd * 128; const float cfar = tbh[127];
    const bf16* ksrc = F.K1 + (rowbase + lane) * 256 + g * 64 + wave * 8;
    const bf16* vsrc = F.V1 + (rowbase + 16 * (wave & 3) + (lane >> 2)) * 256 + g * 64 + (wave >> 2) * 32 + (lane & 3) * 8;
    const unsigned kdst = (unsigned)__builtin_amdgcn_readfirstlane(l0 + wave * 1024), vdst = kdst + 24576;
    const LAS unsigned char* kp = L + hi * 1024 + r32 * 16;
    const LAS unsigned char* vb = L + 24576 + ((lane >> 4) & 1) * 32 + (lane & 3) * 8 + (4 * hi + ((lane & 15) >> 2)) * 64;
    for (int ui = 0; ui < 4; ++ui) {
        const int qb = (ui == 0) ? s3 : (ui == 1) ? 15 - s3 : (ui == 2) ? 16 + s3 : 31 - s3, q0 = qb * 64 + qh * 32, qpos = q0 + r32, nt = qb + 1;
        int kt_near = (q0 - 175 + 63) >> 6; kt_near = kt_near < 0 ? 0 : kt_near;
        const bf16* Pq = F.Q1 + (rowbase + qpos) * 1024 + hd * 64 + hi * 8;
        bf16x8 qr[4];
#pragma unroll
        for (int d0 = 0; d0 < 4; ++d0) qr[d0] = *(const bf16x8*)(Pq + d0 * 16);
        glds16(ksrc, kdst); glds16(vsrc, vdst); if (nt > 1) glds16(ksrc + (size_t)64 * 256, kdst + 8192);
        { const v4u* mrow = (const v4u*)(F.MASK + (rowbase + qpos) * 32 + 16 * hi);
#pragma unroll
          for (int i = 0; i < 8; ++i) { const v4u w = mrow[i]; ml[(16 * hi + 2 * i) * 32 + r32] = ((unsigned long long)w.y << 32) | w.x; ml[(16 * hi + 2 * i + 1) * 32 + r32] = ((unsigned long long)w.w << 32) | w.z; } }
        f32x16 o0 = {}, o1 = {}, S0 = {}, S1 = {}; float l = 0.f; bf16x8 Pp[4] = {};
        WAIT_BAR(0);
        int nfly = 0;
        for (int h = 0; h <= 2 * nt + 1; ++h) {
            if (!(h & 1)) { const int t = h >> 1;
                nfly = 0;
                if (t + 2 < nt && PMODE != 4) { glds16(ksrc + (size_t)(t + 2) * 64 * 256, kdst + ((t + 2) % 3) * 8192); ++nfly; }
                if (t + 1 < nt && PMODE != 4) { glds16(vsrc + (size_t)(t + 1) * 64 * 256, vdst + ((t + 1) % 3) * 8192); ++nfly; } }
            const int j = h - role;
            if (j >= 0 && j <= 2 * nt) {
                const int t = j >> 1;
                if (!(j & 1)) {
                    if (t >= 1 && PMODE != 3) { const LAS unsigned char* vq = vb + ((t - 1) % 3) * 8192;
#pragma unroll
                        for (int ks = 0; ks < 4; ++ks) { const s16x4 a0 = vtr(vq + ks * 1024), b0 = vtr(vq + ks * 1024 + 512), a1 = vtr(vq + 4096 + ks * 1024), b1 = vtr(vq + 4096 + ks * 1024 + 512);
                            o0 = __builtin_amdgcn_mfma_f32_32x32x16_bf16(Pp[ks], (bf16x8){a0[0], a0[1], a0[2], a0[3], b0[0], b0[1], b0[2], b0[3]}, o0, 0, 0, 0);
                            o1 = __builtin_amdgcn_mfma_f32_32x32x16_bf16(Pp[ks], (bf16x8){a1[0], a1[1], a1[2], a1[3], b1[0], b1[1], b1[2], b1[3]}, o1, 0, 0, 0); } }
                    if (t < nt && PMODE != 3) { const float ci = (t < kt_near) ? cfar : 0.f; const LAS unsigned char* kq = kp + (t % 3) * 8192;
#pragma unroll
                        for (int r = 0; r < 16; ++r) { S0[r] = ci; S1[r] = ci; }
#pragma unroll
                        for (int d0 = 0; d0 < 4; ++d0) { const bf16x8 k0 = *(const LAS bf16x8*)(kq + d0 * 2048), k1 = *(const LAS bf16x8*)(kq + d0 * 2048 + 512);
                            S0 = __builtin_amdgcn_mfma_f32_32x32x16_bf16(k0, qr[d0], S0, 0, 0, 0); S1 = __builtin_amdgcn_mfma_f32_32x32x16_bf16(k1, qr[d0], S1, 0, 0, 0); } }
                } else if (PMODE != 2) {
                    const unsigned long long mw = ml[t * 32 + r32];
                    if (t >= kt_near) { const int d00 = qpos - 64 * t - 4 * hi;
#pragma unroll
                        for (int r = 0; r < 16; ++r) { const int d = d00 - ((r & 3) + 8 * (r >> 2)); S0[r] += tbh[min(max(d, 0), 127)]; S1[r] += tbh[min(max(d - 32, 0), 127)]; } }
                    const unsigned m0 = (unsigned)mw >> (4 * hi), m1 = (unsigned)(mw >> 32) >> (4 * hi);
#pragma unroll
                    for (int r = 0; r < 16; ++r) { const int bit = (r & 3) + 8 * (r >> 2); unsigned k0, k1;
                        asm("v_bfe_i32 %0, %1, %2, 1" : "=v"(k0) : "v"(m0), "n"(bit)); asm("v_bfe_i32 %0, %1, %2, 1" : "=v"(k1) : "v"(m1), "n"(bit));
                        const float e0 = __uint_as_float(__float_as_uint(__builtin_amdgcn_exp2f(S0[r])) & k0), e1 = __uint_as_float(__float_as_uint(__builtin_amdgcn_exp2f(S1[r])) & k1);
                        l += e0 + e1; S0[r] = e0; S1[r] = e1; }
#pragma unroll
                    for (int ks = 0; ks < 4; ++ks) { const f32x16& P = (ks < 2) ? S0 : S1; const int bb = (ks & 1) * 8; v4u w; w.x = cvtpk(P[bb], P[bb + 1]); w.y = cvtpk(P[bb + 2], P[bb + 3]);
                        w.z = cvtpk(P[bb + 4], P[bb + 5]); w.w = cvtpk(P[bb + 6], P[bb + 7]); Pp[ks] = __builtin_bit_cast(bf16x8, w); }
                }
            }
            if (nfly == 2) WAIT_BAR(2); else if (nfly == 1) WAIT_BAR(1); else WAIT_BAR(0);
        }
        { auto rr = __builtin_amdgcn_permlane32_swap(__float_as_uint(l), __float_as_uint(l), false, false); l = __uint_as_float(rr[0]) + __uint_as_float(rr[1]); }
        if (hi == 0) wsf[r32] = l;
        LDS_WAIT(); asm volatile("" ::: "memory");
        float rl[16];
#pragma unroll
        for (int r = 0; r < 16; ++r) rl[r] = __builtin_amdgcn_rcpf(wsf[(r & 3) + 8 * (r >> 2) + 4 * hi]);
        store_o(stg, o0, o1, rl, OUT + (rowbase + q0) * D + hd * 64, D, lane);
    }
}
template <int PMODE> __device__ __forceinline__ void dsa_hand(Frame& F, bf16* OUT) {
    const int lane = F.lane, r32 = lane & 31, hi = lane >> 5, wave = F.wave;
    LAS unsigned char* L = F.lds + RING_OFF;
    LAS unsigned char* stg = L + 32768 + wave * 4096; LAS float* wsf = (LAS float*)(L + 65536 + wave * 256); LAS float* tb = (LAS float*)(L + 69632); LAS unsigned long long* ml = (LAS unsigned long long*)(L + 77824 + wave * 8192);
    const unsigned l0 = (unsigned)(uintptr_t)L;
    for (int i = F.tid; i < 2048; i += NWAVES * 64) tb[i] = (F.rel_bias[rel_bucket(i & 127) * 16 + (i >> 7)] - F.rel_bias[31 * 16 + (i >> 7)]) * 1.4426950408889634f;
    __syncthreads();
    const int v = F.vcu, bg = v >> 3, b = bg >> 2, g = bg & 3, s3 = v & 7, hd = 4 * g + (wave & 3), qh = wave >> 2; const size_t rowbase = (size_t)b * S;
    const LAS float* tbh = tb + hd * 128;
    const bf16* ksrc = F.K1 + (rowbase + lane) * 256 + g * 64 + wave * 8;
    const bf16* vsrc = F.V1 + (rowbase + 16 * (wave & 3) + (lane >> 2)) * 256 + g * 64 + (wave >> 2) * 32 + (lane & 3) * 8;
    const unsigned kdst = (unsigned)__builtin_amdgcn_readfirstlane(l0 + wave * 1024), vdst = kdst + 16384;
    const LAS unsigned char* kp = L + hi * 1024 + r32 * 16;
    const LAS unsigned char* vb = L + 16384 + ((lane >> 4) & 1) * 32 + (lane & 3) * 8 + (4 * hi + ((lane & 15) >> 2)) * 64;
#define SBAR0() __builtin_amdgcn_sched_barrier(0)
#define DH_SM4(E) do {   \
        if (PMODE != 2) { unsigned ka, kb2, kc, kd; asm("v_bfe_i32 %0, %1, %2, 1" : "=v"(ka) : "v"(m0), "n"(((2 * (E)) & 3) + 8 * ((2 * (E)) >> 2))); asm("v_bfe_i32 %0, %1, %2, 1" : "=v"(kb2) : "v"(m0), "n"(((2 * (E) + 1) & 3) + 8 * ((2 * (E) + 1) >> 2))); \
          asm("v_bfe_i32 %0, %1, %2, 1" : "=v"(kc) : "v"(m1), "n"(((2 * (E)) & 3) + 8 * ((2 * (E)) >> 2))); asm("v_bfe_i32 %0, %1, %2, 1" : "=v"(kd) : "v"(m1), "n"(((2 * (E) + 1) & 3) + 8 * ((2 * (E) + 1) >> 2))); \
          const float ea = __uint_as_float(__float_as_uint(__builtin_amdgcn_exp2f(S0[2 * (E)])) & ka), eb = __uint_as_float(__float_as_uint(__builtin_amdgcn_exp2f(S0[2 * (E) + 1])) & kb2); \
          const float ec = __uint_as_float(__float_as_uint(__builtin_amdgcn_exp2f(S1[2 * (E)])) & kc), ed = __uint_as_float(__float_as_uint(__builtin_amdgcn_exp2f(S1[2 * (E) + 1])) & kd); \
          S0[2 * (E)] = ea; S0[2 * (E) + 1] = eb; S1[2 * (E)] = ec; S1[2 * (E) + 1] = ed; la += ea; lb += eb; la += ec; lb += ed; } \
        asm volatile("" : "+v"(S0), "+v"(S1), "+v"(la), "+v"(lb)); } while (0)
    for (int ui = 0; ui < 4; ++ui) {
        const int qb = (ui == 0) ? s3 : (ui == 1) ? 15 - s3 : (ui == 2) ? 16 + s3 : 31 - s3, q0 = qb * 64 + qh * 32, qpos = q0 + r32, nt = qb + 1;
        int kt_near = (q0 - 175 + 63) >> 6; kt_near = kt_near < 0 ? 0 : kt_near;
        const bf16* Pq = F.Q1 + (rowbase + qpos) * 1024 + hd * 64 + hi * 8;
        bf16x8 qr[4];
#pragma unroll
        for (int d0 = 0; d0 < 4; ++d0) qr[d0] = *(const bf16x8*)(Pq + d0 * 16);
        glds16(ksrc, kdst); glds16(vsrc, vdst); if (nt > 1) glds16(ksrc + (size_t)64 * 256, kdst + 8192);
        { const v4u* mrow = (const v4u*)(F.MASK + (rowbase + qpos) * 32 + 16 * hi);
#pragma unroll
          for (int i = 0; i < 8; ++i) { const v4u w = mrow[i]; ml[(16 * hi + 2 * i) * 32 + r32] = ((unsigned long long)w.y << 32) | w.x; ml[(16 * hi + 2 * i + 1) * 32 + r32] = ((unsigned long long)w.w << 32) | w.z; } }
        f32x16 o0 = {}, o1 = {}, S0 = {}, S1 = {}; float la = 0.f, lb = 0.f;
        WAIT_BAR(0);
#pragma unroll
        for (int d0 = 0; d0 < 4; ++d0) { const bf16x8 k0 = *(const LAS bf16x8*)(kp + d0 * 2048), k1 = *(const LAS bf16x8*)(kp + d0 * 2048 + 512);
            S0 = __builtin_amdgcn_mfma_f32_32x32x16_bf16(k0, qr[d0], S0, 0, 0, 0); S1 = __builtin_amdgcn_mfma_f32_32x32x16_bf16(k1, qr[d0], S1, 0, 0, 0); }
        WAIT_BAR(0);
        for (int kt = 0; kt < nt; ++kt) {
            const int cur = (kt & 1) * 8192;
            if (kt + 2 < nt) glds16(ksrc + (size_t)(kt + 2) * 64 * 256, kdst + cur);
            if (kt + 1 < nt) glds16(vsrc + (size_t)(kt + 1) * 64 * 256, vdst + (8192 - cur));
            const unsigned long long mw = ml[kt * 32 + r32];
            if (kt >= kt_near && PMODE != 4) { const int d00 = qpos - 64 * kt - 4 * hi;
#pragma unroll
                for (int r = 0; r < 16; ++r) { const int d = d00 - ((r & 3) + 8 * (r >> 2)); S0[r] += tbh[min(max(d, 0), 127)]; S1[r] += tbh[min(max(d - 32, 0), 127)]; } }
            const unsigned m0 = (unsigned)mw >> (4 * hi), m1 = (unsigned)(mw >> 32) >> (4 * hi);
            f32x16 N0 = {}, N1 = {};
            if (kt + 1 < nt && PMODE != 5) {
                const LAS unsigned char* kq = kp + (8192 - cur);
                bf16x8 kf[8];
#pragma unroll
                for (int i = 0; i < 8; ++i) kf[i] = *(const LAS bf16x8*)(kq + (i >> 1) * 2048 + (i & 1) * 512);
                SBAR0();
                N0 = __builtin_amdgcn_mfma_f32_32x32x16_bf16(kf[0], qr[0], N0, 0, 0, 0); DH_SM4(0); SBAR0();
                N1 = __builtin_amdgcn_mfma_f32_32x32x16_bf16(kf[1], qr[0], N1, 0, 0, 0); DH_SM4(1); SBAR0();
                N0 = __builtin_amdgcn_mfma_f32_32x32x16_bf16(kf[2], qr[1], N0, 0, 0, 0); DH_SM4(2); SBAR0();
                N1 = __builtin_amdgcn_mfma_f32_32x32x16_bf16(kf[3], qr[1], N1, 0, 0, 0); DH_SM4(3); SBAR0();
                N0 = __builtin_amdgcn_mfma_f32_32x32x16_bf16(kf[4], qr[2], N0, 0, 0, 0); DH_SM4(4); SBAR0();
                N1 = __builtin_amdgcn_mfma_f32_32x32x16_bf16(kf[5], qr[2], N1, 0, 0, 0); DH_SM4(5); SBAR0();
                N0 = __builtin_amdgcn_mfma_f32_32x32x16_bf16(kf[6], qr[3], N0, 0, 0, 0); DH_SM4(6); SBAR0();
                N1 = __builtin_amdgcn_mfma_f32_32x32x16_bf16(kf[7], qr[3], N1, 0, 0, 0); DH_SM4(7); SBAR0();
            } else { DH_SM4(0); DH_SM4(1); DH_SM4(2); DH_SM4(3); DH_SM4(4); DH_SM4(5); DH_SM4(6); DH_SM4(7); }
            if (PMODE != 3) pv_mma(o0, o1, vb + cur, S0, S1);
            WAIT_BAR(0);
            S0 = N0; S1 = N1;
        }
        float l = la + lb;
        { auto rr = __builtin_amdgcn_permlane32_swap(__float_as_uint(l), __float_as_uint(l), false, false); l = __uint_as_float(rr[0]) + __uint_as_float(rr[1]); }
        if (hi == 0) wsf[r32] = l;
        LDS_WAIT(); asm volatile("" ::: "memory");
        float rl[16];
#pragma unroll
        for (int r = 0; r < 16; ++r) rl[r] = __builtin_amdgcn_rcpf(wsf[(r & 3) + 8 * (r >> 2) + 4 * hi]);
        store_o(stg, o0, o1, rl, OUT + (rowbase + q0) * D + hd * 64, D, lane);
    }
#undef DH_SM4
#undef SBAR0
}
__device__ __forceinline__ void p6_mini(Frame& F) {
    const int lane = F.lane, c16 = lane & 15, kq = lane >> 4, mt = F.wave & 3, ns = F.wave >> 2;
    for (int blk = (int)blockIdx.x; blk < M / 64; blk += F.G) {
        const int r0 = blk * 64 + mt * 16;
        const bf16* ap = F.XB + (size_t)(r0 + c16) * D + 8 * kq;
        const int nb0 = ns ? 2176 : 2048, nb1 = ns ? 2192 : 2064, nb2 = 2080;
        const bf16* b0 = F.W_in1 + (size_t)(nb0 + c16) * D + 8 * kq; const bf16* b1 = F.W_in1 + (size_t)(nb1 + c16) * D + 8 * kq; const bf16* b2 = F.W_in1 + (size_t)(nb2 + c16) * D + 8 * kq;
        f32x4 a0 = {0.f, 0.f, 0.f, 0.f}, a1 = a0, a2 = a0;
#pragma unroll 4
        for (int ks = 0; ks < 32; ++ks) { const bf16x8 av = *(const bf16x8*)(ap + 32 * ks), v0 = *(const bf16x8*)(b0 + 32 * ks), v1 = *(const bf16x8*)(b1 + 32 * ks);
            a0 = __builtin_amdgcn_mfma_f32_16x16x32_bf16(av, v0, a0, 0, 0, 0); a1 = __builtin_amdgcn_mfma_f32_16x16x32_bf16(av, v1, a1, 0, 0, 0);
            if (!ns) { const bf16x8 v2 = *(const bf16x8*)(b2 + 32 * ks); a2 = __builtin_amdgcn_mfma_f32_16x16x32_bf16(av, v2, a2, 0, 0, 0); } }
#pragma unroll
        for (int i = 0; i < 4; ++i) { const int row = r0 + 4 * kq + i; const float sc = pg8::row_rstd(F.SS + 2 * M, row);
            F.KI[(size_t)row * 64 + (ns ? 32 : 0) + c16] = (bf16)f2bf(a0[i] * sc); F.KI[(size_t)row * 64 + (ns ? 48 : 16) + c16] = (bf16)f2bf(a1[i] * sc);
            if (!ns && c16 < 8) F.WI[(size_t)row * 8 + c16] = a2[i] * sc; }
    }
}
struct Args { const float* in[14]; float* out; unsigned char* ws; int ph_lo, ph_hi, li, pad; };
__global__ void __launch_bounds__(NWAVES * 64, 2) hybrid_fwd(Args args) {
    extern __shared__ __attribute__((aligned(16))) unsigned char lds[];
    Frame F;
    F.lds = (LAS unsigned char*)lds;
    F.MISC = (volatile LAS unsigned*)(F.lds + MISC_OFF);
    F.tid = threadIdx.x; F.lane = F.tid & 63; F.wave = __builtin_amdgcn_readfirstlane(F.tid >> 6);
    F.G = gridDim.x; { const int bx = blockIdx.x; F.vcu = (F.G % 8 == 0) ? (bx % 8) * (F.G / 8) + bx / 8 : bx; }
    unsigned char* ws = args.ws;
    F.ctl = (gu32*)(ws + WS_CTL);
    F.x = args.in[0]; F.norm_mix = args.in[1]; F.norm_ffn = args.in[2]; F.ev_w_in = args.in[3]; F.ev_conv_w = args.in[4]; F.ev_w_out = args.in[5]; F.od_w_in = args.in[6];
    F.od_q_gain = args.in[7]; F.od_k_gain = args.in[8]; F.od_w_out = args.in[9]; F.rel_bias = args.in[10]; F.w_gate = args.in[11]; F.w_up = args.in[12]; F.w_down = args.in[13];
    F.out = args.out; F.SS = (float*)(ws + WS_CTL) + CW_SS;
    F.W_in0 = (bf16*)(ws + WS_W_IN0); F.W_out0 = (bf16*)(ws + WS_W_OUT0); F.W_gu0 = (bf16*)(ws + WS_W_GU0); F.W_dn0 = (bf16*)(ws + WS_W_DN0);
    F.W_in1 = (bf16*)(ws + WS_W_IN1); F.W_out1 = (bf16*)(ws + WS_W_OUT1); F.W_gu1 = (bf16*)(ws + WS_W_GU1); F.W_dn1 = (bf16*)(ws + WS_W_DN1);
    F.XB = (bf16*)(ws + WS_XB); F.ATT = (bf16*)(ws + WS_ATT); F.PROJ0 = (bf16*)(ws + WS_PROJ0); F.H = (bf16*)(ws + WS_H);
    F.Q1 = (bf16*)(ws + WS_Q1); F.K1 = (bf16*)(ws + WS_K1); F.V1 = (bf16*)(ws + WS_V1); F.QI = (bf16*)(ws + WS_QI); F.KI = (bf16*)(ws + WS_KI); F.WI = (float*)(ws + WS_WI); F.MASK = (unsigned long long*)(ws + WS_MASK);
    if (F.tid < 64) ((LAS unsigned*)(F.lds + MISC_OFF))[F.tid] = 0u;
    __syncthreads();
    const int lo = args.ph_lo, hi = args.ph_hi;
    const bool use_bar = (hi - lo) > 1;
    XcdBarrier bar; bar.bar = (unsigned*)(F.ctl + CW_BAR) + args.li * XCD_BAR_WORDS; bar.x = 0; bar.st = nullptr;
    if (use_bar) bar = xcd_barrier_post((unsigned*)(F.ctl + CW_BAR) + args.li * XCD_BAR_WORDS, F.MISC + 8);
#define IN(k) (lo <= (k) && (k) < hi)
#define SEAM(k) do { if (IN(k) && IN((k) + 1)) xcd_barrier(bar); } while (0)
#define GEMM_PHASE(EPI, A_, B_, N_, K_, E_) do { pg8::Gemm g{A_, B_, M, N_, K_}; pg8::StaticOrder So; So.init(M, N_, F.G, (int)blockIdx.x); \
        pg8::gemm_phase<EPI, pg8::StaticOrder, PG8_ALIGN, PG8_SP2>(F.lds + RING_OFF, g, So, E_); } while (0)
#define GEMM_PHASE_T(EPI, A_, B_, N_, K_, E_) do { pg8::Gemm g{A_, B_, M, N_, K_}; pg8::TailOrder So; So.init(M, N_, F.G, (int)blockIdx.x); \
        pg8::gemm_phase<EPI, pg8::TailOrder, PG8_ALIGN, PG8_SP2>(F.lds + RING_OFF, g, So, E_); } while (0)

    if (IN(0)) { for (int rep = 0; rep < (PROBE_REP == 0 ? 2 : 1); ++rep) p0_prologue(F); } SEAM(0);
    if (IN(1)) { pg8::EpiIn0 E{F.PROJ0, F.SS, C2}; GEMM_PHASE(pg8::EpiIn0, F.XB, F.W_in0, EVEN_IN, D, E); if (PROBE_REP == 1) { GEMM_PHASE(pg8::EpiIn0, F.XB, F.W_in0, EVEN_IN, D, E); } } SEAM(1);
    if (IN(2)) { for (int rep = 0; rep < (PROBE_REP == 2 ? 2 : 1); ++rep) { conv_part(F); if (SB_FAST) sb_fast(F); else sb_naive(F); __syncthreads(); p2_weights(F); } } SEAM(2);
    if (IN(3)) { pg8::EpiRes E{F.XB, nullptr, F.SS + M}; GEMM_PHASE(pg8::EpiRes, F.ATT, F.W_out0, D, D, E); } SEAM(3);
    if (IN(4)) { pg8::EpiGU E{F.H, F.SS + M}; GEMM_PHASE(pg8::EpiGU, F.XB, F.W_gu0, GU, D, E); late_weights(F); } SEAM(4);
    if (IN(5)) { pg8::EpiRes E{F.XB, nullptr, F.SS + 2 * M}; GEMM_PHASE(pg8::EpiRes, F.H, F.W_dn0, D, FF, E); } SEAM(5);
    if (IN(6)) { LAS float* gl = (LAS float*)(F.lds + 131072 + 1024); if (F.tid < 64) { gl[F.tid] = F.od_q_gain[F.tid]; gl[64 + F.tid] = F.od_k_gain[F.tid]; } __syncthreads();
        pg8::EpiIn1 E{F.Q1, F.K1, F.V1, F.QI, F.KI, F.WI, F.SS + 2 * M, gl, gl + 64, C2}; GEMM_PHASE_T(pg8::EpiIn1, F.XB, F.W_in1, (P6_MINI ? 2048 : ODD_PAD), D, E); if (P6_MINI) p6_mini(F); } SEAM(6);
    if (IN(7)) { for (int rep = 0; rep < (PROBE_REP == 7 ? 2 : 1); ++rep) { if (IDX_FAST && F.G == 256) { idx_fast<0>(F, F.MASK); if (PROBE_IDX) { __syncthreads(); idx_fast<PROBE_IDX>(F, (unsigned long long*)F.XB); } } else idx_naive(F); } } SEAM(7);
    if (IN(8)) { for (int rep = 0; rep < (PROBE_REP == 8 ? 2 : 1); ++rep) { if (F.G != 256) dsa_naive(F); else if (DSA_FAST == 5) { dsa_hand<0>(F, F.ATT); if (PROBE_DSA) { __syncthreads(); dsa_hand<PROBE_DSA>(F, F.XB); } } else if (DSA_FAST == 4) { dsa_pp<0>(F, F.ATT); if (PROBE_DSA) { __syncthreads(); dsa_pp<PROBE_DSA>(F, F.XB); } } else if (DSA_FAST == 3) dsa_pipe(F); else if (DSA_FAST == 2) dsa_coop(F); else if (DSA_FAST) dsa_fast(F); else dsa_naive(F); __syncthreads(); } } SEAM(8);
    if (IN(9)) { pg8::EpiRes E{F.XB, nullptr, F.SS + 3 * M}; GEMM_PHASE(pg8::EpiRes, F.ATT, F.W_out1, D, D, E); } SEAM(9);
    if (IN(10)) { pg8::EpiGU E{F.H, F.SS + 3 * M}; GEMM_PHASE_T(pg8::EpiGU, F.XB, F.W_gu1, GU, D, E); } SEAM(10);
    if (IN(11)) { pg8::EpiRes E{F.XB, F.out, nullptr}; GEMM_PHASE(pg8::EpiRes, F.H, F.W_dn1, D, FF, E); }
#undef IN
#undef SEAM
#undef GEMM_PHASE
#undef GEMM_PHASE_T
}

extern "C" void kernel_launch(void* const* d_in, const int* in_sizes, int n_in, void* d_out, int out_size, void* d_ws, size_t ws_size, hipStream_t stream) {
    static int grid = 0;
    if (grid == 0) {
        if (n_in != 14 || in_sizes[0] != M * D || out_size != M * D || ws_size < WS_END) { fprintf(stderr, "kernel_launch: unexpected shapes (n_in %d, in0 %d, out %d, ws %zu); nothing launched\n", n_in, n_in > 0 ? in_sizes[0] : -1, out_size, ws_size); grid = -1; return; }
        int dev = 0, cus = 0, per_cu = 0;
        if (hipGetDevice(&dev) != hipSuccess || hipDeviceGetAttribute(&cus, hipDeviceAttributeMultiprocessorCount, dev) != hipSuccess) { grid = -1; return; }
        if (hipFuncSetAttribute((const void*)hybrid_fwd, hipFuncAttributeMaxDynamicSharedMemorySize, LDS_BYTES) != hipSuccess) { fprintf(stderr, "kernel_launch: hipFuncSetAttribute failed\n"); grid = -1; return; }
        if (hipOccupancyMaxActiveBlocksPerMultiprocessor(&per_cu, (const void*)hybrid_fwd, NWAVES * 64, LDS_BYTES) != hipSuccess || per_cu < 1) fprintf(stderr, "kernel_launch: note: occupancy query reports %d workgroups per CU\n", per_cu);
        (void)hipGetLastError();
        grid = cus;
    }
    if (grid < 0) return;
    if (hipMemsetAsync((char*)d_ws + WS_CTL, 0, CTL_ZERO_BYTES, stream) != hipSuccess) return;
    Args a{};
    for (int i = 0; i < 14; ++i) a.in[i] = (const float*)d_in[i];
    a.out = (float*)d_out; a.ws = (unsigned char*)d_ws;
#if MK_ONE_LAUNCH
    a.ph_lo = 0; a.ph_hi = NPH; a.li = 0;
    hipLaunchKernelGGL(hybrid_fwd, dim3(grid), dim3(NWAVES * 64), LDS_BYTES, stream, a);
#else
    for (int p = 0; p < NPH; ++p) { a.ph_lo = p; a.ph_hi = p + 1; a.li = p; hipLaunchKernelGGL(hybrid_fwd, dim3(grid), dim3(NWAVES * 64), LDS_BYTES, stream, a); }
#endif
}
```

```cpp
#include <hip/hip_runtime.h>
#include <cstdio>
#include <cstdint>
#include <cmath>
namespace pg8 {
#define PG8_LAS __attribute__((address_space(3)))
typedef unsigned short bf16_t;
typedef short bf16x8 __attribute__((ext_vector_type(8)));
typedef float f32x4 __attribute__((ext_vector_type(4)));
typedef unsigned u32x4 __attribute__((ext_vector_type(4)));
constexpr int BM = 256, BK = 64, HALF = 128, HTB = HALF * BK * 2  , STAGE_BYTES = 8 * HTB, NXCD = 8, WGM = 8;

__host__ __device__ __forceinline__ int lds_byte(int r, int c) { const int st = (r >> 4) * 2 + (c >> 5), rr = r & 15, cc = c & 31, ob = rr * 64 + cc * 2; return st * 1024 + (ob ^ (((ob >> 9) & 1) << 5)); }
__host__ __device__ __forceinline__ void stage_rc(int b, int& R, int& C) { const int st = b / 1024, sb = b % 1024, swz = sb ^ (((sb >> 9) & 1) << 5); R = (st >> 1) * 16 + swz / 64; C = (st & 1) * 32 + (swz % 64) / 2; }
__host__ __device__ __forceinline__ int perm32(int rho) { const int n = rho >> 4, i = rho & 15; return 8 * (i >> 2) + 4 * n + (i & 3); }

struct Unit { int pm, pn, half; };
struct Gemm { const bf16_t* A; const bf16_t* Bt; int M, N, K; };

struct StaticOrder {
    static constexpr bool HAS_HALF = false;
    int nM, nN, nwg, G, c;
    __host__ __device__ void init(int M, int N, int G_, int c_) { nM = M / BM; nN = N / BM; nwg = nM * nN; G = G_; c = c_; }
    __host__ __device__ __forceinline__ bool next(int i, Unit& u) const { return at((long)i * G + c, u); }
    __host__ __device__ __forceinline__ bool at(long L, Unit& u) const {
        if (L >= nwg) return false;
        int wgid = (int)L; { const int q = nwg / NXCD, r = nwg % NXCD, xcd = wgid % NXCD, off = wgid / NXCD; wgid = (xcd < r ? xcd * (q + 1) : r * (q + 1) + (xcd - r) * q) + off; }
        const int nig = WGM * nN, gid = wgid / nig, fm = gid * WGM, gsz = (nM - fm) < WGM ? (nM - fm) : WGM;
        u.pm = fm + ((wgid % nig) % gsz); u.pn = (wgid % nig) / gsz; u.half = 0; return true;
    }
    __device__ __forceinline__ void a_ready(const Unit&) const {}
    __device__ __forceinline__ void done(const Unit&) const {}
};
struct TailOrder {
    static constexpr bool HAS_HALF = true;
    StaticOrder so; int R, rem;
    __host__ __device__ __forceinline__ void init(int M, int N, int G_, int c_) { so.init(M, N, G_, c_); R = so.nwg / G_; rem = so.nwg % G_; if (2 * rem > G_) { R += 1; rem = 0; } }
    __host__ __device__ __forceinline__ bool next(int i, Unit& u) const {
        if (i < R) return so.next(i, u);
        if (i > R || so.c >= 2 * rem) return false;
        if (!so.at((long)R * so.G + (so.c >> 1), u)) return false; u.half = 1 + (so.c & 1); return true;
    }
    __device__ __forceinline__ void a_ready(const Unit&) const {}
    __device__ __forceinline__ void done(const Unit&) const {}
};
__device__ __forceinline__ unsigned cvt_pk_bf16(float lo, float hi) { unsigned r; asm volatile("v_cvt_pk_bf16_f32 %0, %1, %2" : "=v"(r) : "v"(lo), "v"(hi)); return r; }
typedef float f32x2 __attribute__((ext_vector_type(2)));
constexpr float NORM_EPS = 1e-6f, LOG2E = 1.4426950408889634f;
__device__ __forceinline__ u32x4 pack8(const f32x4 a, const f32x4 b) { u32x4 w; w.x = cvt_pk_bf16(a[0], a[1]); w.y = cvt_pk_bf16(a[2], a[3]); w.z = cvt_pk_bf16(b[0], b[1]); w.w = cvt_pk_bf16(b[2], b[3]); return w; }
__device__ __forceinline__ float row_rstd(const float* ss, int row) { return __builtin_amdgcn_rsqf(ss[row] * (1.0f / 1024.0f) + NORM_EPS); }
__device__ __forceinline__ float dot4(const f32x4 a) { return (a[0] * a[0] + a[1] * a[1]) + (a[2] * a[2] + a[3] * a[3]); }

struct EpiIn0 {
    static constexpr bool PERM = true, AFTER_DRAIN = false, PRE = true;
    bf16_t* O; const float* ss; float c2;
    __device__ __forceinline__ void pre(const Unit& u, int wr, int fr, float (&rs)[8]) const { const int row0 = u.pm * BM + wr * 64 + fr;
#pragma unroll
        for (int i = 0; i < 8; ++i) rs[i] = ss[row0 + (i >> 2) * HALF + (i & 3) * 16]; }
    __device__ __forceinline__ void operator()(const f32x4 (&acc)[2][2][4][2], const Unit& u, int wr, int wc, int fr, int fq, const float (&rs)[8]) const {
        const int row0 = u.pm * BM + wr * 64 + fr, col0 = u.pn * BM + wc * 32 + 8 * fq; const float cs = (u.pn < 2) ? c2 : 1.f;
#pragma unroll
        for (int ai = 0; ai < 2; ++ai)
#pragma unroll
            for (int m = 0; m < 4; ++m) { const int row = row0 + ai * HALF + m * 16; const float s = __builtin_amdgcn_rsqf(rs[ai * 4 + m] * (1.0f / 1024.0f) + NORM_EPS) * cs; bf16_t* rowp = O + (size_t)row * 3072 + col0;
#pragma unroll
                for (int bj = 0; bj < 2; ++bj) *(u32x4*)(rowp + bj * HALF) = pack8(acc[ai][bj][m][0] * s, acc[ai][bj][m][1] * s); }
    }
};
__device__ __forceinline__ f32x4 bf4lo(const u32x4 w) { f32x4 r; r[0] = __builtin_bit_cast(float, w.x << 16); r[1] = __builtin_bit_cast(float, w.x & 0xffff0000u); r[2] = __builtin_bit_cast(float, w.y << 16); r[3] = __builtin_bit_cast(float, w.y & 0xffff0000u); return r; }
__device__ __forceinline__ f32x4 bf4hi(const u32x4 w) { f32x4 r; r[0] = __builtin_bit_cast(float, w.z << 16); r[1] = __builtin_bit_cast(float, w.z & 0xffff0000u); r[2] = __builtin_bit_cast(float, w.w << 16); r[3] = __builtin_bit_cast(float, w.w & 0xffff0000u); return r; }
struct EpiRes {
    static constexpr bool PERM = true, AFTER_DRAIN = false, PRE = false;
    bf16_t* xb; float* out; float* ssn;
    __device__ __forceinline__ void operator()(const f32x4 (&acc)[2][2][4][2], const Unit& u, int wr, int wc, int fr, int fq) const {
        const int row0 = u.pm * BM + wr * 64 + fr, col0 = u.pn * BM + wc * 32 + 8 * fq;
#pragma unroll
        for (int ai = 0; ai < 2; ++ai)
#pragma unroll
            for (int m = 0; m < 4; ++m) { const int row = row0 + ai * HALF + m * 16; const size_t off = (size_t)row * 1024 + col0; float q = 0.f;
#pragma unroll
                for (int bj = 0; bj < 2; ++bj) { const u32x4 bw = *(const u32x4*)(xb + off + bj * HALF);
                    const f32x4 o0 = bf4lo(bw) + acc[ai][bj][m][0], o1 = bf4hi(bw) + acc[ai][bj][m][1];
                    if (out) { *(f32x4*)(out + off + bj * HALF) = o0; *(f32x4*)(out + off + bj * HALF + 4) = o1; }
                    else *(u32x4*)(xb + off + bj * HALF) = pack8(o0, o1);
                    q += dot4(o0) + dot4(o1); }
                if (ssn) { q += __shfl_xor(q, 16); q += __shfl_xor(q, 32); if (fq == 0) unsafeAtomicAdd(ssn + row, q); } }
    }
};
struct EpiGU {
    static constexpr bool PERM = true, AFTER_DRAIN = false, PRE = true;
    bf16_t* H; const float* ss;
    __device__ __forceinline__ void pre(const Unit& u, int wr, int fr, float (&rs)[8]) const { const int row0 = u.pm * BM + (u.half == 2 ? HALF : 0) + wr * 64 + fr;
#pragma unroll
        for (int i = 0; i < 8; ++i) rs[i] = ss[row0 + ((i >> 2) && !u.half ? HALF : 0) + (i & 3) * 16]; }
    __device__ __forceinline__ void operator()(const f32x4 (&acc)[2][2][4][2], const Unit& u, int wr, int wc, int fr, int fq, const float (&rs)[8]) const {
        const int row0 = u.pm * BM + (u.half == 2 ? HALF : 0) + wr * 64 + fr, col0 = u.pn * HALF + wc * 32 + 8 * fq;
#pragma unroll
        for (int ai = 0; ai < 2; ++ai)
#pragma unroll
            for (int m = 0; m < 4; ++m) { if (ai == 1 && u.half) continue; const int row = row0 + ai * HALF + m * 16; const float s = __builtin_amdgcn_rsqf(rs[ai * 4 + m] * (1.0f / 1024.0f) + NORM_EPS); f32x4 h[2];
#pragma unroll
                for (int n = 0; n < 2; ++n) { const f32x4 g = acc[ai][0][m][n] * s, uu = acc[ai][1][m][n] * s;
#pragma unroll
                    for (int i = 0; i < 4; ++i) { const float e = __builtin_amdgcn_exp2f(g[i] * (-LOG2E)); h[n][i] = g[i] * uu[i] * __builtin_amdgcn_rcpf(1.0f + e); } }
                *(u32x4*)(H + (size_t)row * 2816 + col0) = pack8(h[0], h[1]); }
    }
};
struct EpiIn1 {
    static constexpr bool PERM = true, AFTER_DRAIN = false, PRE = true;
    bf16_t *Q, *Kk, *V, *QI, *KI; float* WI; const float* ss; const PG8_LAS float* qg; const PG8_LAS float* kg; float c2;
    __device__ __forceinline__ void pre(const Unit& u, int wr, int fr, float (&rs)[8]) const { const int row0 = u.pm * BM + (u.half == 2 ? HALF : 0) + wr * 64 + fr;
#pragma unroll
        for (int i = 0; i < 8; ++i) rs[i] = ss[row0 + ((i >> 2) && !u.half ? HALF : 0) + (i & 3) * 16]; }
    __device__ __forceinline__ void operator()(const f32x4 (&acc)[2][2][4][2], const Unit& u, int wr, int wc, int fr, int fq, const float (&rs)[8]) const {
        const int row0 = u.pm * BM + (u.half == 2 ? HALF : 0) + wr * 64 + fr, pn = u.pn;
        if (pn <= 4) {
            const PG8_LAS float* gs = (pn < 4) ? qg : kg; const float gm = (pn < 4) ? c2 : 1.f; f32x4 gv[2][2];
#pragma unroll
            for (int bj = 0; bj < 2; ++bj)
#pragma unroll
                for (int n = 0; n < 2; ++n) gv[bj][n] = *(const PG8_LAS f32x4*)(gs + 32 * bj + 8 * fq + 4 * n) * gm;
#pragma unroll
            for (int ai = 0; ai < 2; ++ai)
#pragma unroll
                for (int m = 0; m < 4; ++m) { if (ai == 1 && u.half) continue; const int row = row0 + ai * HALF + m * 16; const float s = __builtin_amdgcn_rsqf(rs[ai * 4 + m] * (1.0f / 1024.0f) + NORM_EPS); f32x4 v[2][2]; float q = 0.f;
#pragma unroll
                    for (int bj = 0; bj < 2; ++bj)
#pragma unroll
                        for (int n = 0; n < 2; ++n) { v[bj][n] = acc[ai][bj][m][n] * s; q += dot4(v[bj][n]); }
                    q += __shfl_xor(q, 16); q += __shfl_xor(q, 32);
                    const float rn = __builtin_amdgcn_rsqf(q * (1.0f / 64.0f) + NORM_EPS);
                    bf16_t* dst = (pn < 4) ? Q + (size_t)row * 1024 + pn * 256 + wc * 64 + 8 * fq : Kk + (size_t)row * 256 + wc * 64 + 8 * fq;
#pragma unroll
                    for (int bj = 0; bj < 2; ++bj) *(u32x4*)(dst + bj * 32) = pack8(v[bj][0] * rn * gv[bj][0], v[bj][1] * rn * gv[bj][1]); }
        } else {
#pragma unroll
            for (int ai = 0; ai < 2; ++ai)
#pragma unroll
                for (int m = 0; m < 4; ++m) { if (ai == 1 && u.half) continue; const int row = row0 + ai * HALF + m * 16; const float s = __builtin_amdgcn_rsqf(rs[ai * 4 + m] * (1.0f / 1024.0f) + NORM_EPS);
                    if (pn == 8) {
                        if (wc == 0) {
#pragma unroll
                            for (int bj = 0; bj < 2; ++bj) *(u32x4*)(KI + (size_t)row * 64 + bj * 32 + 8 * fq) = pack8(acc[ai][bj][m][0] * s, acc[ai][bj][m][1] * s);
                        } else if (wc == 1 && fq == 0) { *(f32x4*)(WI + (size_t)row * 8) = acc[ai][0][m][0] * s; *(f32x4*)(WI + (size_t)row * 8 + 4) = acc[ai][0][m][1] * s; }
                    } else {
                        bf16_t* dst = (pn == 5) ? V + (size_t)row * 256 + wc * 64 + 8 * fq : QI + (size_t)row * 512 + (pn - 6) * 256 + wc * 64 + 8 * fq;
#pragma unroll
                        for (int bj = 0; bj < 2; ++bj) *(u32x4*)(dst + bj * 32) = pack8(acc[ai][bj][m][0] * s, acc[ai][bj][m][1] * s);
                    } }
        }
    }
};
template <class Epi, class Sched, bool ALIGN_EPI = false, bool SP2 = false>
__device__ __forceinline__ void gemm_phase(PG8_LAS unsigned char* lds, const Gemm g, const Sched& S, const Epi& E) {
    const int tid = threadIdx.x, wid = __builtin_amdgcn_readfirstlane(tid >> 6), lane = tid & 63, wr = wid >> 2, wc = wid & 3, fr = lane & 15, fq = lane >> 4;
    const int K = g.K, nt = K / BK;
    unsigned voffA[2], voffB[2];
#pragma unroll
    for (int i = 0; i < 2; ++i) { int R, C; stage_rc(tid * 16 + i * 8192, R, C); const int Rb = Epi::PERM ? ((R & ~31) + perm32(R & 31)) : R;
        voffA[i] = (unsigned)(R * K + C) * 2u; voffB[i] = (unsigned)(Rb * K + C) * 2u; }
    const size_t kstep = (size_t)(BK * 2);
    const size_t hstep = (size_t)HALF * K * 2;
    const size_t tstep = 2 * hstep;
    const unsigned ldsw = (unsigned)wid * 1024u;
    const int aoff = lds_byte(wr * 64 + fr, fq * 8), boff = lds_byte(wc * 32 + fr, fq * 8);
#define PG8_SA(b, h) (((b) * 2 + (h)) * HTB)
#define PG8_SB(b, h) ((4 + (b) * 2 + (h)) * HTB)
#define PG8_STAGE(bufoff, gbase, voff) do { _Pragma("unroll") for (int _i = 0; _i < 2; ++_i) \
        __builtin_amdgcn_global_load_lds((const unsigned*)((const char*)(gbase) + (voff)[_i]), (PG8_LAS unsigned*)(lds + (bufoff) + ldsw + _i * 8192), 16, 0, 0); } while (0)
#define PG8_LDA(dst, b, h) do { _Pragma("unroll") for (int m = 0; m < 4; ++m) _Pragma("unroll") for (int k = 0; k < 2; ++k) dst[m][k] = *(const PG8_LAS bf16x8*)(lds + PG8_SA(b, h) + aoff + m * 2048 + k * 1024); } while (0)
#define PG8_LDB(dst, b, h) do { _Pragma("unroll") for (int n = 0; n < 2; ++n) _Pragma("unroll") for (int k = 0; k < 2; ++k) dst[n][k] = *(const PG8_LAS bf16x8*)(lds + PG8_SB(b, h) + boff + n * 2048 + k * 1024); } while (0)
#define PG8_MMA(ai, bj, At, Bt) do { __builtin_amdgcn_s_setprio(1); _Pragma("unroll") for (int m = 0; m < 4; ++m) _Pragma("unroll") for (int n = 0; n < 2; ++n) _Pragma("unroll") for (int k = 0; k < 2; ++k) \
        acc[ai][bj][m][n] = __builtin_amdgcn_mfma_f32_16x16x32_bf16(Bt[n][k], At[m][k], acc[ai][bj][m][n], 0, 0, 0); __builtin_amdgcn_s_setprio(0); } while (0)
#define PG8_WAIT_V(n) asm volatile("s_waitcnt vmcnt(" #n ")" ::: "memory")
#define PG8_WAIT_L(n) asm volatile("s_waitcnt lgkmcnt(" #n ")" ::: "memory")
#define PG8_BAR __builtin_amdgcn_s_barrier()
#define PG8_SCHED __builtin_amdgcn_sched_barrier(0)
    Unit cur, nxt; int ui = 0;
    if (!S.next(0, cur)) return;
    f32x4 acc[2][2][4][2];
#pragma unroll
    for (int a = 0; a < 2; ++a)
#pragma unroll
        for (int b = 0; b < 2; ++b)
#pragma unroll
            for (int m = 0; m < 4; ++m)
#pragma unroll
                for (int n = 0; n < 2; ++n) acc[a][b][m][n] = (f32x4){0.f, 0.f, 0.f, 0.f};
    bf16x8 At[4][2], B0[2][2], B1[2][2];
    const char* cA = (const char*)g.A + (size_t)cur.pm * tstep + ((Sched::HAS_HALF && cur.half == 2) ? hstep : 0); const char* cB = (const char*)g.Bt + (size_t)cur.pn * tstep;
    unsigned cHs = (Sched::HAS_HALF && cur.half) ? 0u : (unsigned)hstep;
    S.a_ready(cur);
    float rs8[8];
    if constexpr (Epi::PRE) E.pre(cur, wr, fr, rs8);
    if constexpr (SP2) {
        PG8_STAGE(PG8_SB(0, 0), cB, voffB); PG8_STAGE(PG8_SB(0, 1), cB + hstep, voffB); PG8_STAGE(PG8_SA(0, 0), cA, voffA); PG8_STAGE(PG8_SA(0, 1), cA + cHs, voffA);
        if (wr == 1) PG8_BAR;
        PG8_WAIT_V(2); PG8_BAR;
        PG8_STAGE(PG8_SB(1, 0), cB + kstep, voffB); PG8_STAGE(PG8_SA(1, 0), cA + kstep, voffA); PG8_STAGE(PG8_SB(1, 1), cB + hstep + kstep, voffB);
        PG8_WAIT_V(6); PG8_BAR;
    } else {
        PG8_STAGE(PG8_SB(0, 0), cB, voffB); PG8_STAGE(PG8_SA(0, 0), cA, voffA); PG8_STAGE(PG8_SB(0, 1), cB + hstep, voffB); PG8_STAGE(PG8_SA(0, 1), cA + hstep, voffA);
        if (wr == 1) PG8_BAR;
        PG8_WAIT_V(4); PG8_BAR;
        PG8_STAGE(PG8_SB(1, 0), cB + kstep, voffB); PG8_STAGE(PG8_SA(1, 0), cA + kstep, voffA); PG8_STAGE(PG8_SB(1, 1), cB + hstep + kstep, voffB);
        PG8_WAIT_V(6); PG8_BAR;
    }
    for (;;) {
        const bool has_next = S.next(ui + 1, nxt);
        const char* nA = has_next ? (const char*)g.A + (size_t)nxt.pm * tstep + ((Sched::HAS_HALF && nxt.half == 2) ? hstep : 0) : cA; const char* nB = has_next ? (const char*)g.Bt + (size_t)nxt.pn * tstep : cB;
        const unsigned nHs = has_next ? ((Sched::HAS_HALF && nxt.half) ? 0u : (unsigned)hstep) : cHs;
        for (int t = 0; t < nt; t += 2) {
            const bool last = (t == nt - 2);
            const char* a1 = cA + (size_t)(t + 1) * kstep;
            const char* a2 = last ? nA : cA + (size_t)(t + 2) * kstep; const char* b2 = last ? nB : cB + (size_t)(t + 2) * kstep;
            const char* a3 = a2 + kstep; const char* b3 = b2 + kstep;
            const unsigned hs2 = last ? nHs : cHs;
            if (last && has_next) S.a_ready(nxt);
            if constexpr (SP2) {
            PG8_LDB(B0, 0, 0); PG8_LDB(B1, 0, 1); PG8_SCHED; PG8_LDA(At, 0, 0); PG8_STAGE(PG8_SA(1, 1), a1 + cHs, voffA);
            PG8_WAIT_V(8); PG8_WAIT_L(0); PG8_BAR; PG8_MMA(0, 0, At, B0); PG8_MMA(0, 1, At, B1); PG8_BAR; PG8_SCHED;
            PG8_LDA(At, 0, 1); PG8_STAGE(PG8_SB(0, 0), b2, voffB); PG8_STAGE(PG8_SB(0, 1), b2 + hstep, voffB); PG8_STAGE(PG8_SA(0, 0), a2, voffA);
            PG8_WAIT_V(8); PG8_WAIT_L(0); PG8_BAR; if (!(Sched::HAS_HALF && cur.half)) { PG8_MMA(1, 0, At, B0); PG8_MMA(1, 1, At, B1); } PG8_BAR; PG8_SCHED;
            PG8_LDB(B0, 1, 0); PG8_LDB(B1, 1, 1); PG8_SCHED; PG8_LDA(At, 1, 0); PG8_STAGE(PG8_SA(0, 1), a2 + hs2, voffA);
            PG8_WAIT_V(8); PG8_WAIT_L(0); PG8_BAR; PG8_MMA(0, 0, At, B0); PG8_MMA(0, 1, At, B1); PG8_BAR; PG8_SCHED;
            PG8_LDA(At, 1, 1); PG8_STAGE(PG8_SB(1, 0), b3, voffB); PG8_STAGE(PG8_SB(1, 1), b3 + hstep, voffB); PG8_STAGE(PG8_SA(1, 0), a3, voffA);
            PG8_WAIT_V(8); PG8_WAIT_L(0); PG8_BAR; if (!(Sched::HAS_HALF && cur.half)) { PG8_MMA(1, 0, At, B0); PG8_MMA(1, 1, At, B1); } PG8_BAR; PG8_SCHED;
            } else {
            PG8_LDB(B0, 0, 0); PG8_SCHED; PG8_LDA(At, 0, 0); PG8_STAGE(PG8_SA(1, 1), a1 + hstep, voffA);
            PG8_WAIT_L(8); PG8_BAR; PG8_WAIT_L(0); PG8_MMA(0, 0, At, B0); PG8_BAR; PG8_SCHED;
            PG8_LDB(B1, 0, 1); PG8_STAGE(PG8_SB(0, 0), b2, voffB);
            PG8_BAR; PG8_WAIT_L(0); PG8_MMA(0, 1, At, B1); PG8_BAR;
            PG8_LDA(At, 0, 1); PG8_STAGE(PG8_SA(0, 0), a2, voffA);
            PG8_BAR; PG8_WAIT_L(0); PG8_MMA(1, 0, At, B0); PG8_BAR; PG8_SCHED;
            PG8_STAGE(PG8_SB(0, 1), b2 + hstep, voffB);
            PG8_WAIT_V(6); PG8_BAR; PG8_MMA(1, 1, At, B1); PG8_BAR;
            PG8_LDB(B0, 1, 0); PG8_SCHED; PG8_LDA(At, 1, 0); PG8_STAGE(PG8_SA(0, 1), a2 + hstep, voffA);
            PG8_WAIT_L(8); PG8_BAR; PG8_WAIT_L(0); PG8_MMA(0, 0, At, B0); PG8_BAR; PG8_SCHED;
            PG8_LDB(B1, 1, 1); PG8_STAGE(PG8_SB(1, 0), b3, voffB);
            PG8_BAR; PG8_WAIT_L(0); PG8_MMA(0, 1, At, B1); PG8_BAR;
            PG8_LDA(At, 1, 1); PG8_STAGE(PG8_SA(1, 0), a3, voffA);
            PG8_BAR; PG8_WAIT_L(0); PG8_MMA(1, 0, At, B0); PG8_BAR; PG8_SCHED;
            PG8_STAGE(PG8_SB(1, 1), b3 + hstep, voffB);
            PG8_WAIT_V(6); PG8_BAR; PG8_MMA(1, 1, At, B1); PG8_BAR;
            }
        }
        if constexpr (ALIGN_EPI) { if (wr == 0) PG8_BAR; }
        if constexpr (!Epi::AFTER_DRAIN) { if constexpr (Epi::PRE) E(acc, cur, wr, wc, fr, fq, rs8); else E(acc, cur, wr, wc, fr, fq); S.done(cur); }
        if (!has_next) break;
#pragma unroll
        for (int a = 0; a < 2; ++a)
#pragma unroll
            for (int b = 0; b < 2; ++b)
#pragma unroll
                for (int m = 0; m < 4; ++m)
#pragma unroll
                    for (int n = 0; n < 2; ++n) acc[a][b][m][n] = (f32x4){0.f, 0.f, 0.f, 0.f};
        cur = nxt; cA = nA; cB = nB; cHs = nHs; ++ui;
        if constexpr (Epi::PRE) E.pre(cur, wr, fr, rs8);
        if constexpr (ALIGN_EPI) { if (wr == 1) PG8_BAR; }
    }
    PG8_WAIT_V(0);
    if constexpr (!ALIGN_EPI) { if (wr == 0) PG8_BAR; }
    PG8_BAR;
    if constexpr (Epi::AFTER_DRAIN) { E.fused(acc, cur, wr, wc, fr, fq, lds, wid, lane); S.done(cur); }
#undef PG8_SA
#undef PG8_SB
#undef PG8_STAGE
#undef PG8_LDA
#undef PG8_LDB
#undef PG8_MMA
#undef PG8_WAIT_V
#undef PG8_WAIT_L
#undef PG8_BAR
#undef PG8_SCHED
}
}
#ifndef PG8_SP2
#define PG8_SP2 true
#endif
#ifndef PG8_ALIGN
#define PG8_ALIGN true
#endif
constexpr int NWAVES = 8;
#ifndef MK_ONE_LAUNCH
#define MK_ONE_LAUNCH 1
#endif
#ifndef SB_FAST
#define SB_FAST 1
#endif
#ifndef IDX_FAST
#define IDX_FAST 1
#endif
#ifndef DSA_FAST
#define DSA_FAST 2
#endif
#ifndef P6_MINI
#define P6_MINI 0
#endif
#ifndef PROBE_IDX
#define PROBE_IDX 0
#endif
#ifndef PROBE_DSA
#define PROBE_DSA 0
#endif
#ifndef PROBE_REP
#define PROBE_REP -1
#endif
constexpr int NPH = 12;

constexpr int BATCH = 8, S = 2048, D = 1024, M = BATCH * S;
constexpr int EVEN_IN = 3072, ODD_IN = 2120, ODD_PAD = 2304, FF = 2816, GU = 2 * FF;
constexpr int TOPK = 256;
constexpr float C2 = 0.125f * 1.4426950408889634f;

constexpr size_t MiB = 1u << 20;
constexpr size_t WS_CTL = 0, CTL_ZERO_BYTES = MiB / 2;
constexpr size_t WS_W_IN0 = 1 * MiB, WS_W_OUT0 = 7 * MiB, WS_W_GU0 = 9 * MiB, WS_W_DN0 = 20 * MiB, WS_W_IN1 = 26 * MiB, WS_W_OUT1 = 31 * MiB, WS_W_GU1 = 33 * MiB, WS_W_DN1 = 44 * MiB;
constexpr size_t WS_XB = 50 * MiB;
constexpr size_t WS_ATT = 82 * MiB;
constexpr size_t WS_BIG = 114 * MiB;
constexpr size_t WS_PROJ0 = WS_BIG;
constexpr size_t WS_H = WS_BIG;
constexpr size_t WS_Q1 = WS_BIG, WS_K1 = WS_BIG + 32 * MiB, WS_V1 = WS_BIG + 40 * MiB, WS_QI = WS_BIG + 48 * MiB, WS_KI = WS_BIG + 64 * MiB, WS_WI = WS_BIG + 66 * MiB, WS_MASK = WS_BIG + 68 * MiB;
constexpr size_t WS_END = 256 * MiB;
static_assert(WS_W_DN1 + (size_t)D * FF * 2 <= WS_XB && WS_PROJ0 + (size_t)M * EVEN_IN * 2 <= WS_END && WS_MASK + (size_t)M * 256 <= WS_END, "d_ws map");
constexpr int CW_BAR = 4096;
constexpr int CW_SS = 65536;

#define GAS __attribute__((address_space(1)))
#define LAS __attribute__((address_space(3)))
typedef unsigned short bf16;
typedef unsigned v4u __attribute__((ext_vector_type(4)));
typedef float f32x4 __attribute__((ext_vector_type(4)));
typedef short bf16x8 __attribute__((ext_vector_type(8)));
typedef GAS unsigned gu32;
#define RLX_AGENT __ATOMIC_RELAXED, __HIP_MEMORY_SCOPE_AGENT
#define LDS_WAIT() asm volatile("s_waitcnt lgkmcnt(0)" ::: "memory")
#define VM_WAIT() asm volatile("s_waitcnt vmcnt(0)" ::: "memory")
__device__ __forceinline__ unsigned f2bf(float f) { unsigned u = __builtin_bit_cast(unsigned, f); return (u + 0x7fffu + ((u >> 16) & 1u)) >> 16; }
__device__ __forceinline__ unsigned pk2(float lo, float hi) { return f2bf(lo) | (f2bf(hi) << 16); }
__device__ __forceinline__ float bf2f(unsigned short b) { return __builtin_bit_cast(float, (unsigned)b << 16); }
__device__ __forceinline__ float bflo(unsigned w) { return __builtin_bit_cast(float, w << 16); }
__device__ __forceinline__ float bfhi(unsigned w) { return __builtin_bit_cast(float, w & 0xffff0000u); }
#define XB_TMO      128
#define XB_XCNT(j)  (256  + 64 * (j))
#define XB_XSUB(j)  (1280 + 64 * (j))
#define XB_XGEN(j)  (2304 + 64 * (j))
#define XB_TOP      3328
#define XB_TOPGEN   3392
#define XCD_BAR_WORDS 3456
#define XB_SPIN_CAP (1u << 18)

__device__ __forceinline__ unsigned xb_ld(unsigned* p)              { return __hip_atomic_load(p, __ATOMIC_RELAXED, __HIP_MEMORY_SCOPE_AGENT); }
__device__ __forceinline__ unsigned xb_add(unsigned* p, unsigned v) { return __hip_atomic_fetch_add(p, v, __ATOMIC_RELAXED, __HIP_MEMORY_SCOPE_AGENT); }
__device__ __forceinline__ unsigned xb_xcc_id() { return (unsigned)__builtin_amdgcn_s_getreg((3 << 11) | 20) & 0xFu; }
#define XB_SPIN(cond, bar) do { unsigned _sp = 0; while (cond) { __builtin_amdgcn_s_sleep(1); \
    if ((++_sp & 255u) == 0u) { if (xb_ld(&(bar)[XB_TMO])) break; if (_sp > XB_SPIN_CAP) { atomicAdd(&(bar)[XB_TMO], 1u); break; } } } } while (0)

struct XcdBarrier {
    unsigned* bar; unsigned x;
    volatile LAS unsigned* st;
};

__device__ __forceinline__ XcdBarrier xcd_barrier_post(unsigned* bar, volatile LAS unsigned* st) {
    XcdBarrier b; b.bar = bar; b.x = xb_xcc_id(); b.st = st;
    if (threadIdx.x == 0) (void)xb_add(&bar[XB_XCNT(b.x)], 1u);
    return b;
}
__device__ __forceinline__ void xcd_barrier_complete(unsigned* bar, unsigned x, unsigned& nloc, unsigned& nx) {
    const unsigned G = gridDim.x * gridDim.y * gridDim.z;
    unsigned sum, cnt, mine, sp = 0u;
    for (;;) {
        sum = 0u; cnt = 0u; mine = 0u;
#pragma unroll
        for (unsigned j = 0; j < 16; ++j) { const unsigned c = xb_ld(&bar[XB_XCNT(j)]); sum += c; cnt += (c > 0u) ? 1u : 0u; mine = (j == x) ? c : mine; }
        if (sum == G) break;
        __builtin_amdgcn_s_sleep(1);
        if ((++sp & 255u) == 0u) { if (xb_ld(&bar[XB_TMO])) break; if (sp > XB_SPIN_CAP) { atomicAdd(&bar[XB_TMO], 1u); break; } }
    }
    nloc = mine > 0u ? mine : 1u; nx = cnt > 0u ? cnt : 1u;
}

__device__ __forceinline__ void xcd_barrier(const XcdBarrier& b) {
    asm volatile("s_waitcnt vmcnt(0)" ::: "memory");
    __syncthreads();
    if (threadIdx.x == 0) {
        unsigned* bar = b.bar;
        __builtin_amdgcn_s_waitcnt(0);
        unsigned nloc = b.st[0], nx = b.st[1];
        if (nloc == 0u) { xcd_barrier_complete(bar, b.x, nloc, nx); b.st[0] = nloc; b.st[1] = nx; }
        const unsigned old = xb_add(&bar[XB_XSUB(b.x)], 1u);
        const unsigned gen = old / nloc;
        if (old + 1u == (gen + 1u) * nloc) {
            __builtin_amdgcn_fence(__ATOMIC_RELEASE, "agent");
            asm volatile("s_waitcnt vmcnt(0)" ::: "memory");
            const unsigned og = xb_add(&bar[XB_TOP], 1u);
            const unsigned tg = og / nx;
            if (og + 1u == (tg + 1u) * nx) xb_add(&bar[XB_TOPGEN], 1u);
            else XB_SPIN(xb_ld(&bar[XB_TOPGEN]) == tg, bar);
            __builtin_amdgcn_fence(__ATOMIC_ACQUIRE, "agent");
            xb_add(&bar[XB_XGEN(b.x)], 1u);
            asm volatile("s_waitcnt vmcnt(0)" ::: "memory");
        } else {
            XB_SPIN(xb_ld(&bar[XB_XGEN(b.x)]) == gen, bar);
            __builtin_amdgcn_fence(__ATOMIC_ACQUIRE, "agent");
            asm volatile("s_waitcnt vmcnt(0)" ::: "memory");
        }
    }
    __syncthreads();
}
constexpr int RING_OFF = 0, RING_BYTES = 160 * 1024 - 256;
constexpr int MISC_OFF = 160 * 1024 - 256;
constexpr int LDS_BYTES = 160 * 1024;
struct Frame {
    LAS unsigned char* lds; volatile LAS unsigned* MISC; gu32* ctl;
    int tid, lane, wave, vcu, G;
    const float *x, *norm_mix, *norm_ffn, *ev_w_in, *ev_conv_w, *ev_w_out, *od_w_in, *od_q_gain, *od_k_gain, *od_w_out, *rel_bias, *w_gate, *w_up, *w_down;
    float* out; float* SS;
    bf16 *W_in0, *W_out0, *W_gu0, *W_dn0, *W_in1, *W_out1, *W_gu1, *W_dn1;
    bf16 *XB, *ATT, *PROJ0, *H, *Q1, *K1, *V1, *QI, *KI; float* WI; unsigned long long* MASK;
};
__device__ __forceinline__ float wave_sum(float v) {
#pragma unroll
    for (int o = 1; o < 64; o <<= 1) v += __shfl_xor(v, o);
    return v;
}
__device__ __forceinline__ float wave_max(float v) {
#pragma unroll
    for (int o = 1; o < 64; o <<= 1) v = fmaxf(v, __shfl_xor(v, o));
    return v;
}
__device__ __forceinline__ void tr_item(const float* W, int ldw, int sc0, int nvalid, const float* gain, int K, bf16* WT, int drow0, LAS float* scr, int kb, int lane) {
    const int k0 = 64 * kb, c = sc0 + (lane & 31); const bool ok = c < nvalid;
    float v[32];
#pragma unroll
    for (int i = 0; i < 32; ++i) v[i] = ok ? W[(size_t)(k0 + 2 * i + (lane >> 5)) * ldw + c] : 0.f;
    const int ch = lane & 7;
    f32x4 g0 = {1.f, 1.f, 1.f, 1.f}, g1 = g0;
    if (gain) { g0 = *(const f32x4*)(gain + k0 + 8 * ch); g1 = *(const f32x4*)(gain + k0 + 8 * ch + 4); }
#pragma unroll
    for (int i = 0; i < 32; ++i) scr[(2 * i + (lane >> 5)) * 33 + (lane & 31)] = v[i];
    LDS_WAIT(); asm volatile("" ::: "memory");
#pragma unroll
    for (int j = 0; j < 4; ++j) { const int n = (lane >> 3) + 8 * j; const LAS float* s = scr + (8 * ch) * 33 + n;
        v4u o; o.x = pk2(s[0 * 33] * g0[0], s[1 * 33] * g0[1]); o.y = pk2(s[2 * 33] * g0[2], s[3 * 33] * g0[3]); o.z = pk2(s[4 * 33] * g1[0], s[5 * 33] * g1[1]); o.w = pk2(s[6 * 33] * g1[2], s[7 * 33] * g1[3]);
        *(GAS v4u*)(WT + (size_t)(drow0 + n) * K + k0 + 8 * ch) = o; }
    LDS_WAIT(); asm volatile("" ::: "memory");
}
constexpr int I_IN0 = 16 * (EVEN_IN / 32), I_OUT = 16 * 32, I_GU = 16 * (GU / 32), I_DN = (FF / 64) * 32, I_IN1 = 16 * (ODD_PAD / 32);
constexpr int N_P0 = I_IN0 + I_OUT;
constexpr int N_EARLY = I_IN0 + I_OUT + I_GU, NITEMS = N_EARLY + I_DN + I_IN1 + I_OUT + I_GU + I_DN;
__device__ __forceinline__ void gu_item(Frame& F, int L, int r, LAS float* scr) { const int nb = GU / 32, kb = r / nb, db = r % nb, pn = db >> 3, j = db & 7;
    const float* W = ((j < 4) ? F.w_gate : F.w_up) + (size_t)L * D * FF;
    tr_item(W, FF, 128 * pn + 32 * (j & 3), FF, F.norm_ffn + L * D, D, L ? F.W_gu1 : F.W_gu0, 32 * db, scr, kb, F.lane); }
__device__ __forceinline__ void weight_item(Frame& F, int r, LAS float* scr) {
    if (r < I_IN0) { const int nb = EVEN_IN / 32, kb = r / nb, db = r % nb; tr_item(F.ev_w_in, EVEN_IN, 32 * db, EVEN_IN, F.norm_mix, D, F.W_in0, 32 * db, scr, kb, F.lane); return; } r -= I_IN0;
    if (r < I_OUT) { const int kb = r / 32, db = r % 32; tr_item(F.ev_w_out, D, 32 * db, D, nullptr, D, F.W_out0, 32 * db, scr, kb, F.lane); return; } r -= I_OUT;
    if (r < I_GU) { gu_item(F, 0, r, scr); return; } r -= I_GU;
    if (r < I_DN) { const int kb = r / 32, db = r % 32; tr_item(F.w_down, D, 32 * db, D, nullptr, FF, F.W_dn0, 32 * db, scr, kb, F.lane); return; } r -= I_DN;
    if (r < I_IN1) { const int nb = ODD_PAD / 32, kb = r / nb, db = r % nb, pn = db >> 3, bj = (db >> 2) & 1, wc = db & 3;
        tr_item(F.od_w_in, ODD_IN, 256 * pn + 64 * wc + 32 * bj, ODD_IN, F.norm_mix + D, D, F.W_in1, 32 * db, scr, kb, F.lane); return; } r -= I_IN1;
    if (r < I_OUT) { const int kb = r / 32, db = r % 32; tr_item(F.od_w_out, D, 32 * db, D, nullptr, D, F.W_out1, 32 * db, scr, kb, F.lane); return; } r -= I_OUT;
    if (r < I_GU) { gu_item(F, 1, r, scr); return; } r -= I_GU;
    { const int kb = r / 32, db = r % 32; tr_item(F.w_down + (size_t)FF * D, D, 32 * db, D, nullptr, FF, F.W_dn1, 32 * db, scr, kb, F.lane); }
}
constexpr int N_MID = N_EARLY + I_DN + I_IN1 + I_OUT;
__device__ __forceinline__ void late_weights(Frame& F, int lo_it, int hi_it) {
    if (F.G != 256 || (int)blockIdx.x < 128) return;
    LAS float* scr = (LAS float*)(F.lds + RING_OFF + F.wave * 16384);
    for (int it = lo_it + ((int)blockIdx.x - 128) * NWAVES + F.wave; it < hi_it; it += 128 * NWAVES) weight_item(F, it, scr);
}
__device__ __forceinline__ void p2_weights(Frame& F) {
    if (F.G != 256) return;
    LAS float* scr = (LAS float*)(F.lds + RING_OFF + F.wave * 16384);
    for (int it = N_P0 + F.vcu * NWAVES + F.wave; it < N_EARLY; it += F.G * NWAVES) weight_item(F, it, scr);
}
__device__ __forceinline__ void p0_prologue(Frame& F) {
    LAS float* scr = (LAS float*)(F.lds + RING_OFF + F.wave * 16384);
    const int gw = F.vcu * NWAVES + F.wave, NGW = F.G * NWAVES;
    const int nit = (F.G == 256) ? N_P0 : NITEMS;
    for (int it = gw; it < nit; it += NGW) weight_item(F, it, scr);
    for (int m = gw; m < M; m += 2 * NGW) {
        const int m2 = m + NGW; const bool has2 = m2 < M;
        const GAS f32x4* xa = (const GAS f32x4*)(F.x + (size_t)m * D) + F.lane; const GAS f32x4* xb = (const GAS f32x4*)(F.x + (size_t)(has2 ? m2 : m) * D) + F.lane;
        f32x4 va[4], vb[4];
#pragma unroll
        for (int j = 0; j < 4; ++j) { va[j] = xa[64 * j]; vb[j] = xb[64 * j]; }
        GAS unsigned long long* oa = (GAS unsigned long long*)(F.XB + (size_t)m * D) + F.lane; GAS unsigned long long* ob = (GAS unsigned long long*)(F.XB + (size_t)m2 * D) + F.lane; float sa = 0.f, sb = 0.f;
#pragma unroll
        for (int j = 0; j < 4; ++j) { const f32x4 a = va[j], c = vb[j]; sa += (a.x * a.x + a.y * a.y) + (a.z * a.z + a.w * a.w); sb += (c.x * c.x + c.y * c.y) + (c.z * c.z + c.w * c.w);
            oa[64 * j] = (unsigned long long)pk2(a.x, a.y) | ((unsigned long long)pk2(a.z, a.w) << 32); if (has2) ob[64 * j] = (unsigned long long)pk2(c.x, c.y) | ((unsigned long long)pk2(c.z, c.w) << 32); }
        sa = wave_sum(sa); sb = wave_sum(sb); if (F.lane == 0) { F.SS[m] = sa; if (has2) F.SS[m2] = sb; }
    }
}
__device__ __forceinline__ void ld8(const bf16* p, float (&f)[8]) { const v4u w = *(const v4u*)p; f[0] = bflo(w.x); f[1] = bfhi(w.x); f[2] = bflo(w.y); f[3] = bfhi(w.y); f[4] = bflo(w.z); f[5] = bfhi(w.z); f[6] = bflo(w.w); f[7] = bfhi(w.w); }
__device__ __forceinline__ int rel_bucket(int dist) { if (dist < 16) return dist; const int l = 16 + (int)(logf((float)dist * (1.0f / 16.0f)) / logf(8.0f) * 16.0f); return l < 31 ? l : 31; }
__device__ __forceinline__ unsigned ord_key(float f) { unsigned u = __builtin_bit_cast(unsigned, f); if (u == 0x80000000u) u = 0u; return (u & 0x80000000u) ? ~u : (u | 0x80000000u); }
__device__ __forceinline__ void conv_part(Frame& F) {
    const int gt = (F.vcu * NWAVES + F.wave) * 64 + F.lane, NT = F.G * NWAVES * 64;
    for (int it = gt; it < M * 64; it += NT) { const int row = it >> 6, c8 = (it & 63) * 8, t = row & (S - 1);
        float bg[8], y[8]; ld8(F.PROJ0 + (size_t)row * EVEN_IN + 1536 + c8, bg);
#pragma unroll
        for (int i = 0; i < 8; ++i) y[i] = 0.f;
#pragma unroll
        for (int j = 0; j < 3; ++j) { if (t - 2 + j >= 0) { float cg[8], uu[8]; const bf16* p = F.PROJ0 + (size_t)(row - 2 + j) * EVEN_IN; ld8(p + 2048 + c8, cg); ld8(p + 2560 + c8, uu);
#pragma unroll
                for (int i = 0; i < 8; ++i) y[i] += F.ev_conv_w[j * 512 + c8 + i] * (cg[i] * uu[i]); } }
        v4u o; o.x = pk2(bg[0] * y[0], bg[1] * y[1]); o.y = pk2(bg[2] * y[2], bg[3] * y[3]); o.z = pk2(bg[4] * y[4], bg[5] * y[5]); o.w = pk2(bg[6] * y[6], bg[7] * y[7]);
        *(v4u*)(F.ATT + (size_t)row * D + 512 + c8) = o; }
}
__device__ __forceinline__ void sb_naive(Frame& F) {
    const int gw = F.vcu * NWAVES + F.wave, NGW = F.G * NWAVES;
    for (int idx = gw; idx < M * 8; idx += NGW) { const int h = idx & 7, row = idx >> 3, t = row & (S - 1);
        const float qd = bf2f(F.PROJ0[(size_t)row * EVEN_IN + h * 64 + F.lane]); float o = 0.f, carry = 1.f;
        for (int s = t - 1; s >= 0; --s) { const bf16* p = F.PROJ0 + (size_t)(row - t + s) * EVEN_IN + h * 64 + F.lane;
            const float z2 = wave_sum(qd * bf2f(p[512])), e = __builtin_amdgcn_exp2f(z2), a = __builtin_amdgcn_rcpf(1.0f + e), beta = 1.0f - a;
            o += beta * carry * bf2f(p[1024]); carry *= a; if (carry < 7.8886091e-31f) break; }
        F.ATT[(size_t)row * D + h * 64 + F.lane] = (bf16)f2bf(o); }
}
#define TK_CNT8(ACC, B, OP, X) do { unsigned long long q0 = __ballot(key[(B) + 0] OP (X)), q1 = __ballot(key[(B) + 1] OP (X)), q2 = __ballot(key[(B) + 2] OP (X)), q3 = __ballot(key[(B) + 3] OP (X)), \
        q4 = __ballot(key[(B) + 4] OP (X)), q5 = __ballot(key[(B) + 5] OP (X)), q6 = __ballot(key[(B) + 6] OP (X)), q7 = __ballot(key[(B) + 7] OP (X)); \
        asm volatile("" : "+s"(q0), "+s"(q1), "+s"(q2), "+s"(q3), "+s"(q4), "+s"(q5), "+s"(q6), "+s"(q7)); \
        ACC += (__popcll(q0) + __popcll(q1)) + (__popcll(q2) + __popcll(q3)) + (__popcll(q4) + __popcll(q5)) + (__popcll(q6) + __popcll(q7)); } while (0)
#define tk_put(lo, hi, w, i) do { const unsigned long long w_ = (w); if (lane == (i)) { lo = (unsigned)w_; hi = (unsigned)(w_ >> 32); } } while (0)
__device__ __forceinline__ void topk_row(const LAS float* sc, int n, unsigned long long* mrow, int lane) {
    unsigned wlo = 0u, whi = 0u;
    if (n <= TOPK) {
#pragma unroll
        for (int i = 0; i < 4; ++i) tk_put(wlo, whi, __ballot(64 * i + lane < n), i);
    } else {
        unsigned key[32];
        const int noct = (n + 511) >> 9;
#pragma unroll
        for (int c = 0; c < 4; ++c) {
            if (c < noct) {
#pragma unroll
                for (int i = 8 * c; i < 8 * c + 8; ++i) { const float f = sc[64 * i + lane]; key[i] = (64 * i + lane < n) ? ord_key(f) : 0u; }
            } else {
#pragma unroll
                for (int i = 8 * c; i < 8 * c + 8; ++i) key[i] = 0u; } }
        unsigned prefix = 0u; bool exact = false;
        for (int bit = 31; bit >= 0; --bit) { const unsigned cand = prefix | (1u << bit); int lc = 0;
#pragma unroll
            for (int i = 0; i < 8; ++i) lc += (key[i] >= cand) ? 1 : 0;
            if (noct > 1) {
#pragma unroll
                for (int i = 8; i < 16; ++i) lc += (key[i] >= cand) ? 1 : 0; }
            if (noct > 2) {
#pragma unroll
                for (int i = 16; i < 24; ++i) lc += (key[i] >= cand) ? 1 : 0; }
            if (noct > 3) {
#pragma unroll
                for (int i = 24; i < 32; ++i) lc += (key[i] >= cand) ? 1 : 0; }
            lc += __builtin_amdgcn_update_dpp(0, lc, 0xB1, 0xf, 0xf, true); lc += __builtin_amdgcn_update_dpp(0, lc, 0x4E, 0xf, 0xf, true);
            lc += __builtin_amdgcn_update_dpp(0, lc, 0x141, 0xf, 0xf, true); lc += __builtin_amdgcn_update_dpp(0, lc, 0x140, 0xf, 0xf, true);
            const int cnt = (__builtin_amdgcn_readlane(lc, 0) + __builtin_amdgcn_readlane(lc, 16)) + (__builtin_amdgcn_readlane(lc, 32) + __builtin_amdgcn_readlane(lc, 48));
            if (cnt >= TOPK) { prefix = cand; if (cnt == TOPK) { exact = true; break; } } }
        if (exact) {
#pragma unroll
            for (int c = 0; c < 4; ++c) { if (c < noct) {
#pragma unroll
                for (int i = 8 * c; i < 8 * c + 8; ++i) tk_put(wlo, whi, __ballot(key[i] >= prefix), i); } }
        } else {
            int gt = 0;
            TK_CNT8(gt, 0, >, prefix); TK_CNT8(gt, 8, >, prefix); TK_CNT8(gt, 16, >, prefix); TK_CNT8(gt, 24, >, prefix);
            const int need = TOPK - gt; int base = 0; const unsigned long long lt = (1ull << lane) - 1ull;
#pragma unroll
            for (int i = 0; i < 32; ++i) { const bool eq = key[i] == prefix; const unsigned long long be = __ballot(eq); const int rank = base + __popcll(be & lt); base += __popcll(be);
                tk_put(wlo, whi, __ballot(key[i] > prefix || (eq && rank < need)), i); }
        }
    }
    if (lane < 32) mrow[lane] = ((unsigned long long)whi << 32) | wlo;
}
#define TK_LOADKEYS(KEY, SC, N) do { _Pragma("unroll") for (int c = 0; c < 4; ++c) { if (c < noct) { _Pragma("unroll") for (int i = 8 * c; i < 8 * c + 8; ++i) { const float f = (SC)[64 * i + lane]; KEY[i] = (64 * i + lane < (N)) ? ord_key(f) : 0u; } } \
        else { _Pragma("unroll") for (int i = 8 * c; i < 8 * c + 8; ++i) KEY[i] = 0u; } } } while (0)
#define TK_FINAL(KEY, PREFIX, EXACT, MROW) do { unsigned wlo = 0u, whi = 0u; \
        if (EXACT) { _Pragma("unroll") for (int c = 0; c < 4; ++c) { if (c < noct) { _Pragma("unroll") for (int i = 8 * c; i < 8 * c + 8; ++i) tk_put(wlo, whi, __ballot(KEY[i] >= (PREFIX)), i); } } } \
        else { const unsigned* key = KEY; int gt = 0; TK_CNT8(gt, 0, >, (PREFIX)); TK_CNT8(gt, 8, >, (PREFIX)); TK_CNT8(gt, 16, >, (PREFIX)); TK_CNT8(gt, 24, >, (PREFIX)); \
            const int need = TOPK - gt; int base = 0; const unsigned long long lt = (1ull << lane) - 1ull; \
            _Pragma("unroll") for (int i = 0; i < 32; ++i) { const bool eq = KEY[i] == (PREFIX); const unsigned long long be = __ballot(eq); const int rank = base + __popcll(be & lt); base += __popcll(be); \
                tk_put(wlo, whi, __ballot(KEY[i] > (PREFIX) || (eq && rank < need)), i); } } \
        if (lane < 32) (MROW)[lane] = ((unsigned long long)whi << 32) | wlo; } while (0)
#define TK_WSUM(X) do { X += __builtin_amdgcn_update_dpp(0, X, 0xB1, 0xf, 0xf, true); X += __builtin_amdgcn_update_dpp(0, X, 0x4E, 0xf, 0xf, true); \
        X += __builtin_amdgcn_update_dpp(0, X, 0x141, 0xf, 0xf, true); X += __builtin_amdgcn_update_dpp(0, X, 0x140, 0xf, 0xf, true); } while (0)
__device__ __forceinline__ unsigned pk_lt1(unsigned candp, unsigned x, unsigned one) { unsigned d, t; asm("v_pk_sub_u16 %0, %1, %2 clamp" : "=v"(d) : "v"(candp), "v"(x)); asm("v_pk_min_u16 %0, %1, %2" : "=v"(t) : "v"(d), "v"(one)); return t; }
__device__ __forceinline__ unsigned pk_add16(unsigned a, unsigned b2) { unsigned r; asm("v_pk_add_u16 %0, %1, %2" : "=v"(r) : "v"(a), "v"(b2)); return r; }
__device__ __forceinline__ unsigned pk_mul16(unsigned a, unsigned b2) { unsigned r; asm("v_pk_mul_lo_u16 %0, %1, %2" : "=v"(r) : "v"(a), "v"(b2)); return r; }
#define TK_PKCOUNT(PA, PB, CA, CB, CNTA, CNTB) do { const unsigned cpa_ = (CA) * 0x10001u, cpb_ = (CB) * 0x10001u; unsigned a0_ = 0u, a1_ = 0u, b0_ = 0u, b1_ = 0u; \
        _Pragma("unroll") for (int c_ = 0; c_ < 4; ++c_) { if (c_ < noct) { \
            a0_ = pk_add16(a0_, pk_lt1(cpa_, PA[4 * c_], one)); b0_ = pk_add16(b0_, pk_lt1(cpb_, PB[4 * c_], one)); a1_ = pk_add16(a1_, pk_lt1(cpa_, PA[4 * c_ + 1], one)); b1_ = pk_add16(b1_, pk_lt1(cpb_, PB[4 * c_ + 1], one)); \
            a0_ = pk_add16(a0_, pk_lt1(cpa_, PA[4 * c_ + 2], one)); b0_ = pk_add16(b0_, pk_lt1(cpb_, PB[4 * c_ + 2], one)); a1_ = pk_add16(a1_, pk_lt1(cpa_, PA[4 * c_ + 3], one)); b1_ = pk_add16(b1_, pk_lt1(cpb_, PB[4 * c_ + 3], one)); } } \
        a0_ = pk_add16(a0_, a1_); b0_ = pk_add16(b0_, b1_); int la_ = (int)((a0_ & 0xffffu) + (a0_ >> 16)), lb_ = (int)((b0_ & 0xffffu) + (b0_ >> 16)); TK_WSUM(la_); TK_WSUM(lb_); \
        CNTA = 512 * noct - ((__builtin_amdgcn_readlane(la_, 0) + __builtin_amdgcn_readlane(la_, 16)) + (__builtin_amdgcn_readlane(la_, 32) + __builtin_amdgcn_readlane(la_, 48))); \
        CNTB = 512 * noct - ((__builtin_amdgcn_readlane(lb_, 0) + __builtin_amdgcn_readlane(lb_, 16)) + (__builtin_amdgcn_readlane(lb_, 32) + __builtin_amdgcn_readlane(lb_, 48))); } while (0)
__device__ __forceinline__ void topk_pair(const LAS float* scA, int nA, unsigned long long* mrowA, const LAS float* scB, int nB, unsigned long long* mrowB, int lane) {
    if (nB <= TOPK) { topk_row(scA, nA, mrowA, lane); topk_row(scB, nB, mrowB, lane); return; }
    const int noct = (nB + 511) >> 9;
    unsigned keyA[32], keyB[32];
    TK_LOADKEYS(keyA, scA, nA); TK_LOADKEYS(keyB, scB, nB);
    const unsigned one = 0x00010001u;
    unsigned PA[16], PB[16];
#pragma unroll
    for (int j = 0; j < 16; ++j) { PA[j] = (keyA[2 * j] >> 16) | (keyA[2 * j + 1] & 0xffff0000u); PB[j] = (keyB[2 * j] >> 16) | (keyB[2 * j + 1] & 0xffff0000u); }
    unsigned hA = 0u, hB = 0u, prefA = 0u, prefB = 0u; bool exA = false, exB = false, doneA = false, doneB = false;
    for (int bit = 15; bit >= 0; --bit) { const unsigned candA = hA | (1u << bit), candB = hB | (1u << bit); int cntA, cntB;
        TK_PKCOUNT(PA, PB, candA, candB, cntA, cntB);
        if (!doneA && cntA >= TOPK) { hA = candA; if (cntA == TOPK) { exA = true; doneA = true; prefA = candA << 16; } }
        if (!doneB && cntB >= TOPK) { hB = candB; if (cntB == TOPK) { exB = true; doneB = true; prefB = candB << 16; } }
        if (doneA && doneB) break; }
    if (!(doneA && doneB)) {
        { const unsigned ppa = hA * 0x10001u, ppb = hB * 0x10001u;
#pragma unroll
          for (int j = 0; j < 16; ++j) { unsigned gt_, lt_, lo_;
              { unsigned d_; asm("v_pk_sub_u16 %0, %1, %2 clamp" : "=v"(d_) : "v"(PA[j]), "v"(ppa)); asm("v_pk_min_u16 %0, %1, %2" : "=v"(gt_) : "v"(d_), "v"(one)); } lt_ = pk_lt1(ppa, PA[j], one);
              lo_ = (keyA[2 * j] & 0xffffu) | (keyA[2 * j + 1] << 16); PA[j] = (lo_ | pk_mul16(gt_, 0xffffffffu)) & ~pk_mul16(lt_, 0xffffffffu);
              { unsigned d_; asm("v_pk_sub_u16 %0, %1, %2 clamp" : "=v"(d_) : "v"(PB[j]), "v"(ppb)); asm("v_pk_min_u16 %0, %1, %2" : "=v"(gt_) : "v"(d_), "v"(one)); } lt_ = pk_lt1(ppb, PB[j], one);
              lo_ = (keyB[2 * j] & 0xffffu) | (keyB[2 * j + 1] << 16); PB[j] = (lo_ | pk_mul16(gt_, 0xffffffffu)) & ~pk_mul16(lt_, 0xffffffffu); } }
        unsigned lA = 0u, lB = 0u;
        for (int bit = 15; bit >= 0; --bit) { const unsigned candA = lA | (1u << bit), candB = lB | (1u << bit); int cntA, cntB;
            TK_PKCOUNT(PA, PB, candA, candB, cntA, cntB);
            if (!doneA && cntA >= TOPK) { lA = candA; if (cntA == TOPK) { exA = true; doneA = true; prefA = (hA << 16) | candA; } }
            if (!doneB && cntB >= TOPK) { lB = candB; if (cntB == TOPK) { exB = true; doneB = true; prefB = (hB << 16) | candB; } }
            if (doneA && doneB) break; }
        if (!doneA) prefA = (hA << 16) | lA;
        if (!doneB) prefB = (hB << 16) | lB;
    }
    TK_FINAL(keyA, prefA, exA, mrowA); TK_FINAL(keyB, prefB, exB, mrowB);
}
#undef TK_PKCOUNT
#undef TK_LOADKEYS
#undef TK_FINAL
#undef TK_WSUM
__device__ __forceinline__ void idx_naive(Frame& F) {
    LAS float* qs = (LAS float*)(F.lds + RING_OFF);
    LAS float* ws = qs + 512;
    LAS float* sc = qs + 1024;
    for (int row = blockIdx.x; row < M; row += F.G) { const int t = row & (S - 1), n = t + 1;
        if (n > TOPK) {
            qs[F.tid] = bf2f(F.QI[(size_t)row * 512 + F.tid]); if (F.tid < 8) ws[F.tid] = F.WI[(size_t)row * 8 + F.tid] * (0.125f * 0.35355339059327373f);
            __syncthreads();
            for (int s = F.tid; s < n; s += NWAVES * 64) { asm volatile("" ::: "memory"); const bf16* kp = F.KI + (size_t)(row - t + s) * 64; float kf[64];
#pragma unroll
                for (int c = 0; c < 8; ++c) { float f[8]; ld8(kp + 8 * c, f);
#pragma unroll
                    for (int i = 0; i < 8; ++i) kf[8 * c + i] = f[i]; }
                float acc = 0.f;
#pragma unroll
                for (int h = 0; h < 8; ++h) { float d = 0.f;
#pragma unroll
                    for (int i = 0; i < 64; ++i) d += qs[h * 64 + i] * kf[i];
                    acc += ws[h] * fmaxf(d, 0.f); }
                sc[s] = acc; }
            __syncthreads();
        }
        if (F.wave == 0) topk_row(sc, n, F.MASK + (size_t)row * 32, F.lane);
        __syncthreads();
    }
}
__device__ __forceinline__ void dsa_naive(Frame& F) {
    LAS int* idx = (LAS int*)(F.lds + RING_OFF);
    LAS float* qf = (LAS float*)(F.lds + RING_OFF + 1024);
    LAS float* pl = (LAS float*)(F.lds + RING_OFF + 8192) + F.wave * 256;
    LAS int* cntp = (LAS int*)(F.lds + RING_OFF + 6144);
    for (int row = blockIdx.x; row < M; row += F.G) { const int t = row & (S - 1);
        for (int i = F.tid; i < 1024; i += NWAVES * 64) qf[i] = bf2f(F.Q1[(size_t)row * 1024 + i]);
        if (F.wave == 0) { int base = 0; const unsigned long long lt = (1ull << F.lane) - 1ull;
            for (int w = 0; w < 32; ++w) { const unsigned long long word = F.MASK[(size_t)row * 32 + w]; if ((word >> F.lane) & 1ull) idx[base + __popcll(word & lt)] = 64 * w + F.lane; base += __popcll(word); }
            if (F.lane == 0) cntp[0] = base; }
        __syncthreads();
        const int cnt = cntp[0];
        for (int hd = F.wave; hd < 16; hd += NWAVES) { const int g = hd >> 2; float lg[4]; float mx = -INFINITY;
#pragma unroll
            for (int j = 0; j < 4; ++j) { asm volatile("" ::: "memory"); const int ki = j * 64 + F.lane; lg[j] = -INFINITY;
                if (ki < cnt) { const int s = idx[ki]; const bf16* kp = F.K1 + (size_t)(row - t + s) * 256 + g * 64; float d = 0.f;
#pragma unroll
                    for (int c = 0; c < 8; ++c) { float f[8]; ld8(kp + 8 * c, f);
#pragma unroll
                        for (int i = 0; i < 8; ++i) d += qf[hd * 64 + 8 * c + i] * f[i]; }
                    lg[j] = d + F.rel_bias[rel_bucket(t - s) * 16 + hd] * 1.4426950408889634f; }
                mx = fmaxf(mx, lg[j]); }
            mx = wave_max(mx); float l = 0.f;
#pragma unroll
            for (int j = 0; j < 4; ++j) { const float p = __builtin_amdgcn_exp2f(lg[j] - mx); l += p; pl[j * 64 + F.lane] = p; }
            l = wave_sum(l); LDS_WAIT(); asm volatile("" ::: "memory");
            float o = 0.f;
            for (int i = 0; i < cnt; ++i) o += pl[i] * bf2f(F.V1[(size_t)(row - t + idx[i]) * 256 + g * 64 + F.lane]);
            F.ATT[(size_t)row * D + hd * 64 + F.lane] = (bf16)f2bf(o / l);
            LDS_WAIT(); asm volatile("" ::: "memory"); }
        __syncthreads();
    }
}
typedef float f32x16 __attribute__((ext_vector_type(16)));
typedef short s16x4 __attribute__((ext_vector_type(4)));
typedef float f32x2_t __attribute__((ext_vector_type(2))); typedef __bf16 bf16x2_t __attribute__((ext_vector_type(2)));
__device__ __forceinline__ unsigned cvtpk(float lo, float hi) { f32x2_t v = {lo, hi}; bf16x2_t b = __builtin_convertvector(v, bf16x2_t); return __builtin_bit_cast(unsigned, b); }
__device__ __forceinline__ s16x4 vtr(const LAS unsigned char* p) { return __builtin_bit_cast(s16x4, __builtin_amdgcn_ds_read_tr16_b64_v4i16((LAS s16x4*)p)); }
__device__ __forceinline__ void load_kfrags(bf16x8 (&kf)[2][4], const bf16* kb, size_t pitch) {
#pragma unroll
    for (int kh = 0; kh < 2; ++kh)
#pragma unroll
        for (int d0 = 0; d0 < 4; ++d0) kf[kh][d0] = *(const bf16x8*)(kb + (size_t)kh * 32 * pitch + d0 * 16);
}
__device__ __forceinline__ void load_vpieces(v4u (&vv)[8], const bf16* vbase, size_t pitch, int lane) {
#pragma unroll
    for (int p = 0; p < 8; ++p) vv[p] = *(const v4u*)(vbase + (size_t)(16 * (p & 3) + (lane >> 2)) * pitch + 32 * (p >> 2) + (lane & 3) * 8);
}
__device__ __forceinline__ void store_vpieces(LAS unsigned char* vl, const v4u (&vv)[8], int lane) {
#pragma unroll
    for (int p = 0; p < 8; ++p) *(LAS v4u*)(vl + p * 1024 + lane * 16) = vv[p];
}
__device__ __forceinline__ void pv_mma(f32x16& o0, f32x16& o1, const LAS unsigned char* vb, const f32x16& p0, const f32x16& p1) {
    bf16x8 pa[4];
#pragma unroll
    for (int ks = 0; ks < 4; ++ks) { const f32x16& P = (ks < 2) ? p0 : p1; const int b = (ks & 1) * 8; v4u w; w.x = cvtpk(P[b], P[b + 1]); w.y = cvtpk(P[b + 2], P[b + 3]); w.z = cvtpk(P[b + 4], P[b + 5]); w.w = cvtpk(P[b + 6], P[b + 7]); pa[ks] = __builtin_bit_cast(bf16x8, w); }
#pragma unroll
    for (int ks = 0; ks < 4; ++ks) {
        const s16x4 l0 = vtr(vb + ks * 1024), h0 = vtr(vb + ks * 1024 + 512), l1 = vtr(vb + 4096 + ks * 1024), h1 = vtr(vb + 4096 + ks * 1024 + 512);
        o0 = __builtin_amdgcn_mfma_f32_32x32x16_bf16(pa[ks], (bf16x8){l0[0], l0[1], l0[2], l0[3], h0[0], h0[1], h0[2], h0[3]}, o0, 0, 0, 0);
        o1 = __builtin_amdgcn_mfma_f32_32x32x16_bf16(pa[ks], (bf16x8){l1[0], l1[1], l1[2], l1[3], h1[0], h1[1], h1[2], h1[3]}, o1, 0, 0, 0); }
}
__device__ __forceinline__ void store_o(LAS unsigned char* stg, const f32x16& o0, const f32x16& o1, const float (&sc)[16], bf16* dst, size_t pitch, int lane) {
    const int r32 = lane & 31, hi = lane >> 5; LAS unsigned short* s16 = (LAS unsigned short*)stg;
#pragma unroll
    for (int r = 0; r < 16; ++r) { const int orow = (r & 3) + 8 * (r >> 2) + 4 * hi; s16[orow * 64 + r32] = (unsigned short)f2bf(o0[r] * sc[r]); s16[orow * 64 + 32 + r32] = (unsigned short)f2bf(o1[r] * sc[r]); }
    LDS_WAIT(); asm volatile("" ::: "memory");
#pragma unroll
    for (int i = 0; i < 4; ++i) { const int row = i * 8 + (lane >> 3), ch = lane & 7; const v4u v = *(const LAS v4u*)(stg + row * 128 + ch * 16); *(v4u*)(dst + (size_t)row * pitch + ch * 8) = v; }
    LDS_WAIT(); asm volatile("" ::: "memory");
}
constexpr int MIX_WAVE_LDS = 12544;
__device__ __forceinline__ void sb_fast(Frame& F) {
    const int lane = F.lane, r32 = lane & 31, hi = lane >> 5;
    LAS unsigned char* vl = F.lds + RING_OFF + F.wave * MIX_WAVE_LDS; LAS unsigned char* stg = vl + 8192;
    const LAS unsigned char* vb = vl + ((lane >> 4) & 1) * 32 + (lane & 3) * 8 + (4 * hi + ((lane & 15) >> 2)) * 64;
    const int gw = F.vcu * NWAVES + F.wave, NGW = F.G * NWAVES;
    for (int u = gw; u < BATCH * 8 * 64; u += NGW) {
        const int qb = u & 63, h = (u >> 6) & 7, b = u >> 9, q0 = qb * 32; const size_t rowbase = (size_t)b * S;
        const bf16* Pq = F.PROJ0 + (rowbase + q0 + r32) * EVEN_IN + h * 64 + hi * 8;
        bf16x8 qr[4];
#pragma unroll
        for (int d0 = 0; d0 < 4; ++d0) qr[d0] = *(const bf16x8*)(Pq + d0 * 16);
        f32x16 o0 = {}, o1 = {}; float C = 1.f; const int ktmax = (q0 + 30) >> 6, qpos = q0 + r32;
        for (int kt = ktmax; kt >= 0; --kt) {
            bf16x8 kf[2][4]; v4u vv[8];
            load_kfrags(kf, F.PROJ0 + (rowbase + 64 * kt + r32) * EVEN_IN + 512 + h * 64 + hi * 8, EVEN_IN);
            load_vpieces(vv, F.PROJ0 + (rowbase + 64 * kt) * EVEN_IN + 1024 + h * 64, EVEN_IN, lane);
            f32x16 p0 = {}, p1 = {};
#pragma unroll
            for (int d0 = 0; d0 < 4; ++d0) { p0 = __builtin_amdgcn_mfma_f32_32x32x16_bf16(kf[0][d0], qr[d0], p0, 0, 0, 0); p1 = __builtin_amdgcn_mfma_f32_32x32x16_bf16(kf[1][d0], qr[d0], p1, 0, 0, 0); }
            store_vpieces(vl, vv, lane);
#pragma unroll
            for (int r = 0; r < 16; ++r) { p0[r] = __builtin_amdgcn_rcpf(1.0f + __builtin_amdgcn_exp2f(p0[r])); p1[r] = __builtin_amdgcn_rcpf(1.0f + __builtin_amdgcn_exp2f(p1[r])); }
            if (kt == ktmax) {
                const int kb = 64 * kt + 4 * hi;
#pragma unroll
                for (int r = 0; r < 16; ++r) { const int key = kb + (r & 3) + 8 * (r >> 2); if (key >= qpos) p0[r] = 1.0f; if (key + 32 >= qpos) p1[r] = 1.0f; }
            }
            float TL[8], TU[8];
#pragma unroll
            for (int blk = 0; blk < 8; ++blk) { const f32x16& P = (blk < 4) ? p0 : p1; const int c = (blk & 3) * 4; const float T = (P[c] * P[c + 1]) * (P[c + 2] * P[c + 3]);
                auto rr = __builtin_amdgcn_permlane32_swap(__float_as_uint(T), __float_as_uint(T), false, false); TL[blk] = __uint_as_float(rr[0]); TU[blk] = __uint_as_float(rr[1]); }
#pragma unroll
            for (int blk = 7; blk >= 0; --blk) { f32x16& P = (blk < 4) ? p0 : p1; const int c = (blk & 3) * 4;
                const float cu = C * TU[blk]; float s = hi ? C : cu; C = cu * TL[blk];
                const float a3 = P[c + 3], a2 = P[c + 2], a1 = P[c + 1], a0 = P[c];
                P[c + 3] = (1.0f - a3) * s; s *= a3; P[c + 2] = (1.0f - a2) * s; s *= a2; P[c + 1] = (1.0f - a1) * s; s *= a1; P[c] = (1.0f - a0) * s; }
            pv_mma(o0, o1, vb, p0, p1);
            if (__all(C < 7.8886091e-31f)) break;
        }
        float one[16];
#pragma unroll
        for (int r = 0; r < 16; ++r) one[r] = 1.0f;
        store_o(stg, o0, o1, one, F.ATT + (rowbase + q0) * D + h * 64, D, lane);
    }
}
constexpr int SC_PITCH = 2052;
template <int PMODE> __device__ __forceinline__ void idx_fast(Frame& F, unsigned long long* MOUT) {
    const int lane = F.lane, c16 = lane & 15, kq = lane >> 4;
    LAS float* scb = (LAS float*)(F.lds + RING_OFF);
    const int cb = (int)blockIdx.x, s6 = cb & 63;
    const int pitA = 16 * (s6 + 1) + 4, pitB = 16 * (128 - s6) + 4;
    LAS float* scA = scb; LAS float* scB = scb + 16 * pitA;
    for (int pi = 0; pi < 2; ++pi) {
        const int b = 2 * ((cb >> 6) & 3) + pi; const size_t rowbase = (size_t)b * S;
        if (PMODE != 2) {
#pragma unroll 1
            for (int un = 0; un < 2; ++un) {
                const int qb = un ? 127 - s6 : s6, q0 = qb * 16; LAS float* sc = un ? scB : scA; const int pit = un ? pitB : pitA;
                if (q0 + 16 <= TOPK) continue;
                const int w0 = un ? ((F.wave - (s6 + 1)) & 7) : F.wave;
                if (w0 > qb) continue;
                bf16x8 bq[8][2]; float w[8];
#pragma unroll
                for (int h = 0; h < 8; ++h) { const bf16* qp = F.QI + (rowbase + q0 + c16) * 512 + h * 64 + 8 * kq; bq[h][0] = *(const bf16x8*)qp; bq[h][1] = *(const bf16x8*)(qp + 32);
                    w[h] = F.WI[(rowbase + q0 + c16) * 8 + h] * (0.125f * 0.35355339059327373f); }
                const bf16* kp0 = F.KI + (rowbase + c16) * 64 + 8 * kq;
                bf16x8 na0 = *(const bf16x8*)(kp0 + (size_t)(16 * w0) * 64), na1 = *(const bf16x8*)(kp0 + (size_t)(16 * w0) * 64 + 32);
                for (int j = w0; j <= qb; j += NWAVES) {
                    const bf16x8 a0 = na0, a1 = na1;
                    { const int jn = (j + NWAVES <= qb) ? j + NWAVES : j; na0 = *(const bf16x8*)(kp0 + (size_t)(16 * jn) * 64); na1 = *(const bf16x8*)(kp0 + (size_t)(16 * jn) * 64 + 32); }
                    f32x4 s4 = {0.f, 0.f, 0.f, 0.f}, dd[8];
#pragma unroll
                    for (int h = 0; h < 8; ++h) { const f32x4 z = {0.f, 0.f, 0.f, 0.f}; dd[h] = __builtin_amdgcn_mfma_f32_16x16x32_bf16(a0, bq[h][0], z, 0, 0, 0); }
#pragma unroll
                    for (int h = 0; h < 8; ++h) dd[h] = __builtin_amdgcn_mfma_f32_16x16x32_bf16(a1, bq[h][1], dd[h], 0, 0, 0);
                    __builtin_amdgcn_sched_barrier(0);
#pragma unroll
                    for (int h = 0; h < 8; ++h)
#pragma unroll
                        for (int i = 0; i < 4; ++i) s4[i] += w[h] * __builtin_amdgcn_fmed3f(dd[h][i], 0.f, __builtin_inff());
                    *(LAS f32x4*)(sc + c16 * pit + 16 * j + 4 * kq) = s4; }
            }
        }
        __syncthreads();
        if (PMODE != 1) {
            { const int q0 = s6 * 16; topk_pair(scA + F.wave * pitA, q0 + F.wave + 1, MOUT + (rowbase + q0 + F.wave) * 32, scA + (F.wave + 8) * pitA, q0 + F.wave + 9, MOUT + (rowbase + q0 + F.wave + 8) * 32, lane); }
            { const int q0 = (127 - s6) * 16; topk_pair(scB + F.wave * pitB, q0 + F.wave + 1, MOUT + (rowbase + q0 + F.wave) * 32, scB + (F.wave + 8) * pitB, q0 + F.wave + 9, MOUT + (rowbase + q0 + F.wave + 8) * 32, lane); }
        }
        __syncthreads();
    }
}
__device__ __forceinline__ void dsa_fast(Frame& F) {
    const int lane = F.lane, r32 = lane & 31, hi = lane >> 5;
    LAS unsigned char* vl = F.lds + RING_OFF + F.wave * MIX_WAVE_LDS; LAS unsigned char* stg = vl + 8192; LAS float* wsf = (LAS float*)(vl + 12288);
    LAS float* tb = (LAS float*)(F.lds + RING_OFF + NWAVES * MIX_WAVE_LDS);
    const LAS unsigned char* vb = vl + ((lane >> 4) & 1) * 32 + (lane & 3) * 8 + (4 * hi + ((lane & 15) >> 2)) * 64;
    { float mq = fabsf(F.od_q_gain[lane]), mk = fabsf(F.od_k_gain[lane]), mb = 0.f;
#pragma unroll
      for (int i = 0; i < 8; ++i) mb = fmaxf(mb, fabsf(F.rel_bias[64 * i + lane]));
      mq = wave_max(mq); mk = wave_max(mk); mb = wave_max(mb);
      const float shift2 = (8.0f * mq * mk + mb) * 1.4426950408889634f;
      for (int i = F.tid; i < 2048; i += NWAVES * 64) tb[i] = F.rel_bias[rel_bucket(i & 127) * 16 + (i >> 7)] * 1.4426950408889634f - shift2; }
    __syncthreads();
    const int v = F.vcu, hd = 8 * (v & 1) + F.wave, g = hd >> 2, s4 = (v >> 1) & 15, b = v >> 5; const size_t rowbase = (size_t)b * S;
    const LAS float* tbh = tb + hd * 128; const float cfar = tbh[127];
    for (int ui = 0; ui < 4; ++ui) {
        const int qb = (ui == 0) ? s4 : (ui == 1) ? 31 - s4 : (ui == 2) ? 32 + s4 : 63 - s4, q0 = qb * 32, qpos = q0 + r32;
        const bf16* Pq = F.Q1 + (rowbase + q0 + r32) * 1024 + hd * 64 + hi * 8;
        bf16x8 qr[4];
#pragma unroll
        for (int d0 = 0; d0 < 4; ++d0) qr[d0] = *(const bf16x8*)(Pq + d0 * 16);
        f32x16 o0 = {}, o1 = {}; float l = 0.f; const int ktmax = (q0 + 31) >> 6;
        for (int kt = 0; kt <= ktmax; ++kt) {
            bf16x8 kf[2][4]; v4u vv[8];
            load_kfrags(kf, F.K1 + (rowbase + 64 * kt + r32) * 256 + g * 64 + hi * 8, 256);
            load_vpieces(vv, F.V1 + (rowbase + 64 * kt) * 256 + g * 64, 256, lane);
            const unsigned long long mw = F.MASK[(rowbase + qpos) * 32 + kt];
            const bool far = (q0 - (64 * kt + 63)) >= 113;
            f32x16 p0, p1;
#pragma unroll
            for (int r = 0; r < 16; ++r) { p0[r] = far ? cfar : 0.f; p1[r] = far ? cfar : 0.f; }
#pragma unroll
            for (int d0 = 0; d0 < 4; ++d0) { p0 = __builtin_amdgcn_mfma_f32_32x32x16_bf16(kf[0][d0], qr[d0], p0, 0, 0, 0); p1 = __builtin_amdgcn_mfma_f32_32x32x16_bf16(kf[1][d0], qr[d0], p1, 0, 0, 0); }
            store_vpieces(vl, vv, lane);
            if (!far) {
                const int d00 = qpos - 64 * kt - 4 * hi;
#pragma unroll
                for (int r = 0; r < 16; ++r) { const int d = d00 - ((r & 3) + 8 * (r >> 2)); p0[r] += tbh[min(max(d, 0), 127)]; p1[r] += tbh[min(max(d - 32, 0), 127)]; }
            }
            const unsigned m0 = (unsigned)mw >> (4 * hi), m1 = (unsigned)(mw >> 32) >> (4 * hi);
#pragma unroll
            for (int r = 0; r < 16; ++r) { const int bit = (r & 3) + 8 * (r >> 2);
                const float e0 = ((m0 >> bit) & 1u) ? __builtin_amdgcn_exp2f(p0[r]) : 0.f, e1 = ((m1 >> bit) & 1u) ? __builtin_amdgcn_exp2f(p1[r]) : 0.f;
                l += e0 + e1; p0[r] = e0; p1[r] = e1; }
            pv_mma(o0, o1, vb, p0, p1);
        }
        { auto rr = __builtin_amdgcn_permlane32_swap(__float_as_uint(l), __float_as_uint(l), false, false); l = __uint_as_float(rr[0]) + __uint_as_float(rr[1]); }
        if (hi == 0) wsf[r32] = l;
        LDS_WAIT(); asm volatile("" ::: "memory");
        float rl[16];
#pragma unroll
        for (int r = 0; r < 16; ++r) rl[r] = __builtin_amdgcn_rcpf(wsf[(r & 3) + 8 * (r >> 2) + 4 * hi]);
        store_o(stg, o0, o1, rl, F.ATT + (rowbase + q0) * D + hd * 64, D, lane);
    }
}
__device__ __forceinline__ void glds16(const void* gsrc, unsigned lds_dst) { unsigned keep;
    asm volatile("s_mov_b32 %0, m0\n\ts_mov_b32 m0, %2\n\ts_nop 0\n\tglobal_load_lds_dwordx4 %1, off\n\ts_mov_b32 m0, %0" : "=&s"(keep) : "v"(gsrc), "s"(lds_dst) : "memory"); }
#define WAIT_BAR(N) asm volatile("s_waitcnt vmcnt(" #N ") lgkmcnt(0)\n\ts_barrier" ::: "memory")
__device__ __forceinline__ void dsa_coop(Frame& F) {
    const int lane = F.lane, r32 = lane & 31, hi = lane >> 5, wave = F.wave;
    LAS unsigned char* L = F.lds + RING_OFF;
    LAS unsigned char* stg = L + 32768 + wave * 4096; LAS float* wsf = (LAS float*)(L + 65536 + wave * 256); LAS float* tb = (LAS float*)(L + 69632); LAS unsigned long long* ml = (LAS unsigned long long*)(L + 77824 + wave * 8192);
    const unsigned l0 = (unsigned)(uintptr_t)L;
    for (int i = F.tid; i < 2048; i += NWAVES * 64) tb[i] = (F.rel_bias[rel_bucket(i & 127) * 16 + (i >> 7)] - F.rel_bias[31 * 16 + (i >> 7)]) * 1.4426950408889634f;
    __syncthreads();
    const int v = F.vcu, bg = v >> 3, b = bg >> 2, g = bg & 3, s3 = v & 7, hd = 4 * g + (wave & 3), qh = wave >> 2; const size_t rowbase = (size_t)b * S;
    const LAS float* tbh = tb + hd * 128;
    const bf16x8 ones8 = {0x3F80, 0x3F80, 0x3F80, 0x3F80, 0x3F80, 0x3F80, 0x3F80, 0x3F80};
    const bf16* ksrc = F.K1 + (rowbase + lane) * 256 + g * 64 + wave * 8;
    const bf16* vsrc = F.V1 + (rowbase + 16 * (wave & 3) + (lane >> 2)) * 256 + g * 64 + (wave >> 2) * 32 + (lane & 3) * 8;
    const unsigned kdst = (unsigned)__builtin_amdgcn_readfirstlane(l0 + wave * 1024), vdst = kdst + 16384;
    const LAS unsigned char* kp = L + hi * 1024 + r32 * 16;
    const LAS unsigned char* vb = L + 16384 + ((lane >> 4) & 1) * 32 + (lane & 3) * 8 + (4 * hi + ((lane & 15) >> 2)) * 64;
    bf16x8 qrn[4]; v4u mreg[8];
#define DSA_PREFETCH(UI) do { const int qb_ = ((UI) == 0) ? s3 : ((UI) == 1) ? 15 - s3 : ((UI) == 2) ? 16 + s3 : 31 - s3; const int qpos_ = qb_ * 64 + qh * 32 + r32; \
        glds16(ksrc, kdst); glds16(vsrc, vdst); \
        const bf16* Pq_ = F.Q1 + (rowbase + qpos_) * 1024 + hd * 64 + hi * 8; _Pragma("unroll") for (int d0 = 0; d0 < 4; ++d0) qrn[d0] = *(const bf16x8*)(Pq_ + d0 * 16); \
        const v4u* mrow_ = (const v4u*)(F.MASK + (rowbase + qpos_) * 32 + 16 * hi); _Pragma("unroll") for (int i = 0; i < 8; ++i) mreg[i] = mrow_[i]; } while (0)
    DSA_PREFETCH(0);
    for (int ui = 0; ui < 4; ++ui) {
        const int qb = (ui == 0) ? s3 : (ui == 1) ? 15 - s3 : (ui == 2) ? 16 + s3 : 31 - s3, q0 = qb * 64 + qh * 32, qpos = q0 + r32, nt = qb + 1;
        bf16x8 qr[4];
#pragma unroll
        for (int d0 = 0; d0 < 4; ++d0) qr[d0] = qrn[d0];
#pragma unroll
        for (int i = 0; i < 8; ++i) { const v4u w = mreg[i]; ml[(16 * hi + 2 * i) * 32 + r32] = ((unsigned long long)w.y << 32) | w.x; ml[(16 * hi + 2 * i + 1) * 32 + r32] = ((unsigned long long)w.w << 32) | w.z; }
        f32x16 o0 = {}, o1 = {}, o2 = {};
        WAIT_BAR(4);
        for (int kt = 0; kt < nt; ++kt) {
            const int cur = (kt & 1) * 8192; const unsigned long long mw = ml[kt * 32 + r32];
            if (kt + 1 < nt) { glds16(ksrc + (size_t)(kt + 1) * 64 * 256, kdst + (8192 - cur)); glds16(vsrc + (size_t)(kt + 1) * 64 * 256, vdst + (8192 - cur)); }
            const bool far = (q0 - (64 * kt + 63)) >= 113;
            const f32x16 z16 = {};
            f32x16 p0, p1;
#pragma unroll
            for (int d0 = 0; d0 < 4; ++d0) { const bf16x8 k0 = *(const LAS bf16x8*)(kp + cur + d0 * 2048), k1 = *(const LAS bf16x8*)(kp + cur + d0 * 2048 + 512);
                p0 = __builtin_amdgcn_mfma_f32_32x32x16_bf16(k0, qr[d0], d0 ? p0 : z16, 0, 0, 0); p1 = __builtin_amdgcn_mfma_f32_32x32x16_bf16(k1, qr[d0], d0 ? p1 : z16, 0, 0, 0); }
            if (!far) {
                const int d00 = qpos - 64 * kt - 4 * hi;
#pragma unroll
                for (int r = 0; r < 16; ++r) { const int d = d00 - ((r & 3) + 8 * (r >> 2)); p0[r] += tbh[min(max(d, 0), 127)]; p1[r] += tbh[min(max(d - 32, 0), 127)]; }
            }
            const unsigned m0 = (unsigned)mw >> (4 * hi), m1 = (unsigned)(mw >> 32) >> (4 * hi);
            bf16x8 pa[4];
#pragma unroll
            for (int ks = 0; ks < 4; ++ks) { const f32x16& P = (ks < 2) ? p0 : p1; const unsigned mm = (ks < 2) ? m0 : m1; const int bb = (ks & 1) * 8; v4u wv;
#pragma unroll
                for (int j = 0; j < 4; ++j) { const int r = bb + 2 * j, bit = (r & 3) + 8 * (r >> 2); unsigned n0, n1, m2;
                    asm("v_bfe_i32 %0, %1, %2, 1" : "=v"(n0) : "v"(mm), "n"(bit)); asm("v_bfe_i32 %0, %1, %2, 1" : "=v"(n1) : "v"(mm), "n"(bit + 1));
                    asm("v_bfi_b32 %0, %1, %2, %3" : "=v"(m2) : "v"(0xffffu), "v"(n0), "v"(n1));
                    wv[j] = cvtpk(__builtin_amdgcn_exp2f(P[r]), __builtin_amdgcn_exp2f(P[r + 1])) & m2; }
                pa[ks] = __builtin_bit_cast(bf16x8, wv); }
            { const LAS unsigned char* vq = vb + cur;
#pragma unroll
              for (int ks = 0; ks < 4; ++ks) {
                const s16x4 l0 = vtr(vq + ks * 1024), h0 = vtr(vq + ks * 1024 + 512), l1 = vtr(vq + 4096 + ks * 1024), h1 = vtr(vq + 4096 + ks * 1024 + 512);
                o0 = __builtin_amdgcn_mfma_f32_32x32x16_bf16(pa[ks], (bf16x8){l0[0], l0[1], l0[2], l0[3], h0[0], h0[1], h0[2], h0[3]}, o0, 0, 0, 0);
                o1 = __builtin_amdgcn_mfma_f32_32x32x16_bf16(pa[ks], (bf16x8){l1[0], l1[1], l1[2], l1[3], h1[0], h1[1], h1[2], h1[3]}, o1, 0, 0, 0);
                o2 = __builtin_amdgcn_mfma_f32_32x32x16_bf16(pa[ks], ones8, o2, 0, 0, 0); } }
            WAIT_BAR(0);
        }
        if (ui == 0) DSA_PREFETCH(1); else if (ui == 1) DSA_PREFETCH(2); else if (ui == 2) DSA_PREFETCH(3);
        float rl[16];
#pragma unroll
        for (int r = 0; r < 16; ++r) rl[r] = __builtin_amdgcn_rcpf(o2[r]);
        store_o(stg, o0, o1, rl, F.ATT + (rowbase + q0) * D + hd * 64, D, lane);
    }
#undef DSA_PREFETCH
}
__device__ __forceinline__ void dsa_pipe(Frame& F) {
    const int lane = F.lane, r32 = lane & 31, hi = lane >> 5, wave = F.wave;
    LAS unsigned char* L = F.lds + RING_OFF;
    LAS unsigned char* stg = L + 32768 + wave * 4096; LAS float* wsf = (LAS float*)(L + 65536 + wave * 256); LAS float* tb = (LAS float*)(L + 69632); LAS unsigned long long* ml = (LAS unsigned long long*)(L + 77824 + wave * 8192);
    const unsigned l0 = (unsigned)(uintptr_t)L;
    { float mq = fabsf(F.od_q_gain[lane]), mk = fabsf(F.od_k_gain[lane]), mb = 0.f;
#pragma unroll
      for (int i = 0; i < 8; ++i) mb = fmaxf(mb, fabsf(F.rel_bias[64 * i + lane]));
      mq = wave_max(mq); mk = wave_max(mk); mb = wave_max(mb);
      const float shift2 = (8.0f * mq * mk + mb) * 1.4426950408889634f;
      for (int i = F.tid; i < 2048; i += NWAVES * 64) tb[i] = F.rel_bias[rel_bucket(i & 127) * 16 + (i >> 7)] * 1.4426950408889634f - shift2; }
    __syncthreads();
    const int v = F.vcu, bg = v >> 3, b = bg >> 2, g = bg & 3, s3 = v & 7, hd = 4 * g + (wave & 3), qh = wave >> 2; const size_t rowbase = (size_t)b * S;
    const LAS float* tbh = tb + hd * 128; const float cfar = tbh[127];
    const bf16* ksrc = F.K1 + (rowbase + lane) * 256 + g * 64 + wave * 8;
    const bf16* vsrc = F.V1 + (rowbase + 16 * (wave & 3) + (lane >> 2)) * 256 + g * 64 + (wave >> 2) * 32 + (lane & 3) * 8;
    const unsigned kdst = (unsigned)__builtin_amdgcn_readfirstlane(l0 + wave * 1024), vdst = kdst + 16384;
    const LAS unsigned char* kp = L + hi * 1024 + r32 * 16;
    const LAS unsigned char* vb = L + 16384 + ((lane >> 4) & 1) * 32 + (lane & 3) * 8 + (4 * hi + ((lane & 15) >> 2)) * 64;
#define DSA_QK(N0, N1, KOFF) do { _Pragma("unroll") for (int d0 = 0; d0 < 4; ++d0) { const bf16x8 k0 = *(const LAS bf16x8*)(kp + (KOFF) + d0 * 2048), k1 = *(const LAS bf16x8*)(kp + (KOFF) + d0 * 2048 + 512); \
        N0 = __builtin_amdgcn_mfma_f32_32x32x16_bf16(k0, qr[d0], N0, 0, 0, 0); N1 = __builtin_amdgcn_mfma_f32_32x32x16_bf16(k1, qr[d0], N1, 0, 0, 0); } } while (0)
#define DSA_STEP(QKF, NEARF) do { const int cur = (kt & 1) * 8192; \
        if (kt + 2 < nt) glds16(ksrc + (size_t)(kt + 2) * 64 * 256, kdst + cur); \
        if (kt + 1 < nt) glds16(vsrc + (size_t)(kt + 1) * 64 * 256, vdst + (8192 - cur)); \
        const unsigned long long mw = ml[kt * 32 + r32]; \
        f32x16 N0 = {}, N1 = {}; \
        if (QKF) { const float ci = (kt + 1 < kt_near) ? cfar : 0.f; _Pragma("unroll") for (int r = 0; r < 16; ++r) { N0[r] = ci; N1[r] = ci; } DSA_QK(N0, N1, 8192 - cur); } \
        if (NEARF) { const int d00 = qpos - 64 * kt - 4 * hi; \
            _Pragma("unroll") for (int r = 0; r < 16; ++r) { const int d = d00 - ((r & 3) + 8 * (r >> 2)); S0[r] += tbh[min(max(d, 0), 127)]; S1[r] += tbh[min(max(d - 32, 0), 127)]; } } \
        { const unsigned m0 = (unsigned)mw >> (4 * hi), m1 = (unsigned)(mw >> 32) >> (4 * hi); \
          _Pragma("unroll") for (int r = 0; r < 16; ++r) { const int bit = (r & 3) + 8 * (r >> 2); unsigned k0, k1; \
              asm("v_bfe_i32 %0, %1, %2, 1" : "=v"(k0) : "v"(m0), "n"(bit)); asm("v_bfe_i32 %0, %1, %2, 1" : "=v"(k1) : "v"(m1), "n"(bit)); \
              const float e0 = __uint_as_float(__float_as_uint(__builtin_amdgcn_exp2f(S0[r])) & k0), e1 = __uint_as_float(__float_as_uint(__builtin_amdgcn_exp2f(S1[r])) & k1); \
              l += e0 + e1; S0[r] = e0; S1[r] = e1; } } \
        if (QKF) { _Pragma("unroll") for (int i = 0; i < 8; ++i) { __builtin_amdgcn_sched_group_barrier(0x100, 1, 0); __builtin_amdgcn_sched_group_barrier(0x008, 1, 0); __builtin_amdgcn_sched_group_barrier(0x402, 20, 0); } } \
        pv_mma(o0, o1, vb + cur, S0, S1); \
        WAIT_BAR(0); \
        S0 = N0; S1 = N1; } while (0)
    for (int ui = 0; ui < 4; ++ui) {
        const int qb = (ui == 0) ? s3 : (ui == 1) ? 15 - s3 : (ui == 2) ? 16 + s3 : 31 - s3, q0 = qb * 64 + qh * 32, qpos = q0 + r32, nt = qb + 1;
        int kt_near = (q0 - 175 + 63) >> 6; kt_near = kt_near < 0 ? 0 : kt_near;
        const bf16* Pq = F.Q1 + (rowbase + qpos) * 1024 + hd * 64 + hi * 8;
        bf16x8 qr[4];
#pragma unroll
        for (int d0 = 0; d0 < 4; ++d0) qr[d0] = *(const bf16x8*)(Pq + d0 * 16);
        glds16(ksrc, kdst); glds16(vsrc, vdst); if (nt > 1) glds16(ksrc + (size_t)64 * 256, kdst + 8192);
        { const v4u* mrow = (const v4u*)(F.MASK + (rowbase + qpos) * 32 + 16 * hi);
#pragma unroll
          for (int i = 0; i < 8; ++i) { const v4u w = mrow[i]; ml[(16 * hi + 2 * i) * 32 + r32] = ((unsigned long long)w.y << 32) | w.x; ml[(16 * hi + 2 * i + 1) * 32 + r32] = ((unsigned long long)w.w << 32) | w.z; } }
        f32x16 o0 = {}, o1 = {}, S0, S1; float l = 0.f;
        WAIT_BAR(0);
        { const float ci = (0 < kt_near) ? cfar : 0.f;
#pragma unroll
          for (int r = 0; r < 16; ++r) { S0[r] = ci; S1[r] = ci; }
          DSA_QK(S0, S1, 0); }
        WAIT_BAR(0);
        for (int kt = 0; kt < nt; ++kt) {
            const bool hasqk = kt + 1 < nt;
            if (kt >= kt_near) { if (hasqk) DSA_STEP(1, 1); else DSA_STEP(0, 1); }
            else DSA_STEP(1, 0);
        }
        { auto rr = __builtin_amdgcn_permlane32_swap(__float_as_uint(l), __float_as_uint(l), false, false); l = __uint_as_float(rr[0]) + __uint_as_float(rr[1]); }
        if (hi == 0) wsf[r32] = l;
        LDS_WAIT(); asm volatile("" ::: "memory");
        float rl[16];
#pragma unroll
        for (int r = 0; r < 16; ++r) rl[r] = __builtin_amdgcn_rcpf(wsf[(r & 3) + 8 * (r >> 2) + 4 * hi]);
        store_o(stg, o0, o1, rl, F.ATT + (rowbase + q0) * D + hd * 64, D, lane);
    }
#undef DSA_QK
#undef DSA_STEP
}
template <int PMODE> __device__ __forceinline__ void dsa_pp(Frame& F, bf16* OUT) {
    const int lane = F.lane, r32 = lane & 31, hi = lane >> 5, wave = F.wave;
    LAS unsigned char* L = F.lds + RING_OFF;
    LAS unsigned char* stg = L + 49152 + wave * 4096; LAS float* wsf = (LAS float*)(L + 81920 + wave * 256); LAS float* tb = (LAS float*)(L + 83968); LAS unsigned long long* ml = (LAS unsigned long long*)(L + 92160 + wave * 8192);
    const unsigned l0 = (unsigned)(uintptr_t)L;
    { float mq = fabsf(F.od_q_gain[lane]), mk = fabsf(F.od_k_gain[lane]), mb = 0.f;
#pragma unroll
      for (int i = 0; i < 8; ++i) mb = fmaxf(mb, fabsf(F.rel_bias[64 * i + lane]));
      mq = wave_max(mq); mk = wave_max(mk); mb = wave_max(mb);
      const float shift2 = (8.0f * mq * mk + mb) * 1.4426950408889634f;
      for (int i = F.tid; i < 2048; i += NWAVES * 64) tb[i] = F.rel_bias[rel_bucket(i & 127) * 16 + (i >> 7)] * 1.4426950408889634f - shift2; }
    __syncthreads();
    const int v = F.vcu, bg = v >> 3, b = bg >> 2, g = bg & 3, s3 = v & 7, hd = 4 * g + (wave & 3), role = wave >> 2, qh = role; const size_t rowbase = (size_t)b * S;
    const LAS float* tbh = tb + hd * 128; const float cfar = tbh[127];
    const bf16* ksrc = F.K1 + (rowbase + lane) * 256 + g * 64 + wave * 8;
    const bf16* vsrc = F.V1 + (rowbase + 16 * (wave & 3) + (lane >> 2)) * 256 + g * 64 + (wave >> 2) * 32 + (lane & 3) * 8;
    const unsigned kdst = (unsigned)__builtin_amdgcn_readfirstlane(l0 + wave * 1024), vdst = kdst + 24576;
    const LAS unsigned char* kp = L + hi * 1024 + r32 * 16;
    const LAS unsigned char* vb = L + 24576 + ((lane >> 4) & 1) * 32 + (lane & 3) * 8 + (4 * hi + ((lane & 15) >> 2)) * 64;
    for (int ui = 0; ui < 4; ++ui) {
        const int qb = (ui == 0) ? s3 : (ui == 1) ? 15 - s3 : (ui == 2) ? 16 + s3 : 31 - s3, q0 = qb * 64 + qh * 32, qpos = q0 + r32, nt = qb + 1;
        int kt_near = (q0 - 175 + 63) >> 6; kt_near = kt_near < 0 ? 0 : kt_near;
        const bf16* Pq = F.Q1 + (rowbase + qpos) * 1024 + hd * 64 + hi * 8;
        bf16x8 qr[4];
#pragma unroll
        for (int d0 = 0; d0 < 4; ++d0) qr[d0] = *(const bf16x8*)(Pq + d0 * 16);
        glds16(ksrc, kdst); glds16(vsrc, vdst); if (nt > 1) glds16(ksrc + (size_t)64 * 256, kdst + 8192);
        { const v4u* mrow = (const v4u*)(F.MASK + (rowbase + qpos) * 32 + 16 * hi);
#pragma unroll
          for (int i = 0; i < 8; ++i) { const v4u w = mrow[i]; ml[(16 * hi + 2 * i) * 32 + r32] = ((unsigned long long)w.y << 32) | w.x; ml[(16 * hi + 2 * i + 1) * 32 + r32] = ((unsigned long long)w.w << 32) | w.z; } }
        f32x16 o0 = {}, o1 = {}, S0 = {}, S1 = {}; float l = 0.f; bf16x8 Pp[4] = {};
        WAIT_BAR(0);
        int nfly = 0;
        for (int h = 0; h <= 2 * nt + 1; ++h) {
            if (!(h & 1)) { const int t = h >> 1;
                nfly = 0;
                if (t + 2 < nt && PMODE != 4) { glds16(ksrc + (size_t)(t + 2) * 64 * 256, kdst + ((t + 2) % 3) * 8192); ++nfly; }
                if (t + 1 < nt && PMODE != 4) { glds16(vsrc + (size_t)(t + 1) * 64 * 256, vdst + ((t + 1) % 3) * 8192); ++nfly; } }
            const int j = h - role;
            if (j >= 0 && j <= 2 * nt) {
                const int t = j >> 1;
                if (!(j & 1)) {
                    if (t >= 1 && PMODE != 3) { const LAS unsigned char* vq = vb + ((t - 1) % 3) * 8192;
#pragma unroll
                        for (int ks = 0; ks < 4; ++ks) { const s16x4 a0 = vtr(vq + ks * 1024), b0 = vtr(vq + ks * 1024 + 512), a1 = vtr(vq + 4096 + ks * 1024), b1 = vtr(vq + 4096 + ks * 1024 + 512);
                            o0 = __builtin_amdgcn_mfma_f32_32x32x16_bf16(Pp[ks], (bf16x8){a0[0], a0[1], a0[2], a0[3], b0[0], b0[1], b0[2], b0[3]}, o0, 0, 0, 0);
                            o1 = __builtin_amdgcn_mfma_f32_32x32x16_bf16(Pp[ks], (bf16x8){a1[0], a1[1], a1[2], a1[3], b1[0], b1[1], b1[2], b1[3]}, o1, 0, 0, 0); } }
                    if (t < nt && PMODE != 3) { const float ci = (t < kt_near) ? cfar : 0.f; const LAS unsigned char* kq = kp + (t % 3) * 8192;
#pragma unroll
                        for (int r = 0; r < 16; ++r) { S0[r] = ci; S1[r] = ci; }
#pragma unroll
                        for (int d0 = 0; d0 < 4; ++d0) { const bf16x8 k0 = *(const LAS bf16x8*)(kq + d0 * 2048), k1 = *(const LAS bf16x8*)(kq + d0 * 2048 + 512);
                            S0 = __builtin_amdgcn_mfma_f32_32x32x16_bf16(k0, qr[d0], S0, 0, 0, 0); S1 = __builtin_amdgcn_mfma_f32_32x32x16_bf16(k1, qr[d0], S1, 0, 0, 0); } }
                } else if (PMODE != 2) {
                    const unsigned long long mw = ml[t * 32 + r32];
                    if (t >= kt_near) { const int d00 = qpos - 64 * t - 4 * hi;
#pragma unroll
                        for (int r = 0; r < 16; ++r) { const int d = d00 - ((r & 3) + 8 * (r >> 2)); S0[r] += tbh[min(max(d, 0), 127)]; S1[r] += tbh[min(max(d - 32, 0), 127)]; } }
                    const unsigned m0 = (unsigned)mw >> (4 * hi), m1 = (unsigned)(mw >> 32) >> (4 * hi);
#pragma unroll
                    for (int r = 0; r < 16; ++r) { const int bit = (r & 3) + 8 * (r >> 2); unsigned k0, k1;
                        asm("v_bfe_i32 %0, %1, %2, 1" : "=v"(k0) : "v"(m0), "n"(bit)); asm("v_bfe_i32 %0, %1, %2, 1" : "=v"(k1) : "v"(m1), "n"(bit));
                        const float e0 = __uint_as_float(__float_as_uint(__builtin_amdgcn_exp2f(S0[r])) & k0), e1 = __uint_as_float(__float_as_uint(__builtin_amdgcn_exp2f(S1[r])) & k1);
                        l += e0 + e1; S0[r] = e0; S1[r] = e1; }
#pragma unroll
                    for (int ks = 0; ks < 4; ++ks) { const f32x16& P = (ks < 2) ? S0 : S1; const int bb = (ks & 1) * 8; v4u w; w.x = cvtpk(P[bb], P[bb + 1]); w.y = cvtpk(P[bb + 2], P[bb + 3]);
                        w.z = cvtpk(P[bb + 4], P[bb + 5]); w.w = cvtpk(P[bb + 6], P[bb + 7]); Pp[ks] = __builtin_bit_cast(bf16x8, w); }
                }
            }
            if (nfly == 2) WAIT_BAR(2); else if (nfly == 1) WAIT_BAR(1); else WAIT_BAR(0);
        }
        { auto rr = __builtin_amdgcn_permlane32_swap(__float_as_uint(l), __float_as_uint(l), false, false); l = __uint_as_float(rr[0]) + __uint_as_float(rr[1]); }
        if (hi == 0) wsf[r32] = l;
        LDS_WAIT(); asm volatile("" ::: "memory");
        float rl[16];
#pragma unroll
        for (int r = 0; r < 16; ++r) rl[r] = __builtin_amdgcn_rcpf(wsf[(r & 3) + 8 * (r >> 2) + 4 * hi]);
        store_o(stg, o0, o1, rl, OUT + (rowbase + q0) * D + hd * 64, D, lane);
    }
}
template <int PMODE> __device__ __forceinline__ void dsa_hand(Frame& F, bf16* OUT) {
    const int lane = F.lane, r32 = lane & 31, hi = lane >> 5, wave = F.wave;
    LAS unsigned char* L = F.lds + RING_OFF;
    LAS unsigned char* stg = L + 32768 + wave * 4096; LAS float* wsf = (LAS float*)(L + 65536 + wave * 256); LAS float* tb = (LAS float*)(L + 69632); LAS unsigned long long* ml = (LAS unsigned long long*)(L + 77824 + wave * 8192);
    const unsigned l0 = (unsigned)(uintptr_t)L;
    for (int i = F.tid; i < 2048; i += NWAVES * 64) tb[i] = (F.rel_bias[rel_bucket(i & 127) * 16 + (i >> 7)] - F.rel_bias[31 * 16 + (i >> 7)]) * 1.4426950408889634f;
    __syncthreads();
    const int v = F.vcu, bg = v >> 3, b = bg >> 2, g = bg & 3, s3 = v & 7, hd = 4 * g + (wave & 3), qh = wave >> 2; const size_t rowbase = (size_t)b * S;
    const LAS float* tbh = tb + hd * 128;
    const bf16* ksrc = F.K1 + (rowbase + lane) * 256 + g * 64 + wave * 8;
    const bf16* vsrc = F.V1 + (rowbase + 16 * (wave & 3) + (lane >> 2)) * 256 + g * 64 + (wave >> 2) * 32 + (lane & 3) * 8;
    const unsigned kdst = (unsigned)__builtin_amdgcn_readfirstlane(l0 + wave * 1024), vdst = kdst + 16384;
    const LAS unsigned char* kp = L + hi * 1024 + r32 * 16;
    const LAS unsigned char* vb = L + 16384 + ((lane >> 4) & 1) * 32 + (lane & 3) * 8 + (4 * hi + ((lane & 15) >> 2)) * 64;
#define SBAR0() __builtin_amdgcn_sched_barrier(0)
#define DH_SM4(E) do {   \
        if (PMODE != 2) { unsigned ka, kb2, kc, kd; asm("v_bfe_i32 %0, %1, %2, 1" : "=v"(ka) : "v"(m0), "n"(((2 * (E)) & 3) + 8 * ((2 * (E)) >> 2))); asm("v_bfe_i32 %0, %1, %2, 1" : "=v"(kb2) : "v"(m0), "n"(((2 * (E) + 1) & 3) + 8 * ((2 * (E) + 1) >> 2))); \
          asm("v_bfe_i32 %0, %1, %2, 1" : "=v"(kc) : "v"(m1), "n"(((2 * (E)) & 3) + 8 * ((2 * (E)) >> 2))); asm("v_bfe_i32 %0, %1, %2, 1" : "=v"(kd) : "v"(m1), "n"(((2 * (E) + 1) & 3) + 8 * ((2 * (E) + 1) >> 2))); \
          const float ea = __uint_as_float(__float_as_uint(__builtin_amdgcn_exp2f(S0[2 * (E)])) & ka), eb = __uint_as_float(__float_as_uint(__builtin_amdgcn_exp2f(S0[2 * (E) + 1])) & kb2); \
          const float ec = __uint_as_float(__float_as_uint(__builtin_amdgcn_exp2f(S1[2 * (E)])) & kc), ed = __uint_as_float(__float_as_uint(__builtin_amdgcn_exp2f(S1[2 * (E) + 1])) & kd); \
          S0[2 * (E)] = ea; S0[2 * (E) + 1] = eb; S1[2 * (E)] = ec; S1[2 * (E) + 1] = ed; la += ea; lb += eb; la += ec; lb += ed; } \
        asm volatile("" : "+v"(S0), "+v"(S1), "+v"(la), "+v"(lb)); } while (0)
    for (int ui = 0; ui < 4; ++ui) {
        const int qb = (ui == 0) ? s3 : (ui == 1) ? 15 - s3 : (ui == 2) ? 16 + s3 : 31 - s3, q0 = qb * 64 + qh * 32, qpos = q0 + r32, nt = qb + 1;
        int kt_near = (q0 - 175 + 63) >> 6; kt_near = kt_near < 0 ? 0 : kt_near;
        const bf16* Pq = F.Q1 + (rowbase + qpos) * 1024 + hd * 64 + hi * 8;
        bf16x8 qr[4];
#pragma unroll
        for (int d0 = 0; d0 < 4; ++d0) qr[d0] = *(const bf16x8*)(Pq + d0 * 16);
        glds16(ksrc, kdst); glds16(vsrc, vdst); if (nt > 1) glds16(ksrc + (size_t)64 * 256, kdst + 8192);
        { const v4u* mrow = (const v4u*)(F.MASK + (rowbase + qpos) * 32 + 16 * hi);
#pragma unroll
          for (int i = 0; i < 8; ++i) { const v4u w = mrow[i]; ml[(16 * hi + 2 * i) * 32 + r32] = ((unsigned long long)w.y << 32) | w.x; ml[(16 * hi + 2 * i + 1) * 32 + r32] = ((unsigned long long)w.w << 32) | w.z; } }
        f32x16 o0 = {}, o1 = {}, S0 = {}, S1 = {}; float la = 0.f, lb = 0.f;
        WAIT_BAR(0);
#pragma unroll
        for (int d0 = 0; d0 < 4; ++d0) { const bf16x8 k0 = *(const LAS bf16x8*)(kp + d0 * 2048), k1 = *(const LAS bf16x8*)(kp + d0 * 2048 + 512);
            S0 = __builtin_amdgcn_mfma_f32_32x32x16_bf16(k0, qr[d0], S0, 0, 0, 0); S1 = __builtin_amdgcn_mfma_f32_32x32x16_bf16(k1, qr[d0], S1, 0, 0, 0); }
        WAIT_BAR(0);
        for (int kt = 0; kt < nt; ++kt) {
            const int cur = (kt & 1) * 8192;
            if (kt + 2 < nt) glds16(ksrc + (size_t)(kt + 2) * 64 * 256, kdst + cur);
            if (kt + 1 < nt) glds16(vsrc + (size_t)(kt + 1) * 64 * 256, vdst + (8192 - cur));
            const unsigned long long mw = ml[kt * 32 + r32];
            if (kt >= kt_near && PMODE != 4) { const int d00 = qpos - 64 * kt - 4 * hi;
#pragma unroll
                for (int r = 0; r < 16; ++r) { const int d = d00 - ((r & 3) + 8 * (r >> 2)); S0[r] += tbh[min(max(d, 0), 127)]; S1[r] += tbh[min(max(d - 32, 0), 127)]; } }
            const unsigned m0 = (unsigned)mw >> (4 * hi), m1 = (unsigned)(mw >> 32) >> (4 * hi);
            f32x16 N0 = {}, N1 = {};
            if (kt + 1 < nt && PMODE != 5) {
                const LAS unsigned char* kq = kp + (8192 - cur);
                bf16x8 kf[8];
#pragma unroll
                for (int i = 0; i < 8; ++i) kf[i] = *(const LAS bf16x8*)(kq + (i >> 1) * 2048 + (i & 1) * 512);
                SBAR0();
                N0 = __builtin_amdgcn_mfma_f32_32x32x16_bf16(kf[0], qr[0], N0, 0, 0, 0); DH_SM4(0); SBAR0();
                N1 = __builtin_amdgcn_mfma_f32_32x32x16_bf16(kf[1], qr[0], N1, 0, 0, 0); DH_SM4(1); SBAR0();
                N0 = __builtin_amdgcn_mfma_f32_32x32x16_bf16(kf[2], qr[1], N0, 0, 0, 0); DH_SM4(2); SBAR0();
                N1 = __builtin_amdgcn_mfma_f32_32x32x16_bf16(kf[3], qr[1], N1, 0, 0, 0); DH_SM4(3); SBAR0();
                N0 = __builtin_amdgcn_mfma_f32_32x32x16_bf16(kf[4], qr[2], N0, 0, 0, 0); DH_SM4(4); SBAR0();
                N1 = __builtin_amdgcn_mfma_f32_32x32x16_bf16(kf[5], qr[2], N1, 0, 0, 0); DH_SM4(5); SBAR0();
                N0 = __builtin_amdgcn_mfma_f32_32x32x16_bf16(kf[6], qr[3], N0, 0, 0, 0); DH_SM4(6); SBAR0();
                N1 = __builtin_amdgcn_mfma_f32_32x32x16_bf16(kf[7], qr[3], N1, 0, 0, 0); DH_SM4(7); SBAR0();
            } else { DH_SM4(0); DH_SM4(1); DH_SM4(2); DH_SM4(3); DH_SM4(4); DH_SM4(5); DH_SM4(6); DH_SM4(7); }
            if (PMODE != 3) pv_mma(o0, o1, vb + cur, S0, S1);
            WAIT_BAR(0);
            S0 = N0; S1 = N1;
        }
        float l = la + lb;
        { auto rr = __builtin_amdgcn_permlane32_swap(__float_as_uint(l), __float_as_uint(l), false, false); l = __uint_as_float(rr[0]) + __uint_as_float(rr[1]); }
        if (hi == 0) wsf[r32] = l;
        LDS_WAIT(); asm volatile("" ::: "memory");
        float rl[16];
#pragma unroll
        for (int r = 0; r < 16; ++r) rl[r] = __builtin_amdgcn_rcpf(wsf[(r & 3) + 8 * (r >> 2) + 4 * hi]);
        store_o(stg, o0, o1, rl, OUT + (rowbase + q0) * D + hd * 64, D, lane);
    }
#undef DH_SM4
#undef SBAR0
}
__device__ __forceinline__ void p6_mini(Frame& F) {
    const int lane = F.lane, c16 = lane & 15, kq = lane >> 4, mt = F.wave & 3, ns = F.wave >> 2;
    for (int blk = (int)blockIdx.x; blk < M / 64; blk += F.G) {
        const int r0 = blk * 64 + mt * 16;
        const bf16* ap = F.XB + (size_t)(r0 + c16) * D + 8 * kq;
        const int nb0 = ns ? 2176 : 2048, nb1 = ns ? 2192 : 2064, nb2 = 2080;
        const bf16* b0 = F.W_in1 + (size_t)(nb0 + c16) * D + 8 * kq; const bf16* b1 = F.W_in1 + (size_t)(nb1 + c16) * D + 8 * kq; const bf16* b2 = F.W_in1 + (size_t)(nb2 + c16) * D + 8 * kq;
        f32x4 a0 = {0.f, 0.f, 0.f, 0.f}, a1 = a0, a2 = a0;
#pragma unroll 4
        for (int ks = 0; ks < 32; ++ks) { const bf16x8 av = *(const bf16x8*)(ap + 32 * ks), v0 = *(const bf16x8*)(b0 + 32 * ks), v1 = *(const bf16x8*)(b1 + 32 * ks);
            a0 = __builtin_amdgcn_mfma_f32_16x16x32_bf16(av, v0, a0, 0, 0, 0); a1 = __builtin_amdgcn_mfma_f32_16x16x32_bf16(av, v1, a1, 0, 0, 0);
            if (!ns) { const bf16x8 v2 = *(const bf16x8*)(b2 + 32 * ks); a2 = __builtin_amdgcn_mfma_f32_16x16x32_bf16(av, v2, a2, 0, 0, 0); } }
#pragma unroll
        for (int i = 0; i < 4; ++i) { const int row = r0 + 4 * kq + i; const float sc = pg8::row_rstd(F.SS + 2 * M, row);
            F.KI[(size_t)row * 64 + (ns ? 32 : 0) + c16] = (bf16)f2bf(a0[i] * sc); F.KI[(size_t)row * 64 + (ns ? 48 : 16) + c16] = (bf16)f2bf(a1[i] * sc);
            if (!ns && c16 < 8) F.WI[(size_t)row * 8 + c16] = a2[i] * sc; }
    }
}
struct Args { const float* in[14]; float* out; unsigned char* ws; int ph_lo, ph_hi, li, pad; };
__global__ void __launch_bounds__(NWAVES * 64, 2) hybrid_fwd(Args args) {
    extern __shared__ __attribute__((aligned(16))) unsigned char lds[];
    Frame F;
    F.lds = (LAS unsigned char*)lds;
    F.MISC = (volatile LAS unsigned*)(F.lds + MISC_OFF);
    F.tid = threadIdx.x; F.lane = F.tid & 63; F.wave = __builtin_amdgcn_readfirstlane(F.tid >> 6);
    F.G = gridDim.x; { const int bx = blockIdx.x; F.vcu = (F.G % 8 == 0) ? (bx % 8) * (F.G / 8) + bx / 8 : bx; }
    unsigned char* ws = args.ws;
    F.ctl = (gu32*)(ws + WS_CTL);
    F.x = args.in[0]; F.norm_mix = args.in[1]; F.norm_ffn = args.in[2]; F.ev_w_in = args.in[3]; F.ev_conv_w = args.in[4]; F.ev_w_out = args.in[5]; F.od_w_in = args.in[6];
    F.od_q_gain = args.in[7]; F.od_k_gain = args.in[8]; F.od_w_out = args.in[9]; F.rel_bias = args.in[10]; F.w_gate = args.in[11]; F.w_up = args.in[12]; F.w_down = args.in[13];
    F.out = args.out; F.SS = (float*)(ws + WS_CTL) + CW_SS;
    F.W_in0 = (bf16*)(ws + WS_W_IN0); F.W_out0 = (bf16*)(ws + WS_W_OUT0); F.W_gu0 = (bf16*)(ws + WS_W_GU0); F.W_dn0 = (bf16*)(ws + WS_W_DN0);
    F.W_in1 = (bf16*)(ws + WS_W_IN1); F.W_out1 = (bf16*)(ws + WS_W_OUT1); F.W_gu1 = (bf16*)(ws + WS_W_GU1); F.W_dn1 = (bf16*)(ws + WS_W_DN1);
    F.XB = (bf16*)(ws + WS_XB); F.ATT = (bf16*)(ws + WS_ATT); F.PROJ0 = (bf16*)(ws + WS_PROJ0); F.H = (bf16*)(ws + WS_H);
    F.Q1 = (bf16*)(ws + WS_Q1); F.K1 = (bf16*)(ws + WS_K1); F.V1 = (bf16*)(ws + WS_V1); F.QI = (bf16*)(ws + WS_QI); F.KI = (bf16*)(ws + WS_KI); F.WI = (float*)(ws + WS_WI); F.MASK = (unsigned long long*)(ws + WS_MASK);
    if (F.tid < 64) ((LAS unsigned*)(F.lds + MISC_OFF))[F.tid] = 0u;
    __syncthreads();
    const int lo = args.ph_lo, hi = args.ph_hi;
    const bool use_bar = (hi - lo) > 1;
    XcdBarrier bar; bar.bar = (unsigned*)(F.ctl + CW_BAR) + args.li * XCD_BAR_WORDS; bar.x = 0; bar.st = nullptr;
    if (use_bar) bar = xcd_barrier_post((unsigned*)(F.ctl + CW_BAR) + args.li * XCD_BAR_WORDS, F.MISC + 8);
#define IN(k) (lo <= (k) && (k) < hi)
#define SEAM(k) do { if (IN(k) && IN((k) + 1)) xcd_barrier(bar); } while (0)
#define GEMM_PHASE(EPI, A_, B_, N_, K_, E_) do { pg8::Gemm g{A_, B_, M, N_, K_}; pg8::StaticOrder So; So.init(M, N_, F.G, (int)blockIdx.x); \
        pg8::gemm_phase<EPI, pg8::StaticOrder, PG8_ALIGN, PG8_SP2>(F.lds + RING_OFF, g, So, E_); } while (0)
#define GEMM_PHASE_T(EPI, A_, B_, N_, K_, E_) do { pg8::Gemm g{A_, B_, M, N_, K_}; pg8::TailOrder So; So.init(M, N_, F.G, (int)blockIdx.x); \
        pg8::gemm_phase<EPI, pg8::TailOrder, PG8_ALIGN, PG8_SP2>(F.lds + RING_OFF, g, So, E_); } while (0)

    if (IN(0)) { for (int rep = 0; rep < (PROBE_REP == 0 ? 2 : 1); ++rep) p0_prologue(F); } SEAM(0);
    if (IN(1)) { pg8::EpiIn0 E{F.PROJ0, F.SS, C2}; GEMM_PHASE(pg8::EpiIn0, F.XB, F.W_in0, EVEN_IN, D, E); if (PROBE_REP == 1) { GEMM_PHASE(pg8::EpiIn0, F.XB, F.W_in0, EVEN_IN, D, E); } } SEAM(1);
    if (IN(2)) { for (int rep = 0; rep < (PROBE_REP == 2 ? 2 : 1); ++rep) { conv_part(F); if (SB_FAST) sb_fast(F); else sb_naive(F); __syncthreads(); p2_weights(F); } } SEAM(2);
    if (IN(3)) { pg8::EpiRes E{F.XB, nullptr, F.SS + M}; GEMM_PHASE(pg8::EpiRes, F.ATT, F.W_out0, D, D, E); } SEAM(3);
    if (IN(4)) { pg8::EpiGU E{F.H, F.SS + M}; GEMM_PHASE(pg8::EpiGU, F.XB, F.W_gu0, GU, D, E); late_weights(F, N_EARLY, N_MID); } SEAM(4);
    if (IN(5)) { pg8::EpiRes E{F.XB, nullptr, F.SS + 2 * M}; GEMM_PHASE(pg8::EpiRes, F.H, F.W_dn0, D, FF, E); } SEAM(5);
    if (IN(6)) { LAS float* gl = (LAS float*)(F.lds + 131072 + 1024); if (F.tid < 64) { gl[F.tid] = F.od_q_gain[F.tid]; gl[64 + F.tid] = F.od_k_gain[F.tid]; } __syncthreads();
        pg8::EpiIn1 E{F.Q1, F.K1, F.V1, F.QI, F.KI, F.WI, F.SS + 2 * M, gl, gl + 64, C2}; GEMM_PHASE_T(pg8::EpiIn1, F.XB, F.W_in1, (P6_MINI ? 2048 : ODD_PAD), D, E); if (P6_MINI) p6_mini(F); late_weights(F, N_MID, NITEMS); } SEAM(6);
    if (IN(7)) { for (int rep = 0; rep < (PROBE_REP == 7 ? 2 : 1); ++rep) { if (IDX_FAST && F.G == 256) { idx_fast<0>(F, F.MASK); if (PROBE_IDX) { __syncthreads(); idx_fast<PROBE_IDX>(F, (unsigned long long*)F.XB); } } else idx_naive(F); } } SEAM(7);
    if (IN(8)) { for (int rep = 0; rep < (PROBE_REP == 8 ? 2 : 1); ++rep) { if (F.G != 256) dsa_naive(F); else if (DSA_FAST == 5) { dsa_hand<0>(F, F.ATT); if (PROBE_DSA) { __syncthreads(); dsa_hand<PROBE_DSA>(F, F.XB); } } else if (DSA_FAST == 4) { dsa_pp<0>(F, F.ATT); if (PROBE_DSA) { __syncthreads(); dsa_pp<PROBE_DSA>(F, F.XB); } } else if (DSA_FAST == 3) dsa_pipe(F); else if (DSA_FAST == 2) dsa_coop(F); else if (DSA_FAST) dsa_fast(F); else dsa_naive(F); __syncthreads(); } } SEAM(8);
    if (IN(9)) { pg8::EpiRes E{F.XB, nullptr, F.SS + 3 * M}; GEMM_PHASE(pg8::EpiRes, F.ATT, F.W_out1, D, D, E); } SEAM(9);
    if (IN(10)) { pg8::EpiGU E{F.H, F.SS + 3 * M}; GEMM_PHASE_T(pg8::EpiGU, F.XB, F.W_gu1, GU, D, E); } SEAM(10);
    if (IN(11)) { pg8::EpiRes E{F.XB, F.out, nullptr}; GEMM_PHASE(pg8::EpiRes, F.H, F.W_dn1, D, FF, E); }
#undef IN
#undef SEAM
#undef GEMM_PHASE
#undef GEMM_PHASE_T
}

extern "C" void kernel_launch(void* const* d_in, const int* in_sizes, int n_in, void* d_out, int out_size, void* d_ws, size_t ws_size, hipStream_t stream) {
    static int grid = 0;
    if (grid == 0) {
        if (n_in != 14 || in_sizes[0] != M * D || out_size != M * D || ws_size < WS_END) { fprintf(stderr, "kernel_launch: unexpected shapes (n_in %d, in0 %d, out %d, ws %zu); nothing launched\n", n_in, n_in > 0 ? in_sizes[0] : -1, out_size, ws_size); grid = -1; return; }
        int dev = 0, cus = 0, per_cu = 0;
        if (hipGetDevice(&dev) != hipSuccess || hipDeviceGetAttribute(&cus, hipDeviceAttributeMultiprocessorCount, dev) != hipSuccess) { grid = -1; return; }
        if (hipFuncSetAttribute((const void*)hybrid_fwd, hipFuncAttributeMaxDynamicSharedMemorySize, LDS_BYTES) != hipSuccess) { fprintf(stderr, "kernel_launch: hipFuncSetAttribute failed\n"); grid = -1; return; }
        if (hipOccupancyMaxActiveBlocksPerMultiprocessor(&per_cu, (const void*)hybrid_fwd, NWAVES * 64, LDS_BYTES) != hipSuccess || per_cu < 1) fprintf(stderr, "kernel_launch: note: occupancy query reports %d workgroups per CU\n", per_cu);
        (void)hipGetLastError();
        grid = cus;
    }
    if (grid < 0) return;
    if (hipMemsetAsync((char*)d_ws + WS_CTL, 0, CTL_ZERO_BYTES, stream) != hipSuccess) return;
    Args a{};
    for (int i = 0; i < 14; ++i) a.in[i] = (const float*)d_in[i];
    a.out = (float*)d_out; a.ws = (unsigned char*)d_ws;
#if MK_ONE_LAUNCH
    a.ph_lo = 0; a.ph_hi = NPH; a.li = 0;
    hipLaunchKernelGGL(hybrid_fwd, dim3(grid), dim3(NWAVES * 64), LDS_BYTES, stream, a);
#else
    for (int p = 0; p < NPH; ++p) { a.ph_lo = p; a.ph_hi = p + 1; a.li = p; hipLaunchKernelGGL(hybrid_fwd, dim3(grid), dim3(NWAVES * 64), LDS_BYTES, stream, a); }
#endif
}
```

```cpp
#include <hip/hip_runtime.h>
#include <cstdio>
#include <cstdint>
#include <cmath>
namespace pg8 {
#define PG8_LAS __attribute__((address_space(3)))
typedef unsigned short bf16_t;
typedef short bf16x8 __attribute__((ext_vector_type(8)));
typedef float f32x4 __attribute__((ext_vector_type(4)));
typedef unsigned u32x4 __attribute__((ext_vector_type(4)));
constexpr int BM = 256, BK = 64, HALF = 128, HTB = HALF * BK * 2  , STAGE_BYTES = 8 * HTB, NXCD = 8, WGM = 8;

__host__ __device__ __forceinline__ int lds_byte(int r, int c) { const int st = (r >> 4) * 2 + (c >> 5), rr = r & 15, cc = c & 31, ob = rr * 64 + cc * 2; return st * 1024 + (ob ^ (((ob >> 9) & 1) << 5)); }
__host__ __device__ __forceinline__ void stage_rc(int b, int& R, int& C) { const int st = b / 1024, sb = b % 1024, swz = sb ^ (((sb >> 9) & 1) << 5); R = (st >> 1) * 16 + swz / 64; C = (st & 1) * 32 + (swz % 64) / 2; }
__host__ __device__ __forceinline__ int perm32(int rho) { const int n = rho >> 4, i = rho & 15; return 8 * (i >> 2) + 4 * n + (i & 3); }

struct Unit { int pm, pn, half; };
struct Gemm { const bf16_t* A; const bf16_t* Bt; int M, N, K; };

struct StaticOrder {
    static constexpr bool HAS_HALF = false;
    int nM, nN, nwg, G, c;
    __host__ __device__ void init(int M, int N, int G_, int c_) { nM = M / BM; nN = N / BM; nwg = nM * nN; G = G_; c = c_; }
    __host__ __device__ __forceinline__ bool next(int i, Unit& u) const { return at((long)i * G + c, u); }
    __host__ __device__ __forceinline__ bool at(long L, Unit& u) const {
        if (L >= nwg) return false;
        int wgid = (int)L; { const int q = nwg / NXCD, r = nwg % NXCD, xcd = wgid % NXCD, off = wgid / NXCD; wgid = (xcd < r ? xcd * (q + 1) : r * (q + 1) + (xcd - r) * q) + off; }
        const int nig = WGM * nN, gid = wgid / nig, fm = gid * WGM, gsz = (nM - fm) < WGM ? (nM - fm) : WGM;
        u.pm = fm + ((wgid % nig) % gsz); u.pn = (wgid % nig) / gsz; u.half = 0; return true;
    }
    __device__ __forceinline__ void a_ready(const Unit&) const {}
    __device__ __forceinline__ void done(const Unit&) const {}
};
struct TailOrder {
    static constexpr bool HAS_HALF = true;
    StaticOrder so; int R, rem;
    __host__ __device__ __forceinline__ void init(int M, int N, int G_, int c_) { so.init(M, N, G_, c_); R = so.nwg / G_; rem = so.nwg % G_; if (2 * rem > G_) { R += 1; rem = 0; } }
    __host__ __device__ __forceinline__ bool next(int i, Unit& u) const {
        if (i < R) return so.next(i, u);
        if (i > R || so.c >= 2 * rem) return false;
        if (!so.at((long)R * so.G + (so.c >> 1), u)) return false; u.half = 1 + (so.c & 1); return true;
    }
    __device__ __forceinline__ void a_ready(const Unit&) const {}
    __device__ __forceinline__ void done(const Unit&) const {}
};
__device__ __forceinline__ unsigned cvt_pk_bf16(float lo, float hi) { unsigned r; asm volatile("v_cvt_pk_bf16_f32 %0, %1, %2" : "=v"(r) : "v"(lo), "v"(hi)); return r; }
typedef float f32x2 __attribute__((ext_vector_type(2)));
constexpr float NORM_EPS = 1e-6f, LOG2E = 1.4426950408889634f;
__device__ __forceinline__ u32x4 pack8(const f32x4 a, const f32x4 b) { u32x4 w; w.x = cvt_pk_bf16(a[0], a[1]); w.y = cvt_pk_bf16(a[2], a[3]); w.z = cvt_pk_bf16(b[0], b[1]); w.w = cvt_pk_bf16(b[2], b[3]); return w; }
__device__ __forceinline__ float row_rstd(const float* ss, int row) { return __builtin_amdgcn_rsqf(ss[row] * (1.0f / 1024.0f) + NORM_EPS); }
__device__ __forceinline__ float dot4(const f32x4 a) { return (a[0] * a[0] + a[1] * a[1]) + (a[2] * a[2] + a[3] * a[3]); }

struct EpiIn0 {
    static constexpr bool PERM = true, AFTER_DRAIN = false, PRE = true;
    bf16_t* O; const float* ss; float c2;
    __device__ __forceinline__ void pre(const Unit& u, int wr, int fr, float (&rs)[8]) const { const int row0 = u.pm * BM + wr * 64 + fr;
#pragma unroll
        for (int i = 0; i < 8; ++i) rs[i] = ss[row0 + (i >> 2) * HALF + (i & 3) * 16]; }
    __device__ __forceinline__ void operator()(const f32x4 (&acc)[2][2][4][2], const Unit& u, int wr, int wc, int fr, int fq, const float (&rs)[8]) const {
        const int row0 = u.pm * BM + wr * 64 + fr, col0 = u.pn * BM + wc * 32 + 8 * fq; const float cs = (u.pn < 2) ? c2 : 1.f;
#pragma unroll
        for (int ai = 0; ai < 2; ++ai)
#pragma unroll
            for (int m = 0; m < 4; ++m) { const int row = row0 + ai * HALF + m * 16; const float s = __builtin_amdgcn_rsqf(rs[ai * 4 + m] * (1.0f / 1024.0f) + NORM_EPS) * cs; bf16_t* rowp = O + (size_t)row * 3072 + col0;
#pragma unroll
                for (int bj = 0; bj < 2; ++bj) *(u32x4*)(rowp + bj * HALF) = pack8(acc[ai][bj][m][0] * s, acc[ai][bj][m][1] * s); }
    }
};
__device__ __forceinline__ f32x4 bf4lo(const u32x4 w) { f32x4 r; r[0] = __builtin_bit_cast(float, w.x << 16); r[1] = __builtin_bit_cast(float, w.x & 0xffff0000u); r[2] = __builtin_bit_cast(float, w.y << 16); r[3] = __builtin_bit_cast(float, w.y & 0xffff0000u); return r; }
__device__ __forceinline__ f32x4 bf4hi(const u32x4 w) { f32x4 r; r[0] = __builtin_bit_cast(float, w.z << 16); r[1] = __builtin_bit_cast(float, w.z & 0xffff0000u); r[2] = __builtin_bit_cast(float, w.w << 16); r[3] = __builtin_bit_cast(float, w.w & 0xffff0000u); return r; }
struct EpiRes {
    static constexpr bool PERM = true, AFTER_DRAIN = false, PRE = false;
    bf16_t* xb; float* out; float* ssn;
    __device__ __forceinline__ void operator()(const f32x4 (&acc)[2][2][4][2], const Unit& u, int wr, int wc, int fr, int fq) const {
        const int row0 = u.pm * BM + wr * 64 + fr, col0 = u.pn * BM + wc * 32 + 8 * fq;
#pragma unroll
        for (int ai = 0; ai < 2; ++ai)
#pragma unroll
            for (int m = 0; m < 4; ++m) { const int row = row0 + ai * HALF + m * 16; const size_t off = (size_t)row * 1024 + col0; float q = 0.f;
#pragma unroll
                for (int bj = 0; bj < 2; ++bj) { const u32x4 bw = *(const u32x4*)(xb + off + bj * HALF);
                    const f32x4 o0 = bf4lo(bw) + acc[ai][bj][m][0], o1 = bf4hi(bw) + acc[ai][bj][m][1];
                    if (out) { *(f32x4*)(out + off + bj * HALF) = o0; *(f32x4*)(out + off + bj * HALF + 4) = o1; }
                    else *(u32x4*)(xb + off + bj * HALF) = pack8(o0, o1);
                    q += dot4(o0) + dot4(o1); }
                if (ssn) { q += __shfl_xor(q, 16); q += __shfl_xor(q, 32); if (fq == 0) unsafeAtomicAdd(ssn + row, q); } }
    }
};
struct EpiGU {
    static constexpr bool PERM = true, AFTER_DRAIN = false, PRE = true;
    bf16_t* H; const float* ss;
    __device__ __forceinline__ void pre(const Unit& u, int wr, int fr, float (&rs)[8]) const { const int row0 = u.pm * BM + (u.half == 2 ? HALF : 0) + wr * 64 + fr;
#pragma unroll
        for (int i = 0; i < 8; ++i) rs[i] = ss[row0 + ((i >> 2) && !u.half ? HALF : 0) + (i & 3) * 16]; }
    __device__ __forceinline__ void operator()(const f32x4 (&acc)[2][2][4][2], const Unit& u, int wr, int wc, int fr, int fq, const float (&rs)[8]) const {
        const int row0 = u.pm * BM + (u.half == 2 ? HALF : 0) + wr * 64 + fr, col0 = u.pn * HALF + wc * 32 + 8 * fq;
#pragma unroll
        for (int ai = 0; ai < 2; ++ai)
#pragma unroll
            for (int m = 0; m < 4; ++m) { if (ai == 1 && u.half) continue; const int row = row0 + ai * HALF + m * 16; const float s = __builtin_amdgcn_rsqf(rs[ai * 4 + m] * (1.0f / 1024.0f) + NORM_EPS); f32x4 h[2];
#pragma unroll
                for (int n = 0; n < 2; ++n) { const f32x4 g = acc[ai][0][m][n] * s, uu = acc[ai][1][m][n] * s;
#pragma unroll
                    for (int i = 0; i < 4; ++i) { const float e = __builtin_amdgcn_exp2f(g[i] * (-LOG2E)); h[n][i] = g[i] * uu[i] * __builtin_amdgcn_rcpf(1.0f + e); } }
                *(u32x4*)(H + (size_t)row * 2816 + col0) = pack8(h[0], h[1]); }
    }
};
struct EpiIn1 {
    static constexpr bool PERM = true, AFTER_DRAIN = false, PRE = true;
    bf16_t *Q, *Kk, *V, *QI, *KI; float* WI; const float* ss; const PG8_LAS float* qg; const PG8_LAS float* kg; float c2;
    __device__ __forceinline__ void pre(const Unit& u, int wr, int fr, float (&rs)[8]) const { const int row0 = u.pm * BM + (u.half == 2 ? HALF : 0) + wr * 64 + fr;
#pragma unroll
        for (int i = 0; i < 8; ++i) rs[i] = ss[row0 + ((i >> 2) && !u.half ? HALF : 0) + (i & 3) * 16]; }
    __device__ __forceinline__ void operator()(const f32x4 (&acc)[2][2][4][2], const Unit& u, int wr, int wc, int fr, int fq, const float (&rs)[8]) const {
        const int row0 = u.pm * BM + (u.half == 2 ? HALF : 0) + wr * 64 + fr, pn = u.pn;
        if (pn <= 4) {
            const PG8_LAS float* gs = (pn < 4) ? qg : kg; const float gm = (pn < 4) ? c2 : 1.f; f32x4 gv[2][2];
#pragma unroll
            for (int bj = 0; bj < 2; ++bj)
#pragma unroll
                for (int n = 0; n < 2; ++n) gv[bj][n] = *(const PG8_LAS f32x4*)(gs + 32 * bj + 8 * fq + 4 * n) * gm;
#pragma unroll
            for (int ai = 0; ai < 2; ++ai)
#pragma unroll
                for (int m = 0; m < 4; ++m) { if (ai == 1 && u.half) continue; const int row = row0 + ai * HALF + m * 16; const float s = __builtin_amdgcn_rsqf(rs[ai * 4 + m] * (1.0f / 1024.0f) + NORM_EPS); f32x4 v[2][2]; float q = 0.f;
#pragma unroll
                    for (int bj = 0; bj < 2; ++bj)
#pragma unroll
                        for (int n = 0; n < 2; ++n) { v[bj][n] = acc[ai][bj][m][n] * s; q += dot4(v[bj][n]); }
                    q += __shfl_xor(q, 16); q += __shfl_xor(q, 32);
                    const float rn = __builtin_amdgcn_rsqf(q * (1.0f / 64.0f) + NORM_EPS);
                    bf16_t* dst = (pn < 4) ? Q + (size_t)row * 1024 + pn * 256 + wc * 64 + 8 * fq : Kk + (size_t)row * 256 + wc * 64 + 8 * fq;
#pragma unroll
                    for (int bj = 0; bj < 2; ++bj) *(u32x4*)(dst + bj * 32) = pack8(v[bj][0] * rn * gv[bj][0], v[bj][1] * rn * gv[bj][1]); }
        } else {
#pragma unroll
            for (int ai = 0; ai < 2; ++ai)
#pragma unroll
                for (int m = 0; m < 4; ++m) { if (ai == 1 && u.half) continue; const int row = row0 + ai * HALF + m * 16; const float s = __builtin_amdgcn_rsqf(rs[ai * 4 + m] * (1.0f / 1024.0f) + NORM_EPS);
                    if (pn == 8) {
                        if (wc == 0) {
#pragma unroll
                            for (int bj = 0; bj < 2; ++bj) *(u32x4*)(KI + (size_t)row * 64 + bj * 32 + 8 * fq) = pack8(acc[ai][bj][m][0] * s, acc[ai][bj][m][1] * s);
                        } else if (wc == 1 && fq == 0) { *(f32x4*)(WI + (size_t)row * 8) = acc[ai][0][m][0] * s; *(f32x4*)(WI + (size_t)row * 8 + 4) = acc[ai][0][m][1] * s; }
                    } else {
                        bf16_t* dst = (pn == 5) ? V + (size_t)row * 256 + wc * 64 + 8 * fq : QI + (size_t)row * 512 + (pn - 6) * 256 + wc * 64 + 8 * fq;
#pragma unroll
                        for (int bj = 0; bj < 2; ++bj) *(u32x4*)(dst + bj * 32) = pack8(acc[ai][bj][m][0] * s, acc[ai][bj][m][1] * s);
                    } }
        }
    }
};
template <class Epi, class Sched, bool ALIGN_EPI = false, bool SP2 = false>
__device__ __forceinline__ void gemm_phase(PG8_LAS unsigned char* lds, const Gemm g, const Sched& S, const Epi& E) {
    const int tid = threadIdx.x, wid = __builtin_amdgcn_readfirstlane(tid >> 6), lane = tid & 63, wr = wid >> 2, wc = wid & 3, fr = lane & 15, fq = lane >> 4;
    const int K = g.K, nt = K / BK;
    unsigned voffA[2], voffB[2];
#pragma unroll
    for (int i = 0; i < 2; ++i) { int R, C; stage_rc(tid * 16 + i * 8192, R, C); const int Rb = Epi::PERM ? ((R & ~31) + perm32(R & 31)) : R;
        voffA[i] = (unsigned)(R * K + C) * 2u; voffB[i] = (unsigned)(Rb * K + C) * 2u; }
    const size_t kstep = (size_t)(BK * 2);
    const size_t hstep = (size_t)HALF * K * 2;
    const size_t tstep = 2 * hstep;
    const unsigned ldsw = (unsigned)wid * 1024u;
    const int aoff = lds_byte(wr * 64 + fr, fq * 8), boff = lds_byte(wc * 32 + fr, fq * 8);
#define PG8_SA(b, h) (((b) * 2 + (h)) * HTB)
#define PG8_SB(b, h) ((4 + (b) * 2 + (h)) * HTB)
#define PG8_STAGE(bufoff, gbase, voff) do { _Pragma("unroll") for (int _i = 0; _i < 2; ++_i) \
        __builtin_amdgcn_global_load_lds((const unsigned*)((const char*)(gbase) + (voff)[_i]), (PG8_LAS unsigned*)(lds + (bufoff) + ldsw + _i * 8192), 16, 0, 0); } while (0)
#define PG8_LDA(dst, b, h) do { _Pragma("unroll") for (int m = 0; m < 4; ++m) _Pragma("unroll") for (int k = 0; k < 2; ++k) dst[m][k] = *(const PG8_LAS bf16x8*)(lds + PG8_SA(b, h) + aoff + m * 2048 + k * 1024); } while (0)
#define PG8_LDB(dst, b, h) do { _Pragma("unroll") for (int n = 0; n < 2; ++n) _Pragma("unroll") for (int k = 0; k < 2; ++k) dst[n][k] = *(const PG8_LAS bf16x8*)(lds + PG8_SB(b, h) + boff + n * 2048 + k * 1024); } while (0)
#define PG8_MMA(ai, bj, At, Bt) do { __builtin_amdgcn_s_setprio(1); _Pragma("unroll") for (int m = 0; m < 4; ++m) _Pragma("unroll") for (int n = 0; n < 2; ++n) _Pragma("unroll") for (int k = 0; k < 2; ++k) \
        acc[ai][bj][m][n] = __builtin_amdgcn_mfma_f32_16x16x32_bf16(Bt[n][k], At[m][k], acc[ai][bj][m][n], 0, 0, 0); __builtin_amdgcn_s_setprio(0); } while (0)
#define PG8_WAIT_V(n) asm volatile("s_waitcnt vmcnt(" #n ")" ::: "memory")
#define PG8_WAIT_L(n) asm volatile("s_waitcnt lgkmcnt(" #n ")" ::: "memory")
#define PG8_BAR __builtin_amdgcn_s_barrier()
#define PG8_SCHED __builtin_amdgcn_sched_barrier(0)
    Unit cur, nxt; int ui = 0;
    if (!S.next(0, cur)) return;
    f32x4 acc[2][2][4][2];
#pragma unroll
    for (int a = 0; a < 2; ++a)
#pragma unroll
        for (int b = 0; b < 2; ++b)
#pragma unroll
            for (int m = 0; m < 4; ++m)
#pragma unroll
                for (int n = 0; n < 2; ++n) acc[a][b][m][n] = (f32x4){0.f, 0.f, 0.f, 0.f};
    bf16x8 At[4][2], B0[2][2], B1[2][2];
    const char* cA = (const char*)g.A + (size_t)cur.pm * tstep + ((Sched::HAS_HALF && cur.half == 2) ? hstep : 0); const char* cB = (const char*)g.Bt + (size_t)cur.pn * tstep;
    unsigned cHs = (Sched::HAS_HALF && cur.half) ? 0u : (unsigned)hstep;
    S.a_ready(cur);
    float rs8[8];
    if constexpr (Epi::PRE) E.pre(cur, wr, fr, rs8);
    if constexpr (SP2) {
        PG8_STAGE(PG8_SB(0, 0), cB, voffB); PG8_STAGE(PG8_SB(0, 1), cB + hstep, voffB); PG8_STAGE(PG8_SA(0, 0), cA, voffA); PG8_STAGE(PG8_SA(0, 1), cA + cHs, voffA);
        if (wr == 1) PG8_BAR;
        PG8_WAIT_V(2); PG8_BAR;
        PG8_STAGE(PG8_SB(1, 0), cB + kstep, voffB); PG8_STAGE(PG8_SA(1, 0), cA + kstep, voffA); PG8_STAGE(PG8_SB(1, 1), cB + hstep + kstep, voffB);
        PG8_WAIT_V(6); PG8_BAR;
    } else {
        PG8_STAGE(PG8_SB(0, 0), cB, voffB); PG8_STAGE(PG8_SA(0, 0), cA, voffA); PG8_STAGE(PG8_SB(0, 1), cB + hstep, voffB); PG8_STAGE(PG8_SA(0, 1), cA + hstep, voffA);
        if (wr == 1) PG8_BAR;
        PG8_WAIT_V(4); PG8_BAR;
        PG8_STAGE(PG8_SB(1, 0), cB + kstep, voffB); PG8_STAGE(PG8_SA(1, 0), cA + kstep, voffA); PG8_STAGE(PG8_SB(1, 1), cB + hstep + kstep, voffB);
        PG8_WAIT_V(6); PG8_BAR;
    }
    for (;;) {
        const bool has_next = S.next(ui + 1, nxt);
        const char* nA = has_next ? (const char*)g.A + (size_t)nxt.pm * tstep + ((Sched::HAS_HALF && nxt.half == 2) ? hstep : 0) : cA; const char* nB = has_next ? (const char*)g.Bt + (size_t)nxt.pn * tstep : cB;
        const unsigned nHs = has_next ? ((Sched::HAS_HALF && nxt.half) ? 0u : (unsigned)hstep) : cHs;
        for (int t = 0; t < nt; t += 2) {
            const bool last = (t == nt - 2);
            const char* a1 = cA + (size_t)(t + 1) * kstep;
            const char* a2 = last ? nA : cA + (size_t)(t + 2) * kstep; const char* b2 = last ? nB : cB + (size_t)(t + 2) * kstep;
            const char* a3 = a2 + kstep; const char* b3 = b2 + kstep;
            const unsigned hs2 = last ? nHs : cHs;
            if (last && has_next) S.a_ready(nxt);
            if constexpr (SP2) {
            PG8_LDB(B0, 0, 0); PG8_LDB(B1, 0, 1); PG8_SCHED; PG8_LDA(At, 0, 0); PG8_STAGE(PG8_SA(1, 1), a1 + cHs, voffA);
            PG8_WAIT_V(8); PG8_WAIT_L(0); PG8_BAR; PG8_MMA(0, 0, At, B0); PG8_MMA(0, 1, At, B1); PG8_BAR; PG8_SCHED;
            PG8_LDA(At, 0, 1); PG8_STAGE(PG8_SB(0, 0), b2, voffB); PG8_STAGE(PG8_SB(0, 1), b2 + hstep, voffB); PG8_STAGE(PG8_SA(0, 0), a2, voffA);
            PG8_WAIT_V(8); PG8_WAIT_L(0); PG8_BAR; if (!(Sched::HAS_HALF && cur.half)) { PG8_MMA(1, 0, At, B0); PG8_MMA(1, 1, At, B1); } PG8_BAR; PG8_SCHED;
            PG8_LDB(B0, 1, 0); PG8_LDB(B1, 1, 1); PG8_SCHED; PG8_LDA(At, 1, 0); PG8_STAGE(PG8_SA(0, 1), a2 + hs2, voffA);
            PG8_WAIT_V(8); PG8_WAIT_L(0); PG8_BAR; PG8_MMA(0, 0, At, B0); PG8_MMA(0, 1, At, B1); PG8_BAR; PG8_SCHED;
            PG8_LDA(At, 1, 1); PG8_STAGE(PG8_SB(1, 0), b3, voffB); PG8_STAGE(PG8_SB(1, 1), b3 + hstep, voffB); PG8_STAGE(PG8_SA(1, 0), a3, voffA);
            PG8_WAIT_V(8); PG8_WAIT_L(0); PG8_BAR; if (!(Sched::HAS_HALF && cur.half)) { PG8_MMA(1, 0, At, B0); PG8_MMA(1, 1, At, B1); } PG8_BAR; PG8_SCHED;
            } else {
            PG8_LDB(B0, 0, 0); PG8_SCHED; PG8_LDA(At, 0, 0); PG8_STAGE(PG8_SA(1, 1), a1 + hstep, voffA);
            PG8_WAIT_L(8); PG8_BAR; PG8_WAIT_L(0); PG8_MMA(0, 0, At, B0); PG8_BAR; PG8_SCHED;
            PG8_LDB(B1, 0, 1); PG8_STAGE(PG8_SB(0, 0), b2, voffB);
            PG8_BAR; PG8_WAIT_L(0); PG8_MMA(0, 1, At, B1); PG8_BAR;
            PG8_LDA(At, 0, 1); PG8_STAGE(PG8_SA(0, 0), a2, voffA);
            PG8_BAR; PG8_WAIT_L(0); PG8_MMA(1, 0, At, B0); PG8_BAR; PG8_SCHED;
            PG8_STAGE(PG8_SB(0, 1), b2 + hstep, voffB);
            PG8_WAIT_V(6); PG8_BAR; PG8_MMA(1, 1, At, B1); PG8_BAR;
            PG8_LDB(B0, 1, 0); PG8_SCHED; PG8_LDA(At, 1, 0); PG8_STAGE(PG8_SA(0, 1), a2 + hstep, voffA);
            PG8_WAIT_L(8); PG8_BAR; PG8_WAIT_L(0); PG8_MMA(0, 0, At, B0); PG8_BAR; PG8_SCHED;
            PG8_LDB(B1, 1, 1); PG8_STAGE(PG8_SB(1, 0), b3, voffB);
            PG8_BAR; PG8_WAIT_L(0); PG8_MMA(0, 1, At, B1); PG8_BAR;
            PG8_LDA(At, 1, 1); PG8_STAGE(PG8_SA(1, 0), a3, voffA);
            PG8_BAR; PG8_WAIT_L(0); PG8_MMA(1, 0, At, B0); PG8_BAR; PG8_SCHED;
            PG8_STAGE(PG8_SB(1, 1), b3 + hstep, voffB);
            PG8_WAIT_V(6); PG8_BAR; PG8_MMA(1, 1, At, B1); PG8_BAR;
            }
        }
        if constexpr (ALIGN_EPI) { if (wr == 0) PG8_BAR; }
        if constexpr (!Epi::AFTER_DRAIN) { if constexpr (Epi::PRE) E(acc, cur, wr, wc, fr, fq, rs8); else E(acc, cur, wr, wc, fr, fq); S.done(cur); }
        if (!has_next) break;
#pragma unroll
        for (int a = 0; a < 2; ++a)
#pragma unroll
            for (int b = 0; b < 2; ++b)
#pragma unroll
                for (int m = 0; m < 4; ++m)
#pragma unroll
                    for (int n = 0; n < 2; ++n) acc[a][b][m][n] = (f32x4){0.f, 0.f, 0.f, 0.f};
        cur = nxt; cA = nA; cB = nB; cHs = nHs; ++ui;
        if constexpr (Epi::PRE) E.pre(cur, wr, fr, rs8);
        if constexpr (ALIGN_EPI) { if (wr == 1) PG8_BAR; }
    }
    PG8_WAIT_V(0);
    if constexpr (!ALIGN_EPI) { if (wr == 0) PG8_BAR; }
    PG8_BAR;
    if constexpr (Epi::AFTER_DRAIN) { E.fused(acc, cur, wr, wc, fr, fq, lds, wid, lane); S.done(cur); }
#undef PG8_SA
#undef PG8_SB
#undef PG8_STAGE
#undef PG8_LDA
#undef PG8_LDB
#undef PG8_MMA
#undef PG8_WAIT_V
#undef PG8_WAIT_L
#undef PG8_BAR
#undef PG8_SCHED
}
}
#ifndef PG8_SP2
#define PG8_SP2 true
#endif
#ifndef PG8_ALIGN
#define PG8_ALIGN true
#endif
constexpr int NWAVES = 8;
#ifndef MK_ONE_LAUNCH
#define MK_ONE_LAUNCH 1
#endif
#ifndef SB_FAST
#define SB_FAST 2
#endif
#ifndef IDX_FAST
#define IDX_FAST 1
#endif
#ifndef DSA_FAST
#define DSA_FAST 2
#endif
#ifndef P6_MINI
#define P6_MINI 0
#endif
#ifndef PROBE_IDX
#define PROBE_IDX 0
#endif
#ifndef PROBE_DSA
#define PROBE_DSA 0
#endif
#ifndef PROBE_REP
#define PROBE_REP -1
#endif
constexpr int NPH = 12;

constexpr int BATCH = 8, S = 2048, D = 1024, M = BATCH * S;
constexpr int EVEN_IN = 3072, ODD_IN = 2120, ODD_PAD = 2304, FF = 2816, GU = 2 * FF;
constexpr int TOPK = 256;
constexpr float C2 = 0.125f * 1.4426950408889634f;

constexpr size_t MiB = 1u << 20;
constexpr size_t WS_CTL = 0, CTL_ZERO_BYTES = MiB / 2;
constexpr size_t WS_W_IN0 = 1 * MiB, WS_W_OUT0 = 7 * MiB, WS_W_GU0 = 9 * MiB, WS_W_DN0 = 20 * MiB, WS_W_IN1 = 26 * MiB, WS_W_OUT1 = 31 * MiB, WS_W_GU1 = 33 * MiB, WS_W_DN1 = 44 * MiB;
constexpr size_t WS_XB = 50 * MiB;
constexpr size_t WS_ATT = 82 * MiB;
constexpr size_t WS_BIG = 114 * MiB;
constexpr size_t WS_PROJ0 = WS_BIG;
constexpr size_t WS_H = WS_BIG;
constexpr size_t WS_Q1 = WS_BIG, WS_K1 = WS_BIG + 32 * MiB, WS_V1 = WS_BIG + 40 * MiB, WS_QI = WS_BIG + 48 * MiB, WS_KI = WS_BIG + 64 * MiB, WS_WI = WS_BIG + 66 * MiB, WS_MASK = WS_BIG + 68 * MiB;
constexpr size_t WS_END = 256 * MiB;
static_assert(WS_W_DN1 + (size_t)D * FF * 2 <= WS_XB && WS_PROJ0 + (size_t)M * EVEN_IN * 2 <= WS_END && WS_MASK + (size_t)M * 256 <= WS_END, "d_ws map");
constexpr int CW_BAR = 4096;
constexpr int CW_SS = 65536;

#define GAS __attribute__((address_space(1)))
#define LAS __attribute__((address_space(3)))
typedef unsigned short bf16;
typedef unsigned v4u __attribute__((ext_vector_type(4)));
typedef float f32x4 __attribute__((ext_vector_type(4)));
typedef short bf16x8 __attribute__((ext_vector_type(8)));
typedef GAS unsigned gu32;
#define RLX_AGENT __ATOMIC_RELAXED, __HIP_MEMORY_SCOPE_AGENT
#define LDS_WAIT() asm volatile("s_waitcnt lgkmcnt(0)" ::: "memory")
#define VM_WAIT() asm volatile("s_waitcnt vmcnt(0)" ::: "memory")
__device__ __forceinline__ unsigned f2bf(float f) { unsigned u = __builtin_bit_cast(unsigned, f); return (u + 0x7fffu + ((u >> 16) & 1u)) >> 16; }
__device__ __forceinline__ unsigned pk2(float lo, float hi) { return f2bf(lo) | (f2bf(hi) << 16); }
__device__ __forceinline__ float bf2f(unsigned short b) { return __builtin_bit_cast(float, (unsigned)b << 16); }
__device__ __forceinline__ float bflo(unsigned w) { return __builtin_bit_cast(float, w << 16); }
__device__ __forceinline__ float bfhi(unsigned w) { return __builtin_bit_cast(float, w & 0xffff0000u); }
#define XB_TMO      128
#define XB_XCNT(j)  (256  + 64 * (j))
#define XB_XSUB(j)  (1280 + 64 * (j))
#define XB_XGEN(j)  (2304 + 64 * (j))
#define XB_TOP      3328
#define XB_TOPGEN   3392
#define XCD_BAR_WORDS 3456
#define XB_SPIN_CAP (1u << 18)

__device__ __forceinline__ unsigned xb_ld(unsigned* p)              { return __hip_atomic_load(p, __ATOMIC_RELAXED, __HIP_MEMORY_SCOPE_AGENT); }
__device__ __forceinline__ unsigned xb_add(unsigned* p, unsigned v) { return __hip_atomic_fetch_add(p, v, __ATOMIC_RELAXED, __HIP_MEMORY_SCOPE_AGENT); }
__device__ __forceinline__ unsigned xb_xcc_id() { return (unsigned)__builtin_amdgcn_s_getreg((3 << 11) | 20) & 0xFu; }
#define XB_SPIN(cond, bar) do { unsigned _sp = 0; while (cond) { __builtin_amdgcn_s_sleep(1); \
    if ((++_sp & 255u) == 0u) { if (xb_ld(&(bar)[XB_TMO])) break; if (_sp > XB_SPIN_CAP) { atomicAdd(&(bar)[XB_TMO], 1u); break; } } } } while (0)

struct XcdBarrier {
    unsigned* bar; unsigned x;
    volatile LAS unsigned* st;
};

__device__ __forceinline__ XcdBarrier xcd_barrier_post(unsigned* bar, volatile LAS unsigned* st) {
    XcdBarrier b; b.bar = bar; b.x = xb_xcc_id(); b.st = st;
    if (threadIdx.x == 0) (void)xb_add(&bar[XB_XCNT(b.x)], 1u);
    return b;
}
__device__ __forceinline__ void xcd_barrier_complete(unsigned* bar, unsigned x, unsigned& nloc, unsigned& nx) {
    const unsigned G = gridDim.x * gridDim.y * gridDim.z;
    unsigned sum, cnt, mine, sp = 0u;
    for (;;) {
        sum = 0u; cnt = 0u; mine = 0u;
#pragma unroll
        for (unsigned j = 0; j < 16; ++j) { const unsigned c = xb_ld(&bar[XB_XCNT(j)]); sum += c; cnt += (c > 0u) ? 1u : 0u; mine = (j == x) ? c : mine; }
        if (sum == G) break;
        __builtin_amdgcn_s_sleep(1);
        if ((++sp & 255u) == 0u) { if (xb_ld(&bar[XB_TMO])) break; if (sp > XB_SPIN_CAP) { atomicAdd(&bar[XB_TMO], 1u); break; } }
    }
    nloc = mine > 0u ? mine : 1u; nx = cnt > 0u ? cnt : 1u;
}

__device__ __forceinline__ void xcd_barrier(const XcdBarrier& b) {
    asm volatile("s_waitcnt vmcnt(0)" ::: "memory");
    __syncthreads();
    if (threadIdx.x == 0) {
        unsigned* bar = b.bar;
        __builtin_amdgcn_s_waitcnt(0);
        unsigned nloc = b.st[0], nx = b.st[1];
        if (nloc == 0u) { xcd_barrier_complete(bar, b.x, nloc, nx); b.st[0] = nloc; b.st[1] = nx; }
        const unsigned old = xb_add(&bar[XB_XSUB(b.x)], 1u);
        const unsigned gen = old / nloc;
        if (old + 1u == (gen + 1u) * nloc) {
            __builtin_amdgcn_fence(__ATOMIC_RELEASE, "agent");
            asm volatile("s_waitcnt vmcnt(0)" ::: "memory");
            const unsigned og = xb_add(&bar[XB_TOP], 1u);
            const unsigned tg = og / nx;
            if (og + 1u == (tg + 1u) * nx) xb_add(&bar[XB_TOPGEN], 1u);
            else XB_SPIN(xb_ld(&bar[XB_TOPGEN]) == tg, bar);
            __builtin_amdgcn_fence(__ATOMIC_ACQUIRE, "agent");
            xb_add(&bar[XB_XGEN(b.x)], 1u);
            asm volatile("s_waitcnt vmcnt(0)" ::: "memory");
        } else {
            XB_SPIN(xb_ld(&bar[XB_XGEN(b.x)]) == gen, bar);
            __builtin_amdgcn_fence(__ATOMIC_ACQUIRE, "agent");
            asm volatile("s_waitcnt vmcnt(0)" ::: "memory");
        }
    }
    __syncthreads();
}
constexpr int RING_OFF = 0, RING_BYTES = 160 * 1024 - 256;
constexpr int MISC_OFF = 160 * 1024 - 256;
constexpr int LDS_BYTES = 160 * 1024;
struct Frame {
    LAS unsigned char* lds; volatile LAS unsigned* MISC; gu32* ctl;
    int tid, lane, wave, vcu, G;
    const float *x, *norm_mix, *norm_ffn, *ev_w_in, *ev_conv_w, *ev_w_out, *od_w_in, *od_q_gain, *od_k_gain, *od_w_out, *rel_bias, *w_gate, *w_up, *w_down;
    float* out; float* SS;
    bf16 *W_in0, *W_out0, *W_gu0, *W_dn0, *W_in1, *W_out1, *W_gu1, *W_dn1;
    bf16 *XB, *ATT, *PROJ0, *H, *Q1, *K1, *V1, *QI, *KI; float* WI; unsigned long long* MASK;
};
__device__ __forceinline__ float wave_sum(float v) {
#pragma unroll
    for (int o = 1; o < 64; o <<= 1) v += __shfl_xor(v, o);
    return v;
}
__device__ __forceinline__ float wave_max(float v) {
#pragma unroll
    for (int o = 1; o < 64; o <<= 1) v = fmaxf(v, __shfl_xor(v, o));
    return v;
}
__device__ __forceinline__ void tr_item(const float* W, int ldw, int sc0, int nvalid, const float* gain, int K, bf16* WT, int drow0, LAS float* scr, int kb, int lane) {
    const int k0 = 64 * kb, c = sc0 + (lane & 31); const bool ok = c < nvalid;
    float v[32];
#pragma unroll
    for (int i = 0; i < 32; ++i) v[i] = ok ? W[(size_t)(k0 + 2 * i + (lane >> 5)) * ldw + c] : 0.f;
    const int ch = lane & 7;
    f32x4 g0 = {1.f, 1.f, 1.f, 1.f}, g1 = g0;
    if (gain) { g0 = *(const f32x4*)(gain + k0 + 8 * ch); g1 = *(const f32x4*)(gain + k0 + 8 * ch + 4); }
#pragma unroll
    for (int i = 0; i < 32; ++i) scr[(2 * i + (lane >> 5)) * 33 + (lane & 31)] = v[i];
    LDS_WAIT(); asm volatile("" ::: "memory");
#pragma unroll
    for (int j = 0; j < 4; ++j) { const int n = (lane >> 3) + 8 * j; const LAS float* s = scr + (8 * ch) * 33 + n;
        v4u o; o.x = pk2(s[0 * 33] * g0[0], s[1 * 33] * g0[1]); o.y = pk2(s[2 * 33] * g0[2], s[3 * 33] * g0[3]); o.z = pk2(s[4 * 33] * g1[0], s[5 * 33] * g1[1]); o.w = pk2(s[6 * 33] * g1[2], s[7 * 33] * g1[3]);
        *(GAS v4u*)(WT + (size_t)(drow0 + n) * K + k0 + 8 * ch) = o; }
    LDS_WAIT(); asm volatile("" ::: "memory");
}
constexpr int I_IN0 = 16 * (EVEN_IN / 32), I_OUT = 16 * 32, I_GU = 16 * (GU / 32), I_DN = (FF / 64) * 32, I_IN1 = 16 * (ODD_PAD / 32);
constexpr int N_P0 = I_IN0 + I_OUT;
constexpr int N_EARLY = I_IN0 + I_OUT + I_GU, NITEMS = N_EARLY + I_DN + I_IN1 + I_OUT + I_GU + I_DN;
__device__ __forceinline__ void gu_item(Frame& F, int L, int r, LAS float* scr) { const int nb = GU / 32, kb = r / nb, db = r % nb, pn = db >> 3, j = db & 7;
    const float* W = ((j < 4) ? F.w_gate : F.w_up) + (size_t)L * D * FF;
    tr_item(W, FF, 128 * pn + 32 * (j & 3), FF, F.norm_ffn + L * D, D, L ? F.W_gu1 : F.W_gu0, 32 * db, scr, kb, F.lane); }
__device__ __forceinline__ void weight_item(Frame& F, int r, LAS float* scr) {
    if (r < I_IN0) { const int nb = EVEN_IN / 32, kb = r / nb, db = r % nb; tr_item(F.ev_w_in, EVEN_IN, 32 * db, EVEN_IN, F.norm_mix, D, F.W_in0, 32 * db, scr, kb, F.lane); return; } r -= I_IN0;
    if (r < I_OUT) { const int kb = r / 32, db = r % 32; tr_item(F.ev_w_out, D, 32 * db, D, nullptr, D, F.W_out0, 32 * db, scr, kb, F.lane); return; } r -= I_OUT;
    if (r < I_GU) { gu_item(F, 0, r, scr); return; } r -= I_GU;
    if (r < I_DN) { const int kb = r / 32, db = r % 32; tr_item(F.w_down, D, 32 * db, D, nullptr, FF, F.W_dn0, 32 * db, scr, kb, F.lane); return; } r -= I_DN;
    if (r < I_IN1) { const int nb = ODD_PAD / 32, kb = r / nb, db = r % nb, pn = db >> 3, bj = (db >> 2) & 1, wc = db & 3;
        tr_item(F.od_w_in, ODD_IN, 256 * pn + 64 * wc + 32 * bj, ODD_IN, F.norm_mix + D, D, F.W_in1, 32 * db, scr, kb, F.lane); return; } r -= I_IN1;
    if (r < I_OUT) { const int kb = r / 32, db = r % 32; tr_item(F.od_w_out, D, 32 * db, D, nullptr, D, F.W_out1, 32 * db, scr, kb, F.lane); return; } r -= I_OUT;
    if (r < I_GU) { gu_item(F, 1, r, scr); return; } r -= I_GU;
    { const int kb = r / 32, db = r % 32; tr_item(F.w_down + (size_t)FF * D, D, 32 * db, D, nullptr, FF, F.W_dn1, 32 * db, scr, kb, F.lane); }
}
constexpr int N_MID = N_EARLY + I_DN + I_IN1 + I_OUT;
__device__ __forceinline__ void late_weights(Frame& F, int lo_it, int hi_it) {
    if (F.G != 256 || (int)blockIdx.x < 128) return;
    LAS float* scr = (LAS float*)(F.lds + RING_OFF + F.wave * 16384);
    for (int it = lo_it + ((int)blockIdx.x - 128) * NWAVES + F.wave; it < hi_it; it += 128 * NWAVES) weight_item(F, it, scr);
}
__device__ __forceinline__ void p2_weights(Frame& F) {
    if (F.G != 256) return;
    LAS float* scr = (LAS float*)(F.lds + RING_OFF + F.wave * 16384);
    for (int it = N_P0 + F.vcu * NWAVES + F.wave; it < N_EARLY; it += F.G * NWAVES) weight_item(F, it, scr);
}
__device__ __forceinline__ void p0_prologue(Frame& F) {
    LAS float* scr = (LAS float*)(F.lds + RING_OFF + F.wave * 16384);
    const int gw = F.vcu * NWAVES + F.wave, NGW = F.G * NWAVES;
    const int nit = (F.G == 256) ? N_P0 : NITEMS;
    for (int it = gw; it < nit; it += NGW) weight_item(F, it, scr);
    for (int m = gw; m < M; m += 2 * NGW) {
        const int m2 = m + NGW; const bool has2 = m2 < M;
        const GAS f32x4* xa = (const GAS f32x4*)(F.x + (size_t)m * D) + F.lane; const GAS f32x4* xb = (const GAS f32x4*)(F.x + (size_t)(has2 ? m2 : m) * D) + F.lane;
        f32x4 va[4], vb[4];
#pragma unroll
        for (int j = 0; j < 4; ++j) { va[j] = xa[64 * j]; vb[j] = xb[64 * j]; }
        GAS unsigned long long* oa = (GAS unsigned long long*)(F.XB + (size_t)m * D) + F.lane; GAS unsigned long long* ob = (GAS unsigned long long*)(F.XB + (size_t)m2 * D) + F.lane; float sa = 0.f, sb = 0.f;
#pragma unroll
        for (int j = 0; j < 4; ++j) { const f32x4 a = va[j], c = vb[j]; sa += (a.x * a.x + a.y * a.y) + (a.z * a.z + a.w * a.w); sb += (c.x * c.x + c.y * c.y) + (c.z * c.z + c.w * c.w);
            oa[64 * j] = (unsigned long long)pk2(a.x, a.y) | ((unsigned long long)pk2(a.z, a.w) << 32); if (has2) ob[64 * j] = (unsigned long long)pk2(c.x, c.y) | ((unsigned long long)pk2(c.z, c.w) << 32); }
        sa = wave_sum(sa); sb = wave_sum(sb); if (F.lane == 0) { F.SS[m] = sa; if (has2) F.SS[m2] = sb; }
    }
}
__device__ __forceinline__ void ld8(const bf16* p, float (&f)[8]) { const v4u w = *(const v4u*)p; f[0] = bflo(w.x); f[1] = bfhi(w.x); f[2] = bflo(w.y); f[3] = bfhi(w.y); f[4] = bflo(w.z); f[5] = bfhi(w.z); f[6] = bflo(w.w); f[7] = bfhi(w.w); }
__device__ __forceinline__ int rel_bucket(int dist) { if (dist < 16) return dist; const int l = 16 + (int)(logf((float)dist * (1.0f / 16.0f)) / logf(8.0f) * 16.0f); return l < 31 ? l : 31; }
__device__ __forceinline__ unsigned ord_key(float f) { unsigned u = __builtin_bit_cast(unsigned, f); if (u == 0x80000000u) u = 0u; return (u & 0x80000000u) ? ~u : (u | 0x80000000u); }
__device__ __forceinline__ void conv_part(Frame& F) {
    const int gt = (F.vcu * NWAVES + F.wave) * 64 + F.lane, NT = F.G * NWAVES * 64;
    for (int it = gt; it < M * 64; it += NT) { const int row = it >> 6, c8 = (it & 63) * 8, t = row & (S - 1);
        float bg[8], y[8]; ld8(F.PROJ0 + (size_t)row * EVEN_IN + 1536 + c8, bg);
#pragma unroll
        for (int i = 0; i < 8; ++i) y[i] = 0.f;
#pragma unroll
        for (int j = 0; j < 3; ++j) { if (t - 2 + j >= 0) { float cg[8], uu[8]; const bf16* p = F.PROJ0 + (size_t)(row - 2 + j) * EVEN_IN; ld8(p + 2048 + c8, cg); ld8(p + 2560 + c8, uu);
#pragma unroll
                for (int i = 0; i < 8; ++i) y[i] += F.ev_conv_w[j * 512 + c8 + i] * (cg[i] * uu[i]); } }
        v4u o; o.x = pk2(bg[0] * y[0], bg[1] * y[1]); o.y = pk2(bg[2] * y[2], bg[3] * y[3]); o.z = pk2(bg[4] * y[4], bg[5] * y[5]); o.w = pk2(bg[6] * y[6], bg[7] * y[7]);
        *(v4u*)(F.ATT + (size_t)row * D + 512 + c8) = o; }
}
__device__ __forceinline__ void sb_naive(Frame& F) {
    const int gw = F.vcu * NWAVES + F.wave, NGW = F.G * NWAVES;
    for (int idx = gw; idx < M * 8; idx += NGW) { const int h = idx & 7, row = idx >> 3, t = row & (S - 1);
        const float qd = bf2f(F.PROJ0[(size_t)row * EVEN_IN + h * 64 + F.lane]); float o = 0.f, carry = 1.f;
        for (int s = t - 1; s >= 0; --s) { const bf16* p = F.PROJ0 + (size_t)(row - t + s) * EVEN_IN + h * 64 + F.lane;
            const float z2 = wave_sum(qd * bf2f(p[512])), e = __builtin_amdgcn_exp2f(z2), a = __builtin_amdgcn_rcpf(1.0f + e), beta = 1.0f - a;
            o += beta * carry * bf2f(p[1024]); carry *= a; if (carry < 7.8886091e-31f) break; }
        F.ATT[(size_t)row * D + h * 64 + F.lane] = (bf16)f2bf(o); }
}
#define TK_CNT8(ACC, B, OP, X) do { unsigned long long q0 = __ballot(key[(B) + 0] OP (X)), q1 = __ballot(key[(B) + 1] OP (X)), q2 = __ballot(key[(B) + 2] OP (X)), q3 = __ballot(key[(B) + 3] OP (X)), \
        q4 = __ballot(key[(B) + 4] OP (X)), q5 = __ballot(key[(B) + 5] OP (X)), q6 = __ballot(key[(B) + 6] OP (X)), q7 = __ballot(key[(B) + 7] OP (X)); \
        asm volatile("" : "+s"(q0), "+s"(q1), "+s"(q2), "+s"(q3), "+s"(q4), "+s"(q5), "+s"(q6), "+s"(q7)); \
        ACC += (__popcll(q0) + __popcll(q1)) + (__popcll(q2) + __popcll(q3)) + (__popcll(q4) + __popcll(q5)) + (__popcll(q6) + __popcll(q7)); } while (0)
#define tk_put(lo, hi, w, i) do { const unsigned long long w_ = (w); if (lane == (i)) { lo = (unsigned)w_; hi = (unsigned)(w_ >> 32); } } while (0)
__device__ __forceinline__ void topk_row(const LAS float* sc, int n, unsigned long long* mrow, int lane) {
    unsigned wlo = 0u, whi = 0u;
    if (n <= TOPK) {
#pragma unroll
        for (int i = 0; i < 4; ++i) tk_put(wlo, whi, __ballot(64 * i + lane < n), i);
    } else {
        unsigned key[32];
        const int noct = (n + 511) >> 9;
#pragma unroll
        for (int c = 0; c < 4; ++c) {
            if (c < noct) {
#pragma unroll
                for (int i = 8 * c; i < 8 * c + 8; ++i) { const float f = sc[64 * i + lane]; key[i] = (64 * i + lane < n) ? ord_key(f) : 0u; }
            } else {
#pragma unroll
                for (int i = 8 * c; i < 8 * c + 8; ++i) key[i] = 0u; } }
        unsigned prefix = 0u; bool exact = false;
        for (int bit = 31; bit >= 0; --bit) { const unsigned cand = prefix | (1u << bit); int lc = 0;
#pragma unroll
            for (int i = 0; i < 8; ++i) lc += (key[i] >= cand) ? 1 : 0;
            if (noct > 1) {
#pragma unroll
                for (int i = 8; i < 16; ++i) lc += (key[i] >= cand) ? 1 : 0; }
            if (noct > 2) {
#pragma unroll
                for (int i = 16; i < 24; ++i) lc += (key[i] >= cand) ? 1 : 0; }
            if (noct > 3) {
#pragma unroll
                for (int i = 24; i < 32; ++i) lc += (key[i] >= cand) ? 1 : 0; }
            lc += __builtin_amdgcn_update_dpp(0, lc, 0xB1, 0xf, 0xf, true); lc += __builtin_amdgcn_update_dpp(0, lc, 0x4E, 0xf, 0xf, true);
            lc += __builtin_amdgcn_update_dpp(0, lc, 0x141, 0xf, 0xf, true); lc += __builtin_amdgcn_update_dpp(0, lc, 0x140, 0xf, 0xf, true);
            const int cnt = (__builtin_amdgcn_readlane(lc, 0) + __builtin_amdgcn_readlane(lc, 16)) + (__builtin_amdgcn_readlane(lc, 32) + __builtin_amdgcn_readlane(lc, 48));
            if (cnt >= TOPK) { prefix = cand; if (cnt == TOPK) { exact = true; break; } } }
        if (exact) {
#pragma unroll
            for (int c = 0; c < 4; ++c) { if (c < noct) {
#pragma unroll
                for (int i = 8 * c; i < 8 * c + 8; ++i) tk_put(wlo, whi, __ballot(key[i] >= prefix), i); } }
        } else {
            int gt = 0;
            TK_CNT8(gt, 0, >, prefix); TK_CNT8(gt, 8, >, prefix); TK_CNT8(gt, 16, >, prefix); TK_CNT8(gt, 24, >, prefix);
            const int need = TOPK - gt; int base = 0; const unsigned long long lt = (1ull << lane) - 1ull;
#pragma unroll
            for (int i = 0; i < 32; ++i) { const bool eq = key[i] == prefix; const unsigned long long be = __ballot(eq); const int rank = base + __popcll(be & lt); base += __popcll(be);
                tk_put(wlo, whi, __ballot(key[i] > prefix || (eq && rank < need)), i); }
        }
    }
    if (lane < 32) mrow[lane] = ((unsigned long long)whi << 32) | wlo;
}
#define TK_LOADKEYS(KEY, SC, N) do { _Pragma("unroll") for (int c = 0; c < 4; ++c) { if (c < noct) { _Pragma("unroll") for (int i = 8 * c; i < 8 * c + 8; ++i) { const float f = (SC)[64 * i + lane]; KEY[i] = (64 * i + lane < (N)) ? ord_key(f) : 0u; } } \
        else { _Pragma("unroll") for (int i = 8 * c; i < 8 * c + 8; ++i) KEY[i] = 0u; } } } while (0)
#define TK_FINAL(KEY, PREFIX, EXACT, MROW) do { unsigned wlo = 0u, whi = 0u; \
        if (EXACT) { _Pragma("unroll") for (int c = 0; c < 4; ++c) { if (c < noct) { _Pragma("unroll") for (int i = 8 * c; i < 8 * c + 8; ++i) tk_put(wlo, whi, __ballot(KEY[i] >= (PREFIX)), i); } } } \
        else { const unsigned* key = KEY; int gt = 0; TK_CNT8(gt, 0, >, (PREFIX)); TK_CNT8(gt, 8, >, (PREFIX)); TK_CNT8(gt, 16, >, (PREFIX)); TK_CNT8(gt, 24, >, (PREFIX)); \
            const int need = TOPK - gt; int base = 0; const unsigned long long lt = (1ull << lane) - 1ull; \
            _Pragma("unroll") for (int i = 0; i < 32; ++i) { const bool eq = KEY[i] == (PREFIX); const unsigned long long be = __ballot(eq); const int rank = base + __popcll(be & lt); base += __popcll(be); \
                tk_put(wlo, whi, __ballot(KEY[i] > (PREFIX) || (eq && rank < need)), i); } } \
        if (lane < 32) (MROW)[lane] = ((unsigned long long)whi << 32) | wlo; } while (0)
#define TK_WSUM(X) do { X += __builtin_amdgcn_update_dpp(0, X, 0xB1, 0xf, 0xf, true); X += __builtin_amdgcn_update_dpp(0, X, 0x4E, 0xf, 0xf, true); \
        X += __builtin_amdgcn_update_dpp(0, X, 0x141, 0xf, 0xf, true); X += __builtin_amdgcn_update_dpp(0, X, 0x140, 0xf, 0xf, true); } while (0)
__device__ __forceinline__ unsigned pk_lt1(unsigned candp, unsigned x, unsigned one) { unsigned d, t; asm("v_pk_sub_u16 %0, %1, %2 clamp" : "=v"(d) : "v"(candp), "v"(x)); asm("v_pk_min_u16 %0, %1, %2" : "=v"(t) : "v"(d), "v"(one)); return t; }
__device__ __forceinline__ unsigned pk_add16(unsigned a, unsigned b2) { unsigned r; asm("v_pk_add_u16 %0, %1, %2" : "=v"(r) : "v"(a), "v"(b2)); return r; }
__device__ __forceinline__ unsigned pk_mul16(unsigned a, unsigned b2) { unsigned r; asm("v_pk_mul_lo_u16 %0, %1, %2" : "=v"(r) : "v"(a), "v"(b2)); return r; }
#define TK_PKCOUNT(PA, PB, CA, CB, CNTA, CNTB) do { const unsigned cpa_ = (CA) * 0x10001u, cpb_ = (CB) * 0x10001u; unsigned a0_ = 0u, a1_ = 0u, b0_ = 0u, b1_ = 0u; \
        _Pragma("unroll") for (int c_ = 0; c_ < 4; ++c_) { if (c_ < noct) { \
            a0_ = pk_add16(a0_, pk_lt1(cpa_, PA[4 * c_], one)); b0_ = pk_add16(b0_, pk_lt1(cpb_, PB[4 * c_], one)); a1_ = pk_add16(a1_, pk_lt1(cpa_, PA[4 * c_ + 1], one)); b1_ = pk_add16(b1_, pk_lt1(cpb_, PB[4 * c_ + 1], one)); \
            a0_ = pk_add16(a0_, pk_lt1(cpa_, PA[4 * c_ + 2], one)); b0_ = pk_add16(b0_, pk_lt1(cpb_, PB[4 * c_ + 2], one)); a1_ = pk_add16(a1_, pk_lt1(cpa_, PA[4 * c_ + 3], one)); b1_ = pk_add16(b1_, pk_lt1(cpb_, PB[4 * c_ + 3], one)); } } \
        a0_ = pk_add16(a0_, a1_); b0_ = pk_add16(b0_, b1_); int la_ = (int)((a0_ & 0xffffu) + (a0_ >> 16)), lb_ = (int)((b0_ & 0xffffu) + (b0_ >> 16)); TK_WSUM(la_); TK_WSUM(lb_); \
        CNTA = 512 * noct - ((__builtin_amdgcn_readlane(la_, 0) + __builtin_amdgcn_readlane(la_, 16)) + (__builtin_amdgcn_readlane(la_, 32) + __builtin_amdgcn_readlane(la_, 48))); \
        CNTB = 512 * noct - ((__builtin_amdgcn_readlane(lb_, 0) + __builtin_amdgcn_readlane(lb_, 16)) + (__builtin_amdgcn_readlane(lb_, 32) + __builtin_amdgcn_readlane(lb_, 48))); } while (0)
__device__ __forceinline__ void topk_pair(const LAS float* scA, int nA, unsigned long long* mrowA, const LAS float* scB, int nB, unsigned long long* mrowB, int lane) {
    if (nB <= TOPK) { topk_row(scA, nA, mrowA, lane); topk_row(scB, nB, mrowB, lane); return; }
    const int noct = (nB + 511) >> 9;
    unsigned keyA[32], keyB[32];
    TK_LOADKEYS(keyA, scA, nA); TK_LOADKEYS(keyB, scB, nB);
    const unsigned one = 0x00010001u;
    unsigned PA[16], PB[16];
#pragma unroll
    for (int j = 0; j < 16; ++j) { PA[j] = (keyA[2 * j] >> 16) | (keyA[2 * j + 1] & 0xffff0000u); PB[j] = (keyB[2 * j] >> 16) | (keyB[2 * j + 1] & 0xffff0000u); }
    unsigned hA = 0u, hB = 0u, prefA = 0u, prefB = 0u; bool exA = false, exB = false, doneA = false, doneB = false;
    for (int bit = 15; bit >= 0; --bit) { const unsigned candA = hA | (1u << bit), candB = hB | (1u << bit); int cntA, cntB;
        TK_PKCOUNT(PA, PB, candA, candB, cntA, cntB);
        if (!doneA && cntA >= TOPK) { hA = candA; if (cntA == TOPK) { exA = true; doneA = true; prefA = candA << 16; } }
        if (!doneB && cntB >= TOPK) { hB = candB; if (cntB == TOPK) { exB = true; doneB = true; prefB = candB << 16; } }
        if (doneA && doneB) break; }
    if (!(doneA && doneB)) {
        { const unsigned ppa = hA * 0x10001u, ppb = hB * 0x10001u;
#pragma unroll
          for (int j = 0; j < 16; ++j) { unsigned gt_, lt_, lo_;
              { unsigned d_; asm("v_pk_sub_u16 %0, %1, %2 clamp" : "=v"(d_) : "v"(PA[j]), "v"(ppa)); asm("v_pk_min_u16 %0, %1, %2" : "=v"(gt_) : "v"(d_), "v"(one)); } lt_ = pk_lt1(ppa, PA[j], one);
              lo_ = (keyA[2 * j] & 0xffffu) | (keyA[2 * j + 1] << 16); PA[j] = (lo_ | pk_mul16(gt_, 0xffffffffu)) & ~pk_mul16(lt_, 0xffffffffu);
              { unsigned d_; asm("v_pk_sub_u16 %0, %1, %2 clamp" : "=v"(d_) : "v"(PB[j]), "v"(ppb)); asm("v_pk_min_u16 %0, %1, %2" : "=v"(gt_) : "v"(d_), "v"(one)); } lt_ = pk_lt1(ppb, PB[j], one);
              lo_ = (keyB[2 * j] & 0xffffu) | (keyB[2 * j + 1] << 16); PB[j] = (lo_ | pk_mul16(gt_, 0xffffffffu)) & ~pk_mul16(lt_, 0xffffffffu); } }
        unsigned lA = 0u, lB = 0u;
        for (int bit = 15; bit >= 0; --bit) { const unsigned candA = lA | (1u << bit), candB = lB | (1u << bit); int cntA, cntB;
            TK_PKCOUNT(PA, PB, candA, candB, cntA, cntB);
            if (!doneA && cntA >= TOPK) { lA = candA; if (cntA == TOPK) { exA = true; doneA = true; prefA = (hA << 16) | candA; } }
            if (!doneB && cntB >= TOPK) { lB = candB; if (cntB == TOPK) { exB = true; doneB = true; prefB = (hB << 16) | candB; } }
            if (doneA && doneB) break; }
        if (!doneA) prefA = (hA << 16) | lA;
        if (!doneB) prefB = (hB << 16) | lB;
    }
    TK_FINAL(keyA, prefA, exA, mrowA); TK_FINAL(keyB, prefB, exB, mrowB);
}
#undef TK_PKCOUNT
#undef TK_LOADKEYS
#undef TK_FINAL
#undef TK_WSUM
__device__ __forceinline__ void idx_naive(Frame& F) {
    LAS float* qs = (LAS float*)(F.lds + RING_OFF);
    LAS float* ws = qs + 512;
    LAS float* sc = qs + 1024;
    for (int row = blockIdx.x; row < M; row += F.G) { const int t = row & (S - 1), n = t + 1;
        if (n > TOPK) {
            qs[F.tid] = bf2f(F.QI[(size_t)row * 512 + F.tid]); if (F.tid < 8) ws[F.tid] = F.WI[(size_t)row * 8 + F.tid] * (0.125f * 0.35355339059327373f);
            __syncthreads();
            for (int s = F.tid; s < n; s += NWAVES * 64) { asm volatile("" ::: "memory"); const bf16* kp = F.KI + (size_t)(row - t + s) * 64; float kf[64];
#pragma unroll
                for (int c = 0; c < 8; ++c) { float f[8]; ld8(kp + 8 * c, f);
#pragma unroll
                    for (int i = 0; i < 8; ++i) kf[8 * c + i] = f[i]; }
                float acc = 0.f;
#pragma unroll
                for (int h = 0; h < 8; ++h) { float d = 0.f;
#pragma unroll
                    for (int i = 0; i < 64; ++i) d += qs[h * 64 + i] * kf[i];
                    acc += ws[h] * fmaxf(d, 0.f); }
                sc[s] = acc; }
            __syncthreads();
        }
        if (F.wave == 0) topk_row(sc, n, F.MASK + (size_t)row * 32, F.lane);
        __syncthreads();
    }
}
__device__ __forceinline__ void dsa_naive(Frame& F) {
    LAS int* idx = (LAS int*)(F.lds + RING_OFF);
    LAS float* qf = (LAS float*)(F.lds + RING_OFF + 1024);
    LAS float* pl = (LAS float*)(F.lds + RING_OFF + 8192) + F.wave * 256;
    LAS int* cntp = (LAS int*)(F.lds + RING_OFF + 6144);
    for (int row = blockIdx.x; row < M; row += F.G) { const int t = row & (S - 1);
        for (int i = F.tid; i < 1024; i += NWAVES * 64) qf[i] = bf2f(F.Q1[(size_t)row * 1024 + i]);
        if (F.wave == 0) { int base = 0; const unsigned long long lt = (1ull << F.lane) - 1ull;
            for (int w = 0; w < 32; ++w) { const unsigned long long word = F.MASK[(size_t)row * 32 + w]; if ((word >> F.lane) & 1ull) idx[base + __popcll(word & lt)] = 64 * w + F.lane; base += __popcll(word); }
            if (F.lane == 0) cntp[0] = base; }
        __syncthreads();
        const int cnt = cntp[0];
        for (int hd = F.wave; hd < 16; hd += NWAVES) { const int g = hd >> 2; float lg[4]; float mx = -INFINITY;
#pragma unroll
            for (int j = 0; j < 4; ++j) { asm volatile("" ::: "memory"); const int ki = j * 64 + F.lane; lg[j] = -INFINITY;
                if (ki < cnt) { const int s = idx[ki]; const bf16* kp = F.K1 + (size_t)(row - t + s) * 256 + g * 64; float d = 0.f;
#pragma unroll
                    for (int c = 0; c < 8; ++c) { float f[8]; ld8(kp + 8 * c, f);
#pragma unroll
                        for (int i = 0; i < 8; ++i) d += qf[hd * 64 + 8 * c + i] * f[i]; }
                    lg[j] = d + F.rel_bias[rel_bucket(t - s) * 16 + hd] * 1.4426950408889634f; }
                mx = fmaxf(mx, lg[j]); }
            mx = wave_max(mx); float l = 0.f;
#pragma unroll
            for (int j = 0; j < 4; ++j) { const float p = __builtin_amdgcn_exp2f(lg[j] - mx); l += p; pl[j * 64 + F.lane] = p; }
            l = wave_sum(l); LDS_WAIT(); asm volatile("" ::: "memory");
            float o = 0.f;
            for (int i = 0; i < cnt; ++i) o += pl[i] * bf2f(F.V1[(size_t)(row - t + idx[i]) * 256 + g * 64 + F.lane]);
            F.ATT[(size_t)row * D + hd * 64 + F.lane] = (bf16)f2bf(o / l);
            LDS_WAIT(); asm volatile("" ::: "memory"); }
        __syncthreads();
    }
}
typedef float f32x16 __attribute__((ext_vector_type(16)));
typedef short s16x4 __attribute__((ext_vector_type(4)));
typedef float f32x2_t __attribute__((ext_vector_type(2))); typedef __bf16 bf16x2_t __attribute__((ext_vector_type(2)));
__device__ __forceinline__ unsigned cvtpk(float lo, float hi) { f32x2_t v = {lo, hi}; bf16x2_t b = __builtin_convertvector(v, bf16x2_t); return __builtin_bit_cast(unsigned, b); }
__device__ __forceinline__ s16x4 vtr(const LAS unsigned char* p) { return __builtin_bit_cast(s16x4, __builtin_amdgcn_ds_read_tr16_b64_v4i16((LAS s16x4*)p)); }
__device__ __forceinline__ void load_kfrags(bf16x8 (&kf)[2][4], const bf16* kb, size_t pitch) {
#pragma unroll
    for (int kh = 0; kh < 2; ++kh)
#pragma unroll
        for (int d0 = 0; d0 < 4; ++d0) kf[kh][d0] = *(const bf16x8*)(kb + (size_t)kh * 32 * pitch + d0 * 16);
}
__device__ __forceinline__ void load_vpieces(v4u (&vv)[8], const bf16* vbase, size_t pitch, int lane) {
#pragma unroll
    for (int p = 0; p < 8; ++p) vv[p] = *(const v4u*)(vbase + (size_t)(16 * (p & 3) + (lane >> 2)) * pitch + 32 * (p >> 2) + (lane & 3) * 8);
}
__device__ __forceinline__ void store_vpieces(LAS unsigned char* vl, const v4u (&vv)[8], int lane) {
#pragma unroll
    for (int p = 0; p < 8; ++p) *(LAS v4u*)(vl + p * 1024 + lane * 16) = vv[p];
}
__device__ __forceinline__ void pv_mma(f32x16& o0, f32x16& o1, const LAS unsigned char* vb, const f32x16& p0, const f32x16& p1) {
    bf16x8 pa[4];
#pragma unroll
    for (int ks = 0; ks < 4; ++ks) { const f32x16& P = (ks < 2) ? p0 : p1; const int b = (ks & 1) * 8; v4u w; w.x = cvtpk(P[b], P[b + 1]); w.y = cvtpk(P[b + 2], P[b + 3]); w.z = cvtpk(P[b + 4], P[b + 5]); w.w = cvtpk(P[b + 6], P[b + 7]); pa[ks] = __builtin_bit_cast(bf16x8, w); }
#pragma unroll
    for (int ks = 0; ks < 4; ++ks) {
        const s16x4 l0 = vtr(vb + ks * 1024), h0 = vtr(vb + ks * 1024 + 512), l1 = vtr(vb + 4096 + ks * 1024), h1 = vtr(vb + 4096 + ks * 1024 + 512);
        o0 = __builtin_amdgcn_mfma_f32_32x32x16_bf16(pa[ks], (bf16x8){l0[0], l0[1], l0[2], l0[3], h0[0], h0[1], h0[2], h0[3]}, o0, 0, 0, 0);
        o1 = __builtin_amdgcn_mfma_f32_32x32x16_bf16(pa[ks], (bf16x8){l1[0], l1[1], l1[2], l1[3], h1[0], h1[1], h1[2], h1[3]}, o1, 0, 0, 0); }
}
__device__ __forceinline__ void store_o(LAS unsigned char* stg, const f32x16& o0, const f32x16& o1, const float (&sc)[16], bf16* dst, size_t pitch, int lane) {
    const int r32 = lane & 31, hi = lane >> 5; LAS unsigned short* s16 = (LAS unsigned short*)stg;
#pragma unroll
    for (int r = 0; r < 16; ++r) { const int orow = (r & 3) + 8 * (r >> 2) + 4 * hi; s16[orow * 64 + r32] = (unsigned short)f2bf(o0[r] * sc[r]); s16[orow * 64 + 32 + r32] = (unsigned short)f2bf(o1[r] * sc[r]); }
    LDS_WAIT(); asm volatile("" ::: "memory");
#pragma unroll
    for (int i = 0; i < 4; ++i) { const int row = i * 8 + (lane >> 3), ch = lane & 7; const v4u v = *(const LAS v4u*)(stg + row * 128 + ch * 16); *(v4u*)(dst + (size_t)row * pitch + ch * 8) = v; }
    LDS_WAIT(); asm volatile("" ::: "memory");
}
constexpr int MIX_WAVE_LDS = 12544;
__device__ __forceinline__ void sb_fast(Frame& F) {
    const int lane = F.lane, r32 = lane & 31, hi = lane >> 5;
    LAS unsigned char* vl = F.lds + RING_OFF + F.wave * MIX_WAVE_LDS; LAS unsigned char* stg = vl + 8192;
    const LAS unsigned char* vb = vl + ((lane >> 4) & 1) * 32 + (lane & 3) * 8 + (4 * hi + ((lane & 15) >> 2)) * 64;
    const int gw = F.vcu * NWAVES + F.wave, NGW = F.G * NWAVES;
    for (int u = gw; u < BATCH * 8 * 64; u += NGW) {
        const int qb = u & 63, h = (u >> 6) & 7, b = u >> 9, q0 = qb * 32; const size_t rowbase = (size_t)b * S;
        const bf16* Pq = F.PROJ0 + (rowbase + q0 + r32) * EVEN_IN + h * 64 + hi * 8;
        bf16x8 qr[4];
#pragma unroll
        for (int d0 = 0; d0 < 4; ++d0) qr[d0] = *(const bf16x8*)(Pq + d0 * 16);
        f32x16 o0 = {}, o1 = {}; float C = 1.f; const int ktmax = (q0 + 30) >> 6, qpos = q0 + r32;
        for (int kt = ktmax; kt >= 0; --kt) {
            bf16x8 kf[2][4]; v4u vv[8];
            load_kfrags(kf, F.PROJ0 + (rowbase + 64 * kt + r32) * EVEN_IN + 512 + h * 64 + hi * 8, EVEN_IN);
            load_vpieces(vv, F.PROJ0 + (rowbase + 64 * kt) * EVEN_IN + 1024 + h * 64, EVEN_IN, lane);
            f32x16 p0 = {}, p1 = {};
#pragma unroll
            for (int d0 = 0; d0 < 4; ++d0) { p0 = __builtin_amdgcn_mfma_f32_32x32x16_bf16(kf[0][d0], qr[d0], p0, 0, 0, 0); p1 = __builtin_amdgcn_mfma_f32_32x32x16_bf16(kf[1][d0], qr[d0], p1, 0, 0, 0); }
            store_vpieces(vl, vv, lane);
#pragma unroll
            for (int r = 0; r < 16; ++r) { p0[r] = __builtin_amdgcn_rcpf(1.0f + __builtin_amdgcn_exp2f(p0[r])); p1[r] = __builtin_amdgcn_rcpf(1.0f + __builtin_amdgcn_exp2f(p1[r])); }
            if (kt == ktmax) {
                const int kb = 64 * kt + 4 * hi;
#pragma unroll
                for (int r = 0; r < 16; ++r) { const int key = kb + (r & 3) + 8 * (r >> 2); if (key >= qpos) p0[r] = 1.0f; if (key + 32 >= qpos) p1[r] = 1.0f; }
            }
            float TL[8], TU[8];
#pragma unroll
            for (int blk = 0; blk < 8; ++blk) { const f32x16& P = (blk < 4) ? p0 : p1; const int c = (blk & 3) * 4; const float T = (P[c] * P[c + 1]) * (P[c + 2] * P[c + 3]);
                auto rr = __builtin_amdgcn_permlane32_swap(__float_as_uint(T), __float_as_uint(T), false, false); TL[blk] = __uint_as_float(rr[0]); TU[blk] = __uint_as_float(rr[1]); }
#pragma unroll
            for (int blk = 7; blk >= 0; --blk) { f32x16& P = (blk < 4) ? p0 : p1; const int c = (blk & 3) * 4;
                const float cu = C * TU[blk]; float s = hi ? C : cu; C = cu * TL[blk];
                const float a3 = P[c + 3], a2 = P[c + 2], a1 = P[c + 1], a0 = P[c];
                P[c + 3] = (1.0f - a3) * s; s *= a3; P[c + 2] = (1.0f - a2) * s; s *= a2; P[c + 1] = (1.0f - a1) * s; s *= a1; P[c] = (1.0f - a0) * s; }
            pv_mma(o0, o1, vb, p0, p1);
            if (__all(C < 7.8886091e-31f)) break;
        }
        float one[16];
#pragma unroll
        for (int r = 0; r < 16; ++r) one[r] = 1.0f;
        store_o(stg, o0, o1, one, F.ATT + (rowbase + q0) * D + h * 64, D, lane);
    }
}
__device__ __forceinline__ void sb_fast32(Frame& F) {
    const int lane = F.lane, r32 = lane & 31, hi = lane >> 5;
    LAS unsigned char* vl = F.lds + RING_OFF + F.wave * MIX_WAVE_LDS; LAS unsigned char* stg = vl + 8192;
    const LAS unsigned char* vb = vl + ((lane >> 4) & 1) * 32 + (lane & 3) * 8 + (4 * hi + ((lane & 15) >> 2)) * 64;
    const int gw = F.vcu * NWAVES + F.wave, NGW = F.G * NWAVES;
    for (int u = gw; u < BATCH * 8 * 64; u += NGW) {
        const int qb = u & 63, h = (u >> 6) & 7, b = u >> 9, q0 = qb * 32; const size_t rowbase = (size_t)b * S;
        const bf16* Pq = F.PROJ0 + (rowbase + q0 + r32) * EVEN_IN + h * 64 + hi * 8;
        bf16x8 qr[4];
#pragma unroll
        for (int d0 = 0; d0 < 4; ++d0) qr[d0] = *(const bf16x8*)(Pq + d0 * 16);
        f32x16 o0 = {}, o1 = {}; float C = 1.f; const int ktmax = (q0 + 30) >> 5, qpos = q0 + r32;
        for (int kt = ktmax; kt >= 0; --kt) {
            bf16x8 kf[4]; v4u vv[4];
            { const bf16* kb = F.PROJ0 + (rowbase + 32 * kt + r32) * EVEN_IN + 512 + h * 64 + hi * 8;
#pragma unroll
              for (int d0 = 0; d0 < 4; ++d0) kf[d0] = *(const bf16x8*)(kb + d0 * 16); }
            { const bf16* vbase = F.PROJ0 + (rowbase + 32 * kt) * EVEN_IN + 1024 + h * 64;
#pragma unroll
              for (int pp = 0; pp < 4; ++pp) vv[pp] = *(const v4u*)(vbase + (size_t)(16 * (pp & 1) + (lane >> 2)) * EVEN_IN + 32 * (pp >> 1) + (lane & 3) * 8); }
            f32x16 p0 = {};
#pragma unroll
            for (int d0 = 0; d0 < 4; ++d0) p0 = __builtin_amdgcn_mfma_f32_32x32x16_bf16(kf[d0], qr[d0], p0, 0, 0, 0);
#pragma unroll
            for (int pp = 0; pp < 4; ++pp) *(LAS v4u*)(vl + pp * 1024 + lane * 16) = vv[pp];
#pragma unroll
            for (int r = 0; r < 16; ++r) p0[r] = __builtin_amdgcn_rcpf(1.0f + __builtin_amdgcn_exp2f(p0[r]));
            if (kt == ktmax) {
                const int kb = 32 * kt + 4 * hi;
#pragma unroll
                for (int r = 0; r < 16; ++r) { const int key = kb + (r & 3) + 8 * (r >> 2); if (key >= qpos) p0[r] = 1.0f; }
            }
            float TL[4], TU[4];
#pragma unroll
            for (int blk = 0; blk < 4; ++blk) { const int c = blk * 4; const float T = (p0[c] * p0[c + 1]) * (p0[c + 2] * p0[c + 3]);
                auto rr = __builtin_amdgcn_permlane32_swap(__float_as_uint(T), __float_as_uint(T), false, false); TL[blk] = __uint_as_float(rr[0]); TU[blk] = __uint_as_float(rr[1]); }
#pragma unroll
            for (int blk = 3; blk >= 0; --blk) { const int c = blk * 4;
                const float cu = C * TU[blk]; float s = hi ? C : cu; C = cu * TL[blk];
                const float a3 = p0[c + 3], a2 = p0[c + 2], a1 = p0[c + 1], a0 = p0[c];
                p0[c + 3] = (1.0f - a3) * s; s *= a3; p0[c + 2] = (1.0f - a2) * s; s *= a2; p0[c + 1] = (1.0f - a1) * s; s *= a1; p0[c] = (1.0f - a0) * s; }
            bf16x8 pa[2];
#pragma unroll
            for (int ks = 0; ks < 2; ++ks) { const int bb = ks * 8; v4u w; w.x = cvtpk(p0[bb], p0[bb + 1]); w.y = cvtpk(p0[bb + 2], p0[bb + 3]); w.z = cvtpk(p0[bb + 4], p0[bb + 5]); w.w = cvtpk(p0[bb + 6], p0[bb + 7]); pa[ks] = __builtin_bit_cast(bf16x8, w); }
#pragma unroll
            for (int ks = 0; ks < 2; ++ks) {
                const s16x4 l0 = vtr(vb + ks * 1024), h0 = vtr(vb + ks * 1024 + 512), l1 = vtr(vb + 2048 + ks * 1024), h1 = vtr(vb + 2048 + ks * 1024 + 512);
                o0 = __builtin_amdgcn_mfma_f32_32x32x16_bf16(pa[ks], (bf16x8){l0[0], l0[1], l0[2], l0[3], h0[0], h0[1], h0[2], h0[3]}, o0, 0, 0, 0);
                o1 = __builtin_amdgcn_mfma_f32_32x32x16_bf16(pa[ks], (bf16x8){l1[0], l1[1], l1[2], l1[3], h1[0], h1[1], h1[2], h1[3]}, o1, 0, 0, 0); }
            if (__all(C < 7.8886091e-31f)) break;
        }
        float one[16];
#pragma unroll
        for (int r = 0; r < 16; ++r) one[r] = 1.0f;
        store_o(stg, o0, o1, one, F.ATT + (rowbase + q0) * D + h * 64, D, lane);
    }
}
constexpr int SC_PITCH = 2052;
template <int PMODE> __device__ __forceinline__ void idx_fast(Frame& F, unsigned long long* MOUT) {
    const int lane = F.lane, c16 = lane & 15, kq = lane >> 4;
    LAS float* scb = (LAS float*)(F.lds + RING_OFF);
    const int cb = (int)blockIdx.x, s6 = cb & 63;
    const int pitA = 16 * (s6 + 1) + 4, pitB = 16 * (128 - s6) + 4;
    LAS float* scA = scb; LAS float* scB = scb + 16 * pitA;
    for (int pi = 0; pi < 2; ++pi) {
        const int b = 2 * ((cb >> 6) & 3) + pi; const size_t rowbase = (size_t)b * S;
        if (PMODE != 2) {
#pragma unroll 1
            for (int un = 0; un < 2; ++un) {
                const int qb = un ? 127 - s6 : s6, q0 = qb * 16; LAS float* sc = un ? scB : scA; const int pit = un ? pitB : pitA;
                if (q0 + 16 <= TOPK) continue;
                const int w0 = un ? ((F.wave - (s6 + 1)) & 7) : F.wave;
                if (w0 > qb) continue;
                bf16x8 bq[8][2]; float w[8];
#pragma unroll
                for (int h = 0; h < 8; ++h) { const bf16* qp = F.QI + (rowbase + q0 + c16) * 512 + h * 64 + 8 * kq; bq[h][0] = *(const bf16x8*)qp; bq[h][1] = *(const bf16x8*)(qp + 32);
                    w[h] = F.WI[(rowbase + q0 + c16) * 8 + h] * (0.125f * 0.35355339059327373f); }
                const bf16* kp0 = F.KI + (rowbase + c16) * 64 + 8 * kq;
                bf16x8 na0 = *(const bf16x8*)(kp0 + (size_t)(16 * w0) * 64), na1 = *(const bf16x8*)(kp0 + (size_t)(16 * w0) * 64 + 32);
                for (int j = w0; j <= qb; j += NWAVES) {
                    const bf16x8 a0 = na0, a1 = na1;
                    { const int jn = (j + NWAVES <= qb) ? j + NWAVES : j; na0 = *(const bf16x8*)(kp0 + (size_t)(16 * jn) * 64); na1 = *(const bf16x8*)(kp0 + (size_t)(16 * jn) * 64 + 32); }
                    f32x4 s4 = {0.f, 0.f, 0.f, 0.f}, dd[8];
#pragma unroll
                    for (int h = 0; h < 8; ++h) { const f32x4 z = {0.f, 0.f, 0.f, 0.f}; dd[h] = __builtin_amdgcn_mfma_f32_16x16x32_bf16(a0, bq[h][0], z, 0, 0, 0); }
#pragma unroll
                    for (int h = 0; h < 8; ++h) dd[h] = __builtin_amdgcn_mfma_f32_16x16x32_bf16(a1, bq[h][1], dd[h], 0, 0, 0);
                    __builtin_amdgcn_sched_barrier(0);
#pragma unroll
                    for (int h = 0; h < 8; ++h)
#pragma unroll
                        for (int i = 0; i < 4; ++i) s4[i] += w[h] * __builtin_amdgcn_fmed3f(dd[h][i], 0.f, __builtin_inff());
                    *(LAS f32x4*)(sc + c16 * pit + 16 * j + 4 * kq) = s4; }
            }
        }
        __syncthreads();
        if (PMODE != 1) {
            { const int q0 = s6 * 16; topk_pair(scA + F.wave * pitA, q0 + F.wave + 1, MOUT + (rowbase + q0 + F.wave) * 32, scA + (F.wave + 8) * pitA, q0 + F.wave + 9, MOUT + (rowbase + q0 + F.wave + 8) * 32, lane); }
            { const int q0 = (127 - s6) * 16; topk_pair(scB + F.wave * pitB, q0 + F.wave + 1, MOUT + (rowbase + q0 + F.wave) * 32, scB + (F.wave + 8) * pitB, q0 + F.wave + 9, MOUT + (rowbase + q0 + F.wave + 8) * 32, lane); }
        }
        __syncthreads();
    }
}
__device__ __forceinline__ void dsa_fast(Frame& F) {
    const int lane = F.lane, r32 = lane & 31, hi = lane >> 5;
    LAS unsigned char* vl = F.lds + RING_OFF + F.wave * MIX_WAVE_LDS; LAS unsigned char* stg = vl + 8192; LAS float* wsf = (LAS float*)(vl + 12288);
    LAS float* tb = (LAS float*)(F.lds + RING_OFF + NWAVES * MIX_WAVE_LDS);
    const LAS unsigned char* vb = vl + ((lane >> 4) & 1) * 32 + (lane & 3) * 8 + (4 * hi + ((lane & 15) >> 2)) * 64;
    { float mq = fabsf(F.od_q_gain[lane]), mk = fabsf(F.od_k_gain[lane]), mb = 0.f;
#pragma unroll
      for (int i = 0; i < 8; ++i) mb = fmaxf(mb, fabsf(F.rel_bias[64 * i + lane]));
      mq = wave_max(mq); mk = wave_max(mk); mb = wave_max(mb);
      const float shift2 = (8.0f * mq * mk + mb) * 1.4426950408889634f;
      for (int i = F.tid; i < 2048; i += NWAVES * 64) tb[i] = F.rel_bias[rel_bucket(i & 127) * 16 + (i >> 7)] * 1.4426950408889634f - shift2; }
    __syncthreads();
    const int v = F.vcu, hd = 8 * (v & 1) + F.wave, g = hd >> 2, s4 = (v >> 1) & 15, b = v >> 5; const size_t rowbase = (size_t)b * S;
    const LAS float* tbh = tb + hd * 128; const float cfar = tbh[127];
    for (int ui = 0; ui < 4; ++ui) {
        const int qb = (ui == 0) ? s4 : (ui == 1) ? 31 - s4 : (ui == 2) ? 32 + s4 : 63 - s4, q0 = qb * 32, qpos = q0 + r32;
        const bf16* Pq = F.Q1 + (rowbase + q0 + r32) * 1024 + hd * 64 + hi * 8;
        bf16x8 qr[4];
#pragma unroll
        for (int d0 = 0; d0 < 4; ++d0) qr[d0] = *(const bf16x8*)(Pq + d0 * 16);
        f32x16 o0 = {}, o1 = {}; float l = 0.f; const int ktmax = (q0 + 31) >> 6;
        for (int kt = 0; kt <= ktmax; ++kt) {
            bf16x8 kf[2][4]; v4u vv[8];
            load_kfrags(kf, F.K1 + (rowbase + 64 * kt + r32) * 256 + g * 64 + hi * 8, 256);
            load_vpieces(vv, F.V1 + (rowbase + 64 * kt) * 256 + g * 64, 256, lane);
            const unsigned long long mw = F.MASK[(rowbase + qpos) * 32 + kt];
            const bool far = (q0 - (64 * kt + 63)) >= 113;
            f32x16 p0, p1;
#pragma unroll
            for (int r = 0; r < 16; ++r) { p0[r] = far ? cfar : 0.f; p1[r] = far ? cfar : 0.f; }
#pragma unroll
            for (int d0 = 0; d0 < 4; ++d0) { p0 = __builtin_amdgcn_mfma_f32_32x32x16_bf16(kf[0][d0], qr[d0], p0, 0, 0, 0); p1 = __builtin_amdgcn_mfma_f32_32x32x16_bf16(kf[1][d0], qr[d0], p1, 0, 0, 0); }
            store_vpieces(vl, vv, lane);
            if (!far) {
                const int d00 = qpos - 64 * kt - 4 * hi;
#pragma unroll
                for (int r = 0; r < 16; ++r) { const int d = d00 - ((r & 3) + 8 * (r >> 2)); p0[r] += tbh[min(max(d, 0), 127)]; p1[r] += tbh[min(max(d - 32, 0), 127)]; }
            }
            const unsigned m0 = (unsigned)mw >> (4 * hi), m1 = (unsigned)(mw >> 32) >> (4 * hi);
#pragma unroll
            for (int r = 0; r < 16; ++r) { const int bit = (r & 3) + 8 * (r >> 2);
                const float e0 = ((m0 >> bit) & 1u) ? __builtin_amdgcn_exp2f(p0[r]) : 0.f, e1 = ((m1 >> bit) & 1u) ? __builtin_amdgcn_exp2f(p1[r]) : 0.f;
                l += e0 + e1; p0[r] = e0; p1[r] = e1; }
            pv_mma(o0, o1, vb, p0, p1);
        }
        { auto rr = __builtin_amdgcn_permlane32_swap(__float_as_uint(l), __float_as_uint(l), false, false); l = __uint_as_float(rr[0]) + __uint_as_float(rr[1]); }
        if (hi == 0) wsf[r32] = l;
        LDS_WAIT(); asm volatile("" ::: "memory");
        float rl[16];
#pragma unroll
        for (int r = 0; r < 16; ++r) rl[r] = __builtin_amdgcn_rcpf(wsf[(r & 3) + 8 * (r >> 2) + 4 * hi]);
        store_o(stg, o0, o1, rl, F.ATT + (rowbase + q0) * D + hd * 64, D, lane);
    }
}
__device__ __forceinline__ void glds16(const void* gsrc, unsigned lds_dst) { unsigned keep;
    asm volatile("s_mov_b32 %0, m0\n\ts_mov_b32 m0, %2\n\ts_nop 0\n\tglobal_load_lds_dwordx4 %1, off\n\ts_mov_b32 m0, %0" : "=&s"(keep) : "v"(gsrc), "s"(lds_dst) : "memory"); }
#define WAIT_BAR(N) asm volatile("s_waitcnt vmcnt(" #N ") lgkmcnt(0)\n\ts_barrier" ::: "memory")
__device__ __forceinline__ void dsa_coop(Frame& F) {
    const int lane = F.lane, r32 = lane & 31, hi = lane >> 5, wave = F.wave;
    LAS unsigned char* L = F.lds + RING_OFF;
    LAS unsigned char* stg = L + 32768 + wave * 4096; LAS float* wsf = (LAS float*)(L + 65536 + wave * 256); LAS float* tb = (LAS float*)(L + 69632); LAS unsigned long long* ml = (LAS unsigned long long*)(L + 77824 + wave * 8192);
    const unsigned l0 = (unsigned)(uintptr_t)L;
    for (int i = F.tid; i < 2048; i += NWAVES * 64) tb[i] = (F.rel_bias[rel_bucket(i & 127) * 16 + (i >> 7)] - F.rel_bias[31 * 16 + (i >> 7)]) * 1.4426950408889634f;
    __syncthreads();
    const int v = F.vcu, bg = v >> 3, b = bg >> 2, g = bg & 3, s3 = v & 7, hd = 4 * g + (wave & 3), qh = wave >> 2; const size_t rowbase = (size_t)b * S;
    const LAS float* tbh = tb + hd * 128;
    const bf16x8 ones8 = {0x3F80, 0x3F80, 0x3F80, 0x3F80, 0x3F80, 0x3F80, 0x3F80, 0x3F80};
    const bf16* ksrc = F.K1 + (rowbase + lane) * 256 + g * 64 + wave * 8;
    const bf16* vsrc = F.V1 + (rowbase + 16 * (wave & 3) + (lane >> 2)) * 256 + g * 64 + (wave >> 2) * 32 + (lane & 3) * 8;
    const unsigned kdst = (unsigned)__builtin_amdgcn_readfirstlane(l0 + wave * 1024), vdst = kdst + 16384;
    const LAS unsigned char* kp = L + hi * 1024 + r32 * 16;
    const LAS unsigned char* vb = L + 16384 + ((lane >> 4) & 1) * 32 + (lane & 3) * 8 + (4 * hi + ((lane & 15) >> 2)) * 64;
    bf16x8 qrn[4]; v4u mreg[8];
#define DSA_PREFETCH(UI) do { const int qb_ = ((UI) == 0) ? s3 : ((UI) == 1) ? 15 - s3 : ((UI) == 2) ? 16 + s3 : 31 - s3; const int qpos_ = qb_ * 64 + qh * 32 + r32; \
        glds16(ksrc, kdst); glds16(vsrc, vdst); \
        const bf16* Pq_ = F.Q1 + (rowbase + qpos_) * 1024 + hd * 64 + hi * 8; _Pragma("unroll") for (int d0 = 0; d0 < 4; ++d0) qrn[d0] = *(const bf16x8*)(Pq_ + d0 * 16); \
        const v4u* mrow_ = (const v4u*)(F.MASK + (rowbase + qpos_) * 32 + 16 * hi); _Pragma("unroll") for (int i = 0; i < 8; ++i) mreg[i] = mrow_[i]; } while (0)
    DSA_PREFETCH(0);
    for (int ui = 0; ui < 4; ++ui) {
        const int qb = (ui == 0) ? s3 : (ui == 1) ? 15 - s3 : (ui == 2) ? 16 + s3 : 31 - s3, q0 = qb * 64 + qh * 32, qpos = q0 + r32, nt = qb + 1;
        bf16x8 qr[4];
#pragma unroll
        for (int d0 = 0; d0 < 4; ++d0) qr[d0] = qrn[d0];
#pragma unroll
        for (int i = 0; i < 8; ++i) { const v4u w = mreg[i]; ml[(16 * hi + 2 * i) * 32 + r32] = ((unsigned long long)w.y << 32) | w.x; ml[(16 * hi + 2 * i + 1) * 32 + r32] = ((unsigned long long)w.w << 32) | w.z; }
        f32x16 o0 = {}, o1 = {}, o2 = {};
        WAIT_BAR(4);
        for (int kt = 0; kt < nt; ++kt) {
            const int cur = (kt & 1) * 8192; const unsigned long long mw = ml[kt * 32 + r32];
            if (kt + 1 < nt) { glds16(ksrc + (size_t)(kt + 1) * 64 * 256, kdst + (8192 - cur)); glds16(vsrc + (size_t)(kt + 1) * 64 * 256, vdst + (8192 - cur)); }
            const bool far = (q0 - (64 * kt + 63)) >= 113;
            const f32x16 z16 = {};
            f32x16 p0, p1;
#pragma unroll
            for (int d0 = 0; d0 < 4; ++d0) { const bf16x8 k0 = *(const LAS bf16x8*)(kp + cur + d0 * 2048), k1 = *(const LAS bf16x8*)(kp + cur + d0 * 2048 + 512);
                p0 = __builtin_amdgcn_mfma_f32_32x32x16_bf16(k0, qr[d0], d0 ? p0 : z16, 0, 0, 0); p1 = __builtin_amdgcn_mfma_f32_32x32x16_bf16(k1, qr[d0], d0 ? p1 : z16, 0, 0, 0); }
            if (!far) {
                const int d00 = qpos - 64 * kt - 4 * hi;
#pragma unroll
                for (int r = 0; r < 16; ++r) { const int d = d00 - ((r & 3) + 8 * (r >> 2)); p0[r] += tbh[min(max(d, 0), 127)]; p1[r] += tbh[min(max(d - 32, 0), 127)]; }
            }
            const unsigned m0 = (unsigned)mw >> (4 * hi), m1 = (unsigned)(mw >> 32) >> (4 * hi);
            bf16x8 pa[4];
#pragma unroll
            for (int ks = 0; ks < 4; ++ks) { const f32x16& P = (ks < 2) ? p0 : p1; const unsigned mm = (ks < 2) ? m0 : m1; const int bb = (ks & 1) * 8; v4u wv;
#pragma unroll
                for (int j = 0; j < 4; ++j) { const int r = bb + 2 * j, bit = (r & 3) + 8 * (r >> 2); unsigned n0, n1, m2;
                    asm("v_bfe_i32 %0, %1, %2, 1" : "=v"(n0) : "v"(mm), "n"(bit)); asm("v_bfe_i32 %0, %1, %2, 1" : "=v"(n1) : "v"(mm), "n"(bit + 1));
                    asm("v_bfi_b32 %0, %1, %2, %3" : "=v"(m2) : "v"(0xffffu), "v"(n0), "v"(n1));
                    wv[j] = cvtpk(__builtin_amdgcn_exp2f(P[r]), __builtin_amdgcn_exp2f(P[r + 1])) & m2; }
                pa[ks] = __builtin_bit_cast(bf16x8, wv); }
            { const LAS unsigned char* vq = vb + cur;
#pragma unroll
              for (int ks = 0; ks < 4; ++ks) {
                const s16x4 l0 = vtr(vq + ks * 1024), h0 = vtr(vq + ks * 1024 + 512), l1 = vtr(vq + 4096 + ks * 1024), h1 = vtr(vq + 4096 + ks * 1024 + 512);
                o0 = __builtin_amdgcn_mfma_f32_32x32x16_bf16(pa[ks], (bf16x8){l0[0], l0[1], l0[2], l0[3], h0[0], h0[1], h0[2], h0[3]}, o0, 0, 0, 0);
                o1 = __builtin_amdgcn_mfma_f32_32x32x16_bf16(pa[ks], (bf16x8){l1[0], l1[1], l1[2], l1[3], h1[0], h1[1], h1[2], h1[3]}, o1, 0, 0, 0);
                o2 = __builtin_amdgcn_mfma_f32_32x32x16_bf16(pa[ks], ones8, o2, 0, 0, 0); } }
            WAIT_BAR(0);
        }
        if (ui == 0) DSA_PREFETCH(1); else if (ui == 1) DSA_PREFETCH(2); else if (ui == 2) DSA_PREFETCH(3);
        float rl[16];
#pragma unroll
        for (int r = 0; r < 16; ++r) rl[r] = __builtin_amdgcn_rcpf(o2[r]);
        store_o(stg, o0, o1, rl, F.ATT + (rowbase + q0) * D + hd * 64, D, lane);
    }
#undef DSA_PREFETCH
}
__device__ __forceinline__ void dsa_pipe(Frame& F) {
    const int lane = F.lane, r32 = lane & 31, hi = lane >> 5, wave = F.wave;
    LAS unsigned char* L = F.lds + RING_OFF;
    LAS unsigned char* stg = L + 32768 + wave * 4096; LAS float* wsf = (LAS float*)(L + 65536 + wave * 256); LAS float* tb = (LAS float*)(L + 69632); LAS unsigned long long* ml = (LAS unsigned long long*)(L + 77824 + wave * 8192);
    const unsigned l0 = (unsigned)(uintptr_t)L;
    { float mq = fabsf(F.od_q_gain[lane]), mk = fabsf(F.od_k_gain[lane]), mb = 0.f;
#pragma unroll
      for (int i = 0; i < 8; ++i) mb = fmaxf(mb, fabsf(F.rel_bias[64 * i + lane]));
      mq = wave_max(mq); mk = wave_max(mk); mb = wave_max(mb);
      const float shift2 = (8.0f * mq * mk + mb) * 1.4426950408889634f;
      for (int i = F.tid; i < 2048; i += NWAVES * 64) tb[i] = F.rel_bias[rel_bucket(i & 127) * 16 + (i >> 7)] * 1.4426950408889634f - shift2; }
    __syncthreads();
    const int v = F.vcu, bg = v >> 3, b = bg >> 2, g = bg & 3, s3 = v & 7, hd = 4 * g + (wave & 3), qh = wave >> 2; const size_t rowbase = (size_t)b * S;
    const LAS float* tbh = tb + hd * 128; const float cfar = tbh[127];
    const bf16* ksrc = F.K1 + (rowbase + lane) * 256 + g * 64 + wave * 8;
    const bf16* vsrc = F.V1 + (rowbase + 16 * (wave & 3) + (lane >> 2)) * 256 + g * 64 + (wave >> 2) * 32 + (lane & 3) * 8;
    const unsigned kdst = (unsigned)__builtin_amdgcn_readfirstlane(l0 + wave * 1024), vdst = kdst + 16384;
    const LAS unsigned char* kp = L + hi * 1024 + r32 * 16;
    const LAS unsigned char* vb = L + 16384 + ((lane >> 4) & 1) * 32 + (lane & 3) * 8 + (4 * hi + ((lane & 15) >> 2)) * 64;
#define DSA_QK(N0, N1, KOFF) do { _Pragma("unroll") for (int d0 = 0; d0 < 4; ++d0) { const bf16x8 k0 = *(const LAS bf16x8*)(kp + (KOFF) + d0 * 2048), k1 = *(const LAS bf16x8*)(kp + (KOFF) + d0 * 2048 + 512); \
        N0 = __builtin_amdgcn_mfma_f32_32x32x16_bf16(k0, qr[d0], N0, 0, 0, 0); N1 = __builtin_amdgcn_mfma_f32_32x32x16_bf16(k1, qr[d0], N1, 0, 0, 0); } } while (0)
#define DSA_STEP(QKF, NEARF) do { const int cur = (kt & 1) * 8192; \
        if (kt + 2 < nt) glds16(ksrc + (size_t)(kt + 2) * 64 * 256, kdst + cur); \
        if (kt + 1 < nt) glds16(vsrc + (size_t)(kt + 1) * 64 * 256, vdst + (8192 - cur)); \
        const unsigned long long mw = ml[kt * 32 + r32]; \
        f32x16 N0 = {}, N1 = {}; \
        if (QKF) { const float ci = (kt + 1 < kt_near) ? cfar : 0.f; _Pragma("unroll") for (int r = 0; r < 16; ++r) { N0[r] = ci; N1[r] = ci; } DSA_QK(N0, N1, 8192 - cur); } \
        if (NEARF) { const int d00 = qpos - 64 * kt - 4 * hi; \
            _Pragma("unroll") for (int r = 0; r < 16; ++r) { const int d = d00 - ((r & 3) + 8 * (r >> 2)); S0[r] += tbh[min(max(d, 0), 127)]; S1[r] += tbh[min(max(d - 32, 0), 127)]; } } \
        { const unsigned m0 = (unsigned)mw >> (4 * hi), m1 = (unsigned)(mw >> 32) >> (4 * hi); \
          _Pragma("unroll") for (int r = 0; r < 16; ++r) { const int bit = (r & 3) + 8 * (r >> 2); unsigned k0, k1; \
              asm("v_bfe_i32 %0, %1, %2, 1" : "=v"(k0) : "v"(m0), "n"(bit)); asm("v_bfe_i32 %0, %1, %2, 1" : "=v"(k1) : "v"(m1), "n"(bit)); \
              const float e0 = __uint_as_float(__float_as_uint(__builtin_amdgcn_exp2f(S0[r])) & k0), e1 = __uint_as_float(__float_as_uint(__builtin_amdgcn_exp2f(S1[r])) & k1); \
              l += e0 + e1; S0[r] = e0; S1[r] = e1; } } \
        if (QKF) { _Pragma("unroll") for (int i = 0; i < 8; ++i) { __builtin_amdgcn_sched_group_barrier(0x100, 1, 0); __builtin_amdgcn_sched_group_barrier(0x008, 1, 0); __builtin_amdgcn_sched_group_barrier(0x402, 20, 0); } } \
        pv_mma(o0, o1, vb + cur, S0, S1); \
        WAIT_BAR(0); \
        S0 = N0; S1 = N1; } while (0)
    for (int ui = 0; ui < 4; ++ui) {
        const int qb = (ui == 0) ? s3 : (ui == 1) ? 15 - s3 : (ui == 2) ? 16 + s3 : 31 - s3, q0 = qb * 64 + qh * 32, qpos = q0 + r32, nt = qb + 1;
        int kt_near = (q0 - 175 + 63) >> 6; kt_near = kt_near < 0 ? 0 : kt_near;
        const bf16* Pq = F.Q1 + (rowbase + qpos) * 1024 + hd * 64 + hi * 8;
        bf16x8 qr[4];
#pragma unroll
        for (int d0 = 0; d0 < 4; ++d0) qr[d0] = *(const bf16x8*)(Pq + d0 * 16);
        glds16(ksrc, kdst); glds16(vsrc, vdst); if (nt > 1) glds16(ksrc + (size_t)64 * 256, kdst + 8192);
        { const v4u* mrow = (const v4u*)(F.MASK + (rowbase + qpos) * 32 + 16 * hi);
#pragma unroll
          for (int i = 0; i < 8; ++i) { const v4u w = mrow[i]; ml[(16 * hi + 2 * i) * 32 + r32] = ((unsigned long long)w.y << 32) | w.x; ml[(16 * hi + 2 * i + 1) * 32 + r32] = ((unsigned long long)w.w << 32) | w.z; } }
        f32x16 o0 = {}, o1 = {}, S0, S1; float l = 0.f;
        WAIT_BAR(0);
        { const float ci = (0 < kt_near) ? cfar : 0.f;
#pragma unroll
          for (int r = 0; r < 16; ++r) { S0[r] = ci; S1[r] = ci; }
          DSA_QK(S0, S1, 0); }
        WAIT_BAR(0);
        for (int kt = 0; kt < nt; ++kt) {
            const bool hasqk = kt + 1 < nt;
            if (kt >= kt_near) { if (hasqk) DSA_STEP(1, 1); else DSA_STEP(0, 1); }
            else DSA_STEP(1, 0);
        }
        { auto rr = __builtin_amdgcn_permlane32_swap(__float_as_uint(l), __float_as_uint(l), false, false); l = __uint_as_float(rr[0]) + __uint_as_float(rr[1]); }
        if (hi == 0) wsf[r32] = l;
        LDS_WAIT(); asm volatile("" ::: "memory");
        float rl[16];
#pragma unroll
        for (int r = 0; r < 16; ++r) rl[r] = __builtin_amdgcn_rcpf(wsf[(r & 3) + 8 * (r >> 2) + 4 * hi]);
        store_o(stg, o0, o1, rl, F.ATT + (rowbase + q0) * D + hd * 64, D, lane);
    }
#undef DSA_QK
#undef DSA_STEP
}
template <int PMODE> __device__ __forceinline__ void dsa_pp(Frame& F, bf16* OUT) {
    const int lane = F.lane, r32 = lane & 31, hi = lane >> 5, wave = F.wave;
    LAS unsigned char* L = F.lds + RING_OFF;
    LAS unsigned char* stg = L + 49152 + wave * 4096; LAS float* wsf = (LAS float*)(L + 81920 + wave * 256); LAS float* tb = (LAS float*)(L + 83968); LAS unsigned long long* ml = (LAS unsigned long long*)(L + 92160 + wave * 8192);
    const unsigned l0 = (unsigned)(uintptr_t)L;
    { float mq = fabsf(F.od_q_gain[lane]), mk = fabsf(F.od_k_gain[lane]), mb = 0.f;
#pragma unroll
      for (int i = 0; i < 8; ++i) mb = fmaxf(mb, fabsf(F.rel_bias[64 * i + lane]));
      mq = wave_max(mq); mk = wave_max(mk); mb = wave_max(mb);
      const float shift2 = (8.0f * mq * mk + mb) * 1.4426950408889634f;
      for (int i = F.tid; i < 2048; i += NWAVES * 64) tb[i] = F.rel_bias[rel_bucket(i & 127) * 16 + (i >> 7)] * 1.4426950408889634f - shift2; }
    __syncthreads();
    const int v = F.vcu, bg = v >> 3, b = bg >> 2, g = bg & 3, s3 = v & 7, hd = 4 * g + (wave & 3), role = wave >> 2, qh = role; const size_t rowbase = (size_t)b * S;
    const LAS float* tbh = tb + hd * 128; const float cfar = tbh[127];
    const bf16* ksrc = F.K1 + (rowbase + lane) * 256 + g * 64 + wave * 8;
    const bf16* vsrc = F.V1 + (rowbase + 16 * (wave & 3) + (lane >> 2)) * 256 + g * 64 + (wave >> 2) * 32 + (lane & 3) * 8;
    const unsigned kdst = (unsigned)__builtin_amdgcn_readfirstlane(l0 + wave * 1024), vdst = kdst + 24576;
    const LAS unsigned char* kp = L + hi * 1024 + r32 * 16;
    const LAS unsigned char* vb = L + 24576 + ((lane >> 4) & 1) * 32 + (lane & 3) * 8 + (4 * hi + ((lane & 15) >> 2)) * 64;
    for (int ui = 0; ui < 4; ++ui) {
        const int qb = (ui == 0) ? s3 : (ui == 1) ? 15 - s3 : (ui == 2) ? 16 + s3 : 31 - s3, q0 = qb * 64 + qh * 32, qpos = q0 + r32, nt = qb + 1;
        int kt_near = (q0 - 175 + 63) >> 6; kt_near = kt_near < 0 ? 0 : kt_near;
        const bf16* Pq = F.Q1 + (rowbase + qpos) * 1024 + hd * 64 + hi * 8;
        bf16x8 qr[4];
#pragma unroll
        for (int d0 = 0; d0 < 4; ++d0) qr[d0] = *(const bf16x8*)(Pq + d0 * 16);
        glds16(ksrc, kdst); glds16(vsrc, vdst); if (nt > 1) glds16(ksrc + (size_t)64 * 256, kdst + 8192);
        { const v4u* mrow = (const v4u*)(F.MASK + (rowbase + qpos) * 32 + 16 * hi);
#pragma unroll
          for (int i = 0; i < 8; ++i) { const v4u w = mrow[i]; ml[(16 * hi + 2 * i) * 32 + r32] = ((unsigned long long)w.y << 32) | w.x; ml[(16 * hi + 2 * i + 1) * 32 + r32] = ((unsigned long long)w.w << 32) | w.z; } }
        f32x16 o0 = {}, o1 = {}, S0 = {}, S1 = {}; float l = 0.f; bf16x8 Pp[4] = {};
        WAIT_BAR(0);
        int nfly = 0;
        for (int h = 0; h <= 2 * nt + 1; ++h) {
            if (!(h & 1)) { const int t = h >> 1;
                nfly = 0;
                if (t + 2 < nt && PMODE != 4) { glds16(ksrc + (size_t)(t + 2) * 64 * 256, kdst + ((t + 2) % 3) * 8192); ++nfly; }
                if (t + 1 < nt && PMODE != 4) { glds16(vsrc + (size_t)(t + 1) * 64 * 256, vdst + ((t + 1) % 3) * 8192); ++nfly; } }
            const int j = h - role;
            if (j >= 0 && j <= 2 * nt) {
                const int t = j >> 1;
                if (!(j & 1)) {
                    if (t >= 1 && PMODE != 3) { const LAS unsigned char* vq = vb + ((t - 1) % 3) * 8192;
#pragma unroll
                        for (int ks = 0; ks < 4; ++ks) { const s16x4 a0 = vtr(vq + ks * 1024), b0 = vtr(vq + ks * 1024 + 512), a1 = vtr(vq + 4096 + ks * 1024), b1 = vtr(vq + 4096 + ks * 1024 + 512);
                            o0 = __builtin_amdgcn_mfma_f32_32x32x16_bf16(Pp[ks], (bf16x8){a0[0], a0[1], a0[2], a0[3], b0[0], b0[1], b0[2], b0[3]}, o0, 0, 0, 0);
                            o1 = __builtin_amdgcn_mfma_f32_32x32x16_bf16(Pp[ks], (bf16x8){a1[0], a1[1], a1[2], a1[3], b1[0], b1[1], b1[2], b1[3]}, o1, 0, 0, 0); } }
                    if (t < nt && PMODE != 3) { const float ci = (t < kt_near) ? cfar : 0.f; const LAS unsigned char* kq = kp + (t % 3) * 8192;
#pragma unroll
                        for (int r = 0; r < 16; ++r) { S0[r] = ci; S1[r] = ci; }
#pragma unroll
                        for (int d0 = 0; d0 < 4; ++d0) { const bf16x8 k0 = *(const LAS bf16x8*)(kq + d0 * 2048), k1 = *(const LAS bf16x8*)(kq + d0 * 2048 + 512);
                            S0 = __builtin_amdgcn_mfma_f32_32x32x16_bf16(k0, qr[d0], S0, 0, 0, 0); S1 = __builtin_amdgcn_mfma_f32_32x32x16_bf16(k1, qr[d0], S1, 0, 0, 0); } }
                } else if (PMODE != 2) {
                    const unsigned long long mw = ml[t * 32 + r32];
                    if (t >= kt_near) { const int d00 = qpos - 64 * t - 4 * hi;
#pragma unroll
                        for (int r = 0; r < 16; ++r) { const int d = d00 - ((r & 3) + 8 * (r >> 2)); S0[r] += tbh[min(max(d, 0), 127)]; S1[r] += tbh[min(max(d - 32, 0), 127)]; } }
                    const unsigned m0 = (unsigned)mw >> (4 * hi), m1 = (unsigned)(mw >> 32) >> (4 * hi);
#pragma unroll
                    for (int r = 0; r < 16; ++r) { const int bit = (r & 3) + 8 * (r >> 2); unsigned k0, k1;
                        asm("v_bfe_i32 %0, %1, %2, 1" : "=v"(k0) : "v"(m0), "n"(bit)); asm("v_bfe_i32 %0, %1, %2, 1" : "=v"(k1) : "v"(m1), "n"(bit));
                        const float e0 = __uint_as_float(__float_as_uint(__builtin_amdgcn_exp2f(S0[r])) & k0), e1 = __uint_as_float(__float_as_uint(__builtin_amdgcn_exp2f(S1[r])) & k1);
                        l += e0 + e1; S0[r] = e0; S1[r] = e1; }
#pragma unroll
                    for (int ks = 0; ks < 4; ++ks) { const f32x16& P = (ks < 2) ? S0 : S1; const int bb = (ks & 1) * 8; v4u w; w.x = cvtpk(P[bb], P[bb + 1]); w.y = cvtpk(P[bb + 2], P[bb + 3]);
                        w.z = cvtpk(P[bb + 4], P[bb + 5]); w.w = cvtpk(P[bb + 6], P[bb + 7]); Pp[ks] = __builtin_bit_cast(bf16x8, w); }
                }
            }
            if (nfly == 2) WAIT_BAR(2); else if (nfly == 1) WAIT_BAR(1); else WAIT_BAR(0);
        }
        { auto rr = __builtin_amdgcn_permlane32_swap(__float_as_uint(l), __float_as_uint(l), false, false); l = __uint_as_float(rr[0]) + __uint_as_float(rr[1]); }
        if (hi == 0) wsf[r32] = l;
        LDS_WAIT(); asm volatile("" ::: "memory");
        float rl[16];
#pragma unroll
        for (int r = 0; r < 16; ++r) rl[r] = __builtin_amdgcn_rcpf(wsf[(r & 3) + 8 * (r >> 2) + 4 * hi]);
        store_o(stg, o0, o1, rl, OUT + (rowbase + q0) * D + hd * 64, D, lane);
    }
}
template <int PMODE> __device__ __forceinline__ void dsa_hand(Frame& F, bf16* OUT) {
    const int lane = F.lane, r32 = lane & 31, hi = lane >> 5, wave = F.wave;
    LAS unsigned char* L = F.lds + RING_OFF;
    LAS unsigned char* stg = L + 32768 + wave * 4096; LAS float* wsf = (LAS float*)(L + 65536 + wave * 256); LAS float* tb = (LAS float*)(L + 69632); LAS unsigned long long* ml = (LAS unsigned long long*)(L + 77824 + wave * 8192);
    const unsigned l0 = (unsigned)(uintptr_t)L;
    for (int i = F.tid; i < 2048; i += NWAVES * 64) tb[i] = (F.rel_bias[rel_bucket(i & 127) * 16 + (i >> 7)] - F.rel_bias[31 * 16 + (i >> 7)]) * 1.4426950408889634f;
    __syncthreads();
    const int v = F.vcu, bg = v >> 3, b = bg >> 2, g = bg & 3, s3 = v & 7, hd = 4 * g + (wave & 3), qh = wave >> 2; const size_t rowbase = (size_t)b * S;
    const LAS float* tbh = tb + hd * 128;
    const bf16* ksrc = F.K1 + (rowbase + lane) * 256 + g * 64 + wave * 8;
    const bf16* vsrc = F.V1 + (rowbase + 16 * (wave & 3) + (lane >> 2)) * 256 + g * 64 + (wave >> 2) * 32 + (lane & 3) * 8;
    const unsigned kdst = (unsigned)__builtin_amdgcn_readfirstlane(l0 + wave * 1024), vdst = kdst + 16384;
    const LAS unsigned char* kp = L + hi * 1024 + r32 * 16;
    const LAS unsigned char* vb = L + 16384 + ((lane >> 4) & 1) * 32 + (lane & 3) * 8 + (4 * hi + ((lane & 15) >> 2)) * 64;
#define SBAR0() __builtin_amdgcn_sched_barrier(0)
#define DH_SM4(E) do {   \
        if (PMODE != 2) { unsigned ka, kb2, kc, kd; asm("v_bfe_i32 %0, %1, %2, 1" : "=v"(ka) : "v"(m0), "n"(((2 * (E)) & 3) + 8 * ((2 * (E)) >> 2))); asm("v_bfe_i32 %0, %1, %2, 1" : "=v"(kb2) : "v"(m0), "n"(((2 * (E) + 1) & 3) + 8 * ((2 * (E) + 1) >> 2))); \
          asm("v_bfe_i32 %0, %1, %2, 1" : "=v"(kc) : "v"(m1), "n"(((2 * (E)) & 3) + 8 * ((2 * (E)) >> 2))); asm("v_bfe_i32 %0, %1, %2, 1" : "=v"(kd) : "v"(m1), "n"(((2 * (E) + 1) & 3) + 8 * ((2 * (E) + 1) >> 2))); \
          const float ea = __uint_as_float(__float_as_uint(__builtin_amdgcn_exp2f(S0[2 * (E)])) & ka), eb = __uint_as_float(__float_as_uint(__builtin_amdgcn_exp2f(S0[2 * (E) + 1])) & kb2); \
          const float ec = __uint_as_float(__float_as_uint(__builtin_amdgcn_exp2f(S1[2 * (E)])) & kc), ed = __uint_as_float(__float_as_uint(__builtin_amdgcn_exp2f(S1[2 * (E) + 1])) & kd); \
          S0[2 * (E)] = ea; S0[2 * (E) + 1] = eb; S1[2 * (E)] = ec; S1[2 * (E) + 1] = ed; la += ea; lb += eb; la += ec; lb += ed; } \
        asm volatile("" : "+v"(S0), "+v"(S1), "+v"(la), "+v"(lb)); } while (0)
    for (int ui = 0; ui < 4; ++ui) {
        const int qb = (ui == 0) ? s3 : (ui == 1) ? 15 - s3 : (ui == 2) ? 16 + s3 : 31 - s3, q0 = qb * 64 + qh * 32, qpos = q0 + r32, nt = qb + 1;
        int kt_near = (q0 - 175 + 63) >> 6; kt_near = kt_near < 0 ? 0 : kt_near;
        const bf16* Pq = F.Q1 + (rowbase + qpos) * 1024 + hd * 64 + hi * 8;
        bf16x8 qr[4];
#pragma unroll
        for (int d0 = 0; d0 < 4; ++d0) qr[d0] = *(const bf16x8*)(Pq + d0 * 16);
        glds16(ksrc, kdst); glds16(vsrc, vdst); if (nt > 1) glds16(ksrc + (size_t)64 * 256, kdst + 8192);
        { const v4u* mrow = (const v4u*)(F.MASK + (rowbase + qpos) * 32 + 16 * hi);
#pragma unroll
          for (int i = 0; i < 8; ++i) { const v4u w = mrow[i]; ml[(16 * hi + 2 * i) * 32 + r32] = ((unsigned long long)w.y << 32) | w.x; ml[(16 * hi + 2 * i + 1) * 32 + r32] = ((unsigned long long)w.w << 32) | w.z; } }
        f32x16 o0 = {}, o1 = {}, S0 = {}, S1 = {}; float la = 0.f, lb = 0.f;
        WAIT_BAR(0);
#pragma unroll
        for (int d0 = 0; d0 < 4; ++d0) { const bf16x8 k0 = *(const LAS bf16x8*)(kp + d0 * 2048), k1 = *(const LAS bf16x8*)(kp + d0 * 2048 + 512);
            S0 = __builtin_amdgcn_mfma_f32_32x32x16_bf16(k0, qr[d0], S0, 0, 0, 0); S1 = __builtin_amdgcn_mfma_f32_32x32x16_bf16(k1, qr[d0], S1, 0, 0, 0); }
        WAIT_BAR(0);
        for (int kt = 0; kt < nt; ++kt) {
            const int cur = (kt & 1) * 8192;
            if (kt + 2 < nt) glds16(ksrc + (size_t)(kt + 2) * 64 * 256, kdst + cur);
            if (kt + 1 < nt) glds16(vsrc + (size_t)(kt + 1) * 64 * 256, vdst + (8192 - cur));
            const unsigned long long mw = ml[kt * 32 + r32];
            if (kt >= kt_near && PMODE != 4) { const int d00 = qpos - 64 * kt - 4 * hi;
#pragma unroll
                for (int r = 0; r < 16; ++r) { const int d = d00 - ((r & 3) + 8 * (r >> 2)); S0[r] += tbh[min(max(d, 0), 127)]; S1[r] += tbh[min(max(d - 32, 0), 127)]; } }
            const unsigned m0 = (unsigned)mw >> (4 * hi), m1 = (unsigned)(mw >> 32) >> (4 * hi);
            f32x16 N0 = {}, N1 = {};
            if (kt + 1 < nt && PMODE != 5) {
                const LAS unsigned char* kq = kp + (8192 - cur);
                bf16x8 kf[8];
#pragma unroll
                for (int i = 0; i < 8; ++i) kf[i] = *(const LAS bf16x8*)(kq + (i >> 1) * 2048 + (i & 1) * 512);
                SBAR0();
                N0 = __builtin_amdgcn_mfma_f32_32x32x16_bf16(kf[0], qr[0], N0, 0, 0, 0); DH_SM4(0); SBAR0();
                N1 = __builtin_amdgcn_mfma_f32_32x32x16_bf16(kf[1], qr[0], N1, 0, 0, 0); DH_SM4(1); SBAR0();
                N0 = __builtin_amdgcn_mfma_f32_32x32x16_bf16(kf[2], qr[1], N0, 0, 0, 0); DH_SM4(2); SBAR0();
                N1 = __builtin_amdgcn_mfma_f32_32x32x16_bf16(kf[3], qr[1], N1, 0, 0, 0); DH_SM4(3); SBAR0();
                N0 = __builtin_amdgcn_mfma_f32_32x32x16_bf16(kf[4], qr[2], N0, 0, 0, 0); DH_SM4(4); SBAR0();
                N1 = __builtin_amdgcn_mfma_f32_32x32x16_bf16(kf[5], qr[2], N1, 0, 0, 0); DH_SM4(5); SBAR0();
                N0 = __builtin_amdgcn_mfma_f32_32x32x16_bf16(kf[6], qr[3], N0, 0, 0, 0); DH_SM4(6); SBAR0();
                N1 = __builtin_amdgcn_mfma_f32_32x32x16_bf16(kf[7], qr[3], N1, 0, 0, 0); DH_SM4(7); SBAR0();
            } else { DH_SM4(0); DH_SM4(1); DH_SM4(2); DH_SM4(3); DH_SM4(4); DH_SM4(5); DH_SM4(6); DH_SM4(7); }
            if (PMODE != 3) pv_mma(o0, o1, vb + cur, S0, S1);
            WAIT_BAR(0);
            S0 = N0; S1 = N1;
        }
        float l = la + lb;
        { auto rr = __builtin_amdgcn_permlane32_swap(__float_as_uint(l), __float_as_uint(l), false, false); l = __uint_as_float(rr[0]) + __uint_as_float(rr[1]); }
        if (hi == 0) wsf[r32] = l;
        LDS_WAIT(); asm volatile("" ::: "memory");
        float rl[16];
#pragma unroll
        for (int r = 0; r < 16; ++r) rl[r] = __builtin_amdgcn_rcpf(wsf[(r & 3) + 8 * (r >> 2) + 4 * hi]);
        store_o(stg, o0, o1, rl, OUT + (rowbase + q0) * D + hd * 64, D, lane);
    }
#undef DH_SM4
#undef SBAR0
}
__device__ __forceinline__ void p6_mini(Frame& F) {
    const int lane = F.lane, c16 = lane & 15, kq = lane >> 4, mt = F.wave & 3, ns = F.wave >> 2;
    for (int blk = (int)blockIdx.x; blk < M / 64; blk += F.G) {
        const int r0 = blk * 64 + mt * 16;
        const bf16* ap = F.XB + (size_t)(r0 + c16) * D + 8 * kq;
        const int nb0 = ns ? 2176 : 2048, nb1 = ns ? 2192 : 2064, nb2 = 2080;
        const bf16* b0 = F.W_in1 + (size_t)(nb0 + c16) * D + 8 * kq; const bf16* b1 = F.W_in1 + (size_t)(nb1 + c16) * D + 8 * kq; const bf16* b2 = F.W_in1 + (size_t)(nb2 + c16) * D + 8 * kq;
        f32x4 a0 = {0.f, 0.f, 0.f, 0.f}, a1 = a0, a2 = a0;
#pragma unroll 4
        for (int ks = 0; ks < 32; ++ks) { const bf16x8 av = *(const bf16x8*)(ap + 32 * ks), v0 = *(const bf16x8*)(b0 + 32 * ks), v1 = *(const bf16x8*)(b1 + 32 * ks);
            a0 = __builtin_amdgcn_mfma_f32_16x16x32_bf16(av, v0, a0, 0, 0, 0); a1 = __builtin_amdgcn_mfma_f32_16x16x32_bf16(av, v1, a1, 0, 0, 0);
            if (!ns) { const bf16x8 v2 = *(const bf16x8*)(b2 + 32 * ks); a2 = __builtin_amdgcn_mfma_f32_16x16x32_bf16(av, v2, a2, 0, 0, 0); } }
#pragma unroll
        for (int i = 0; i < 4; ++i) { const int row = r0 + 4 * kq + i; const float sc = pg8::row_rstd(F.SS + 2 * M, row);
            F.KI[(size_t)row * 64 + (ns ? 32 : 0) + c16] = (bf16)f2bf(a0[i] * sc); F.KI[(size_t)row * 64 + (ns ? 48 : 16) + c16] = (bf16)f2bf(a1[i] * sc);
            if (!ns && c16 < 8) F.WI[(size_t)row * 8 + c16] = a2[i] * sc; }
    }
}
struct Args { const float* in[14]; float* out; unsigned char* ws; int ph_lo, ph_hi, li, pad; };
__global__ void __launch_bounds__(NWAVES * 64, 2) hybrid_fwd(Args args) {
    extern __shared__ __attribute__((aligned(16))) unsigned char lds[];
    Frame F;
    F.lds = (LAS unsigned char*)lds;
    F.MISC = (volatile LAS unsigned*)(F.lds + MISC_OFF);
    F.tid = threadIdx.x; F.lane = F.tid & 63; F.wave = __builtin_amdgcn_readfirstlane(F.tid >> 6);
    F.G = gridDim.x; { const int bx = blockIdx.x; F.vcu = (F.G % 8 == 0) ? (bx % 8) * (F.G / 8) + bx / 8 : bx; }
    unsigned char* ws = args.ws;
    F.ctl = (gu32*)(ws + WS_CTL);
    F.x = args.in[0]; F.norm_mix = args.in[1]; F.norm_ffn = args.in[2]; F.ev_w_in = args.in[3]; F.ev_conv_w = args.in[4]; F.ev_w_out = args.in[5]; F.od_w_in = args.in[6];
    F.od_q_gain = args.in[7]; F.od_k_gain = args.in[8]; F.od_w_out = args.in[9]; F.rel_bias = args.in[10]; F.w_gate = args.in[11]; F.w_up = args.in[12]; F.w_down = args.in[13];
    F.out = args.out; F.SS = (float*)(ws + WS_CTL) + CW_SS;
    F.W_in0 = (bf16*)(ws + WS_W_IN0); F.W_out0 = (bf16*)(ws + WS_W_OUT0); F.W_gu0 = (bf16*)(ws + WS_W_GU0); F.W_dn0 = (bf16*)(ws + WS_W_DN0);
    F.W_in1 = (bf16*)(ws + WS_W_IN1); F.W_out1 = (bf16*)(ws + WS_W_OUT1); F.W_gu1 = (bf16*)(ws + WS_W_GU1); F.W_dn1 = (bf16*)(ws + WS_W_DN1);
    F.XB = (bf16*)(ws + WS_XB); F.ATT = (bf16*)(ws + WS_ATT); F.PROJ0 = (bf16*)(ws + WS_PROJ0); F.H = (bf16*)(ws + WS_H);
    F.Q1 = (bf16*)(ws + WS_Q1); F.K1 = (bf16*)(ws + WS_K1); F.V1 = (bf16*)(ws + WS_V1); F.QI = (bf16*)(ws + WS_QI); F.KI = (bf16*)(ws + WS_KI); F.WI = (float*)(ws + WS_WI); F.MASK = (unsigned long long*)(ws + WS_MASK);
    if (F.tid < 64) ((LAS unsigned*)(F.lds + MISC_OFF))[F.tid] = 0u;
    __syncthreads();
    const int lo = args.ph_lo, hi = args.ph_hi;
    const bool use_bar = (hi - lo) > 1;
    XcdBarrier bar; bar.bar = (unsigned*)(F.ctl + CW_BAR) + args.li * XCD_BAR_WORDS; bar.x = 0; bar.st = nullptr;
    if (use_bar) bar = xcd_barrier_post((unsigned*)(F.ctl + CW_BAR) + args.li * XCD_BAR_WORDS, F.MISC + 8);
#define IN(k) (lo <= (k) && (k) < hi)
#define SEAM(k) do { if (IN(k) && IN((k) + 1)) xcd_barrier(bar); } while (0)
#define GEMM_PHASE(EPI, A_, B_, N_, K_, E_) do { pg8::Gemm g{A_, B_, M, N_, K_}; pg8::StaticOrder So; So.init(M, N_, F.G, (int)blockIdx.x); \
        pg8::gemm_phase<EPI, pg8::StaticOrder, PG8_ALIGN, PG8_SP2>(F.lds + RING_OFF, g, So, E_); } while (0)
#define GEMM_PHASE_T(EPI, A_, B_, N_, K_, E_) do { pg8::Gemm g{A_, B_, M, N_, K_}; pg8::TailOrder So; So.init(M, N_, F.G, (int)blockIdx.x); \
        pg8::gemm_phase<EPI, pg8::TailOrder, PG8_ALIGN, PG8_SP2>(F.lds + RING_OFF, g, So, E_); } while (0)

    if (IN(0)) { for (int rep = 0; rep < (PROBE_REP == 0 ? 2 : 1); ++rep) p0_prologue(F); } SEAM(0);
    if (IN(1)) { pg8::EpiIn0 E{F.PROJ0, F.SS, C2}; GEMM_PHASE(pg8::EpiIn0, F.XB, F.W_in0, EVEN_IN, D, E); if (PROBE_REP == 1) { GEMM_PHASE(pg8::EpiIn0, F.XB, F.W_in0, EVEN_IN, D, E); } } SEAM(1);
    if (IN(2)) { for (int rep = 0; rep < (PROBE_REP == 2 ? 2 : 1); ++rep) { conv_part(F); if (SB_FAST == 2) sb_fast32(F); else if (SB_FAST) sb_fast(F); else sb_naive(F); __syncthreads(); p2_weights(F); } } SEAM(2);
    if (IN(3)) { pg8::EpiRes E{F.XB, nullptr, F.SS + M}; GEMM_PHASE(pg8::EpiRes, F.ATT, F.W_out0, D, D, E); } SEAM(3);
    if (IN(4)) { pg8::EpiGU E{F.H, F.SS + M}; GEMM_PHASE(pg8::EpiGU, F.XB, F.W_gu0, GU, D, E); late_weights(F, N_EARLY, N_MID); } SEAM(4);
    if (IN(5)) { pg8::EpiRes E{F.XB, nullptr, F.SS + 2 * M}; GEMM_PHASE(pg8::EpiRes, F.H, F.W_dn0, D, FF, E); } SEAM(5);
    if (IN(6)) { LAS float* gl = (LAS float*)(F.lds + 131072 + 1024); if (F.tid < 64) { gl[F.tid] = F.od_q_gain[F.tid]; gl[64 + F.tid] = F.od_k_gain[F.tid]; } __syncthreads();
        pg8::EpiIn1 E{F.Q1, F.K1, F.V1, F.QI, F.KI, F.WI, F.SS + 2 * M, gl, gl + 64, C2}; GEMM_PHASE_T(pg8::EpiIn1, F.XB, F.W_in1, (P6_MINI ? 2048 : ODD_PAD), D, E); if (P6_MINI) p6_mini(F); late_weights(F, N_MID, NITEMS); } SEAM(6);
    if (IN(7)) { for (int rep = 0; rep < (PROBE_REP == 7 ? 2 : 1); ++rep) { if (IDX_FAST && F.G == 256) { idx_fast<0>(F, F.MASK); if (PROBE_IDX) { __syncthreads(); idx_fast<PROBE_IDX>(F, (unsigned long long*)F.XB); } } else idx_naive(F); } } SEAM(7);
    if (IN(8)) { for (int rep = 0; rep < (PROBE_REP == 8 ? 2 : 1); ++rep) { if (F.G != 256) dsa_naive(F); else if (DSA_FAST == 5) { dsa_hand<0>(F, F.ATT); if (PROBE_DSA) { __syncthreads(); dsa_hand<PROBE_DSA>(F, F.XB); } } else if (DSA_FAST == 4) { dsa_pp<0>(F, F.ATT); if (PROBE_DSA) { __syncthreads(); dsa_pp<PROBE_DSA>(F, F.XB); } } else if (DSA_FAST == 3) dsa_pipe(F); else if (DSA_FAST == 2) dsa_coop(F); else if (DSA_FAST) dsa_fast(F); else dsa_naive(F); __syncthreads(); } } SEAM(8);
    if (IN(9)) { pg8::EpiRes E{F.XB, nullptr, F.SS + 3 * M}; GEMM_PHASE(pg8::EpiRes, F.ATT, F.W_out1, D, D, E); } SEAM(9);
    if (IN(10)) { pg8::EpiGU E{F.H, F.SS + 3 * M}; GEMM_PHASE_T(pg8::EpiGU, F.XB, F.W_gu1, GU, D, E); } SEAM(10);
    if (IN(11)) { pg8::EpiRes E{F.XB, F.out, nullptr}; GEMM_PHASE(pg8::EpiRes, F.H, F.W_dn1, D, FF, E); }
#undef IN
#undef SEAM
#undef GEMM_PHASE
#undef GEMM_PHASE_T
}

extern "C" void kernel_launch(void* const* d_in, const int* in_sizes, int n_in, void* d_out, int out_size, void* d_ws, size_t ws_size, hipStream_t stream) {
    static int grid = 0;
    if (grid == 0) {
        if (n_in != 14 || in_sizes[0] != M * D || out_size != M * D || ws_size < WS_END) { fprintf(stderr, "kernel_launch: unexpected shapes (n_in %d, in0 %d, out %d, ws %zu); nothing launched\n", n_in, n_in > 0 ? in_sizes[0] : -1, out_size, ws_size); grid = -1; return; }
        int dev = 0, cus = 0, per_cu = 0;
        if (hipGetDevice(&dev) != hipSuccess || hipDeviceGetAttribute(&cus, hipDeviceAttributeMultiprocessorCount, dev) != hipSuccess) { grid = -1; return; }
        if (hipFuncSetAttribute((const void*)hybrid_fwd, hipFuncAttributeMaxDynamicSharedMemorySize, LDS_BYTES) != hipSuccess) { fprintf(stderr, "kernel_launch: hipFuncSetAttribute failed\n"); grid = -1; return; }
        if (hipOccupancyMaxActiveBlocksPerMultiprocessor(&per_cu, (const void*)hybrid_fwd, NWAVES * 64, LDS_BYTES) != hipSuccess || per_cu < 1) fprintf(stderr, "kernel_launch: note: occupancy query reports %d workgroups per CU\n", per_cu);
        (void)hipGetLastError();
        grid = cus;
    }
    if (grid < 0) return;
    if (hipMemsetAsync((char*)d_ws + WS_CTL, 0, CTL_ZERO_BYTES, stream) != hipSuccess) return;
    Args a{};
    for (int i = 0; i < 14; ++i) a.in[i] = (const float*)d_in[i];
    a.out = (float*)d_out; a.ws = (unsigned char*)d_ws;
#if MK_ONE_LAUNCH
    a.ph_lo = 0; a.ph_hi = NPH; a.li = 0;
    hipLaunchKernelGGL(hybrid_fwd, dim3(grid), dim3(NWAVES * 64), LDS_BYTES, stream, a);
#else
    for (int p = 0; p < NPH; ++p) { a.ph_lo = p; a.ph_hi = p + 1; a.li = p; hipLaunchKernelGGL(hybrid_fwd, dim3(grid), dim3(NWAVES * 64), LDS_BYTES, stream, a); }
#endif
}
```

```cpp
#include <hip/hip_runtime.h>
#include <cstdio>
#include <cstdint>
#include <cmath>
namespace pg8 {
#define PG8_LAS __attribute__((address_space(3)))
typedef unsigned short bf16_t;
typedef short bf16x8 __attribute__((ext_vector_type(8)));
typedef float f32x4 __attribute__((ext_vector_type(4)));
typedef unsigned u32x4 __attribute__((ext_vector_type(4)));
constexpr int BM = 256, BK = 64, HALF = 128, HTB = HALF * BK * 2  , STAGE_BYTES = 8 * HTB, NXCD = 8, WGM = 8;

__host__ __device__ __forceinline__ int lds_byte(int r, int c) { const int st = (r >> 4) * 2 + (c >> 5), rr = r & 15, cc = c & 31, ob = rr * 64 + cc * 2; return st * 1024 + (ob ^ (((ob >> 9) & 1) << 5)); }
__host__ __device__ __forceinline__ void stage_rc(int b, int& R, int& C) { const int st = b / 1024, sb = b % 1024, swz = sb ^ (((sb >> 9) & 1) << 5); R = (st >> 1) * 16 + swz / 64; C = (st & 1) * 32 + (swz % 64) / 2; }
__host__ __device__ __forceinline__ int perm32(int rho) { const int n = rho >> 4, i = rho & 15; return 8 * (i >> 2) + 4 * n + (i & 3); }

struct Unit { int pm, pn, half; };
struct Gemm { const bf16_t* A; const bf16_t* Bt; int M, N, K; };

struct StaticOrder {
    static constexpr bool HAS_HALF = false;
    int nM, nN, nwg, G, c;
    __host__ __device__ void init(int M, int N, int G_, int c_) { nM = M / BM; nN = N / BM; nwg = nM * nN; G = G_; c = c_; }
    __host__ __device__ __forceinline__ bool next(int i, Unit& u) const { return at((long)i * G + c, u); }
    __host__ __device__ __forceinline__ bool at(long L, Unit& u) const {
        if (L >= nwg) return false;
        int wgid = (int)L; { const int q = nwg / NXCD, r = nwg % NXCD, xcd = wgid % NXCD, off = wgid / NXCD; wgid = (xcd < r ? xcd * (q + 1) : r * (q + 1) + (xcd - r) * q) + off; }
        const int nig = WGM * nN, gid = wgid / nig, fm = gid * WGM, gsz = (nM - fm) < WGM ? (nM - fm) : WGM;
        u.pm = fm + ((wgid % nig) % gsz); u.pn = (wgid % nig) / gsz; u.half = 0; return true;
    }
    __device__ __forceinline__ void a_ready(const Unit&) const {}
    __device__ __forceinline__ void done(const Unit&) const {}
};
struct TailOrder {
    static constexpr bool HAS_HALF = true;
    StaticOrder so; int R, rem;
    __host__ __device__ __forceinline__ void init(int M, int N, int G_, int c_) { so.init(M, N, G_, c_); R = so.nwg / G_; rem = so.nwg % G_; if (2 * rem > G_) { R += 1; rem = 0; } }
    __host__ __device__ __forceinline__ bool next(int i, Unit& u) const {
        if (i < R) return so.next(i, u);
        if (i > R || so.c >= 2 * rem) return false;
        if (!so.at((long)R * so.G + (so.c >> 1), u)) return false; u.half = 1 + (so.c & 1); return true;
    }
    __device__ __forceinline__ void a_ready(const Unit&) const {}
    __device__ __forceinline__ void done(const Unit&) const {}
};
__device__ __forceinline__ unsigned cvt_pk_bf16(float lo, float hi) { unsigned r; asm volatile("v_cvt_pk_bf16_f32 %0, %1, %2" : "=v"(r) : "v"(lo), "v"(hi)); return r; }
typedef float f32x2 __attribute__((ext_vector_type(2)));
constexpr float NORM_EPS = 1e-6f, LOG2E = 1.4426950408889634f;
__device__ __forceinline__ u32x4 pack8(const f32x4 a, const f32x4 b) { u32x4 w; w.x = cvt_pk_bf16(a[0], a[1]); w.y = cvt_pk_bf16(a[2], a[3]); w.z = cvt_pk_bf16(b[0], b[1]); w.w = cvt_pk_bf16(b[2], b[3]); return w; }
#ifndef PG8_WT
#define PG8_WT 1
#endif
__device__ __forceinline__ void st16(bf16_t* base, size_t elem, const u32x4 v) {
#if PG8_WT
    __builtin_amdgcn_raw_buffer_store_b128(v, __builtin_amdgcn_make_buffer_rsrc((void*)base, (short)0, 0x7ffffff0, 0x00020000), (int)(elem * 2), 0, 16);
#else
    *(u32x4*)(base + elem) = v;
#endif
}
__device__ __forceinline__ float row_rstd(const float* ss, int row) { return __builtin_amdgcn_rsqf(ss[row] * (1.0f / 1024.0f) + NORM_EPS); }
__device__ __forceinline__ float dot4(const f32x4 a) { return (a[0] * a[0] + a[1] * a[1]) + (a[2] * a[2] + a[3] * a[3]); }

struct EpiIn0 {
    static constexpr bool PERM = true, AFTER_DRAIN = false, PRE = true;
    bf16_t* O; const float* ss; float c2;
    __device__ __forceinline__ void pre(const Unit& u, int wr, int fr, float (&rs)[8]) const { const int row0 = u.pm * BM + wr * 64 + fr;
#pragma unroll
        for (int i = 0; i < 8; ++i) rs[i] = ss[row0 + (i >> 2) * HALF + (i & 3) * 16]; }
    __device__ __forceinline__ void operator()(const f32x4 (&acc)[2][2][4][2], const Unit& u, int wr, int wc, int fr, int fq, const float (&rs)[8]) const {
        const int row0 = u.pm * BM + wr * 64 + fr, col0 = u.pn * BM + wc * 32 + 8 * fq; const float cs = (u.pn < 2) ? c2 : 1.f;
#pragma unroll
        for (int ai = 0; ai < 2; ++ai)
#pragma unroll
            for (int m = 0; m < 4; ++m) { const int row = row0 + ai * HALF + m * 16; const float s = __builtin_amdgcn_rsqf(rs[ai * 4 + m] * (1.0f / 1024.0f) + NORM_EPS) * cs; const size_t rowe = (size_t)row * 3072 + col0;
#pragma unroll
                for (int bj = 0; bj < 2; ++bj) st16(O, rowe + bj * HALF, pack8(acc[ai][bj][m][0] * s, acc[ai][bj][m][1] * s)); }
    }
};
__device__ __forceinline__ f32x4 bf4lo(const u32x4 w) { f32x4 r; r[0] = __builtin_bit_cast(float, w.x << 16); r[1] = __builtin_bit_cast(float, w.x & 0xffff0000u); r[2] = __builtin_bit_cast(float, w.y << 16); r[3] = __builtin_bit_cast(float, w.y & 0xffff0000u); return r; }
__device__ __forceinline__ f32x4 bf4hi(const u32x4 w) { f32x4 r; r[0] = __builtin_bit_cast(float, w.z << 16); r[1] = __builtin_bit_cast(float, w.z & 0xffff0000u); r[2] = __builtin_bit_cast(float, w.w << 16); r[3] = __builtin_bit_cast(float, w.w & 0xffff0000u); return r; }
struct EpiRes {
    static constexpr bool PERM = true, AFTER_DRAIN = false, PRE = false;
    bf16_t* xb; float* out; float* ssn;
    __device__ __forceinline__ void operator()(const f32x4 (&acc)[2][2][4][2], const Unit& u, int wr, int wc, int fr, int fq) const {
        const int row0 = u.pm * BM + wr * 64 + fr, col0 = u.pn * BM + wc * 32 + 8 * fq; float qs[8];
#pragma unroll
        for (int ai = 0; ai < 2; ++ai)
#pragma unroll
            for (int m = 0; m < 4; ++m) { const int row = row0 + ai * HALF + m * 16; const size_t off = (size_t)row * 1024 + col0; float q = 0.f;
#pragma unroll
                for (int bj = 0; bj < 2; ++bj) { const u32x4 bw = *(const u32x4*)(xb + off + bj * HALF);
                    const f32x4 o0 = bf4lo(bw) + acc[ai][bj][m][0], o1 = bf4hi(bw) + acc[ai][bj][m][1];
                    if (out) { *(f32x4*)(out + off + bj * HALF) = o0; *(f32x4*)(out + off + bj * HALF + 4) = o1; }
                    else st16(xb, off + bj * HALF, pack8(o0, o1));
                    q += dot4(o0) + dot4(o1); }
                if (ssn) { q += __shfl_xor(q, 16); q += __shfl_xor(q, 32); } qs[ai * 4 + m] = q; }
        if (ssn) { const float qa = (fq == 0) ? qs[0] : (fq == 1) ? qs[1] : (fq == 2) ? qs[2] : qs[3], qb = (fq == 0) ? qs[4] : (fq == 1) ? qs[5] : (fq == 2) ? qs[6] : qs[7];
            unsafeAtomicAdd(ssn + row0 + fq * 16, qa); unsafeAtomicAdd(ssn + row0 + HALF + fq * 16, qb); }
    }
};
struct EpiGU {
    static constexpr bool PERM = true, AFTER_DRAIN = false, PRE = true;
    bf16_t* H; const float* ss;
    __device__ __forceinline__ void pre(const Unit& u, int wr, int fr, float (&rs)[8]) const { const int row0 = u.pm * BM + (u.half == 2 ? HALF : 0) + wr * 64 + fr;
#pragma unroll
        for (int i = 0; i < 8; ++i) rs[i] = ss[row0 + ((i >> 2) && !u.half ? HALF : 0) + (i & 3) * 16]; }
    __device__ __forceinline__ void operator()(const f32x4 (&acc)[2][2][4][2], const Unit& u, int wr, int wc, int fr, int fq, const float (&rs)[8]) const {
        const int row0 = u.pm * BM + (u.half == 2 ? HALF : 0) + wr * 64 + fr, col0 = u.pn * HALF + wc * 32 + 8 * fq;
#pragma unroll
        for (int ai = 0; ai < 2; ++ai)
#pragma unroll
            for (int m = 0; m < 4; ++m) { if (ai == 1 && u.half) continue; const int row = row0 + ai * HALF + m * 16; const float s = __builtin_amdgcn_rsqf(rs[ai * 4 + m] * (1.0f / 1024.0f) + NORM_EPS); f32x4 h[2];
#pragma unroll
                for (int n = 0; n < 2; ++n) { const f32x4 g = acc[ai][0][m][n] * s, uu = acc[ai][1][m][n] * s;
#pragma unroll
                    for (int i = 0; i < 4; ++i) { const float e = __builtin_amdgcn_exp2f(g[i] * (-LOG2E)); h[n][i] = g[i] * uu[i] * __builtin_amdgcn_rcpf(1.0f + e); } }
                st16(H, (size_t)row * 2816 + col0, pack8(h[0], h[1])); }
    }
};
struct EpiIn1 {
    static constexpr bool PERM = true, AFTER_DRAIN = false, PRE = true;
    bf16_t *Q, *Kk, *V, *QI, *KI; float* WI; const float* ss; const PG8_LAS float* qg; const PG8_LAS float* kg; float c2;
    __device__ __forceinline__ void pre(const Unit& u, int wr, int fr, float (&rs)[8]) const { const int row0 = u.pm * BM + (u.half == 2 ? HALF : 0) + wr * 64 + fr;
#pragma unroll
        for (int i = 0; i < 8; ++i) rs[i] = ss[row0 + ((i >> 2) && !u.half ? HALF : 0) + (i & 3) * 16]; }
    __device__ __forceinline__ void operator()(const f32x4 (&acc)[2][2][4][2], const Unit& u, int wr, int wc, int fr, int fq, const float (&rs)[8]) const {
        const int row0 = u.pm * BM + (u.half == 2 ? HALF : 0) + wr * 64 + fr, pn = u.pn;
        if (pn <= 4) {
            const PG8_LAS float* gs = (pn < 4) ? qg : kg; const float gm = (pn < 4) ? c2 : 1.f; f32x4 gv[2][2];
#pragma unroll
            for (int bj = 0; bj < 2; ++bj)
#pragma unroll
                for (int n = 0; n < 2; ++n) gv[bj][n] = *(const PG8_LAS f32x4*)(gs + 32 * bj + 8 * fq + 4 * n) * gm;
#pragma unroll
            for (int ai = 0; ai < 2; ++ai)
#pragma unroll
                for (int m = 0; m < 4; ++m) { if (ai == 1 && u.half) continue; const int row = row0 + ai * HALF + m * 16; const float s = __builtin_amdgcn_rsqf(rs[ai * 4 + m] * (1.0f / 1024.0f) + NORM_EPS); f32x4 v[2][2]; float q = 0.f;
#pragma unroll
                    for (int bj = 0; bj < 2; ++bj)
#pragma unroll
                        for (int n = 0; n < 2; ++n) { v[bj][n] = acc[ai][bj][m][n] * s; q += dot4(v[bj][n]); }
                    q += __shfl_xor(q, 16); q += __shfl_xor(q, 32);
                    const float rn = __builtin_amdgcn_rsqf(q * (1.0f / 64.0f) + NORM_EPS);
                    bf16_t* dstb = (pn < 4) ? Q : Kk; const size_t dste = (pn < 4) ? (size_t)row * 1024 + pn * 256 + wc * 64 + 8 * fq : (size_t)row * 256 + wc * 64 + 8 * fq;
#pragma unroll
                    for (int bj = 0; bj < 2; ++bj) st16(dstb, dste + bj * 32, pack8(v[bj][0] * rn * gv[bj][0], v[bj][1] * rn * gv[bj][1])); }
        } else {
#pragma unroll
            for (int ai = 0; ai < 2; ++ai)
#pragma unroll
                for (int m = 0; m < 4; ++m) { if (ai == 1 && u.half) continue; const int row = row0 + ai * HALF + m * 16; const float s = __builtin_amdgcn_rsqf(rs[ai * 4 + m] * (1.0f / 1024.0f) + NORM_EPS);
                    if (pn == 8) {
                        if (wc == 0) {
#pragma unroll
                            for (int bj = 0; bj < 2; ++bj) st16(KI, (size_t)row * 64 + bj * 32 + 8 * fq, pack8(acc[ai][bj][m][0] * s, acc[ai][bj][m][1] * s));
                        } else if (wc == 1 && fq == 0) { { const f32x4 wa_ = acc[ai][0][m][0] * s, wb_ = acc[ai][0][m][1] * s; const __amdgpu_buffer_rsrc_t rw_ = __builtin_amdgcn_make_buffer_rsrc((void*)WI, (short)0, 0x7ffffff0, 0x00020000);
                            __builtin_amdgcn_raw_buffer_store_b128(__builtin_bit_cast(u32x4, wa_), rw_, (int)((size_t)row * 32), 0, 16); __builtin_amdgcn_raw_buffer_store_b128(__builtin_bit_cast(u32x4, wb_), rw_, (int)((size_t)row * 32 + 16), 0, 16); } }
                    } else {
                        bf16_t* dstb = (pn == 5) ? V : QI; const size_t dste = (pn == 5) ? (size_t)row * 256 + wc * 64 + 8 * fq : (size_t)row * 512 + (pn - 6) * 256 + wc * 64 + 8 * fq;
#pragma unroll
                        for (int bj = 0; bj < 2; ++bj) st16(dstb, dste + bj * 32, pack8(acc[ai][bj][m][0] * s, acc[ai][bj][m][1] * s));
                    } }
        }
    }
};
template <class Epi, class Sched, bool ALIGN_EPI = false, bool SP2 = false>
__device__ __forceinline__ void gemm_phase(PG8_LAS unsigned char* lds, const Gemm g, const Sched& S, const Epi& E) {
    const int tid = threadIdx.x, wid = __builtin_amdgcn_readfirstlane(tid >> 6), lane = tid & 63, wr = wid >> 2, wc = wid & 3, fr = lane & 15, fq = lane >> 4;
    const int K = g.K, nt = K / BK;
    unsigned voffA[2], voffB[2];
#pragma unroll
    for (int i = 0; i < 2; ++i) { int R, C; stage_rc(tid * 16 + i * 8192, R, C); const int Rb = Epi::PERM ? ((R & ~31) + perm32(R & 31)) : R;
        voffA[i] = (unsigned)(R * K + C) * 2u; voffB[i] = (unsigned)(Rb * K + C) * 2u; }
    const size_t kstep = (size_t)(BK * 2);
    const size_t hstep = (size_t)HALF * K * 2;
    const size_t tstep = 2 * hstep;
    const unsigned ldsw = (unsigned)wid * 1024u;
    const int aoff = lds_byte(wr * 64 + fr, fq * 8), boff = lds_byte(wc * 32 + fr, fq * 8);
#define PG8_SA(b, h) (((b) * 2 + (h)) * HTB)
#define PG8_SB(b, h) ((4 + (b) * 2 + (h)) * HTB)
#define PG8_STAGE(bufoff, gbase, voff) do { _Pragma("unroll") for (int _i = 0; _i < 2; ++_i) \
        __builtin_amdgcn_global_load_lds((const unsigned*)((const char*)(gbase) + (voff)[_i]), (PG8_LAS unsigned*)(lds + (bufoff) + ldsw + _i * 8192), 16, 0, 0); } while (0)
#define PG8_LDA(dst, b, h) do { _Pragma("unroll") for (int m = 0; m < 4; ++m) _Pragma("unroll") for (int k = 0; k < 2; ++k) dst[m][k] = *(const PG8_LAS bf16x8*)(lds + PG8_SA(b, h) + aoff + m * 2048 + k * 1024); } while (0)
#define PG8_LDB(dst, b, h) do { _Pragma("unroll") for (int n = 0; n < 2; ++n) _Pragma("unroll") for (int k = 0; k < 2; ++k) dst[n][k] = *(const PG8_LAS bf16x8*)(lds + PG8_SB(b, h) + boff + n * 2048 + k * 1024); } while (0)
#define PG8_MMA(ai, bj, At, Bt) do { __builtin_amdgcn_s_setprio(1); _Pragma("unroll") for (int m = 0; m < 4; ++m) _Pragma("unroll") for (int n = 0; n < 2; ++n) _Pragma("unroll") for (int k = 0; k < 2; ++k) \
        acc[ai][bj][m][n] = __builtin_amdgcn_mfma_f32_16x16x32_bf16(Bt[n][k], At[m][k], acc[ai][bj][m][n], 0, 0, 0); __builtin_amdgcn_s_setprio(0); } while (0)
#define PG8_WAIT_V(n) asm volatile("s_waitcnt vmcnt(" #n ")" ::: "memory")
#define PG8_WAIT_L(n) asm volatile("s_waitcnt lgkmcnt(" #n ")" ::: "memory")
#define PG8_BAR __builtin_amdgcn_s_barrier()
#define PG8_SCHED __builtin_amdgcn_sched_barrier(0)
    Unit cur, nxt; int ui = 0;
    if (!S.next(0, cur)) return;
    f32x4 acc[2][2][4][2];
#pragma unroll
    for (int a = 0; a < 2; ++a)
#pragma unroll
        for (int b = 0; b < 2; ++b)
#pragma unroll
            for (int m = 0; m < 4; ++m)
#pragma unroll
                for (int n = 0; n < 2; ++n) acc[a][b][m][n] = (f32x4){0.f, 0.f, 0.f, 0.f};
    bf16x8 At[4][2], B0[2][2], B1[2][2];
    const char* cA = (const char*)g.A + (size_t)cur.pm * tstep + ((Sched::HAS_HALF && cur.half == 2) ? hstep : 0); const char* cB = (const char*)g.Bt + (size_t)cur.pn * tstep;
    unsigned cHs = (Sched::HAS_HALF && cur.half) ? 0u : (unsigned)hstep;
    S.a_ready(cur);
    float rs8[8];
    if constexpr (Epi::PRE) E.pre(cur, wr, fr, rs8);
    if constexpr (SP2) {
        PG8_STAGE(PG8_SB(0, 0), cB, voffB); PG8_STAGE(PG8_SB(0, 1), cB + hstep, voffB); PG8_STAGE(PG8_SA(0, 0), cA, voffA); PG8_STAGE(PG8_SA(0, 1), cA + cHs, voffA);
        if (wr == 1) PG8_BAR;
        PG8_WAIT_V(2); PG8_BAR;
        PG8_STAGE(PG8_SB(1, 0), cB + kstep, voffB); PG8_STAGE(PG8_SA(1, 0), cA + kstep, voffA); PG8_STAGE(PG8_SB(1, 1), cB + hstep + kstep, voffB);
        PG8_WAIT_V(6); PG8_BAR;
    } else {
        PG8_STAGE(PG8_SB(0, 0), cB, voffB); PG8_STAGE(PG8_SA(0, 0), cA, voffA); PG8_STAGE(PG8_SB(0, 1), cB + hstep, voffB); PG8_STAGE(PG8_SA(0, 1), cA + hstep, voffA);
        if (wr == 1) PG8_BAR;
        PG8_WAIT_V(4); PG8_BAR;
        PG8_STAGE(PG8_SB(1, 0), cB + kstep, voffB); PG8_STAGE(PG8_SA(1, 0), cA + kstep, voffA); PG8_STAGE(PG8_SB(1, 1), cB + hstep + kstep, voffB);
        PG8_WAIT_V(6); PG8_BAR;
    }
    for (;;) {
        const bool has_next = S.next(ui + 1, nxt);
        const char* nA = has_next ? (const char*)g.A + (size_t)nxt.pm * tstep + ((Sched::HAS_HALF && nxt.half == 2) ? hstep : 0) : cA; const char* nB = has_next ? (const char*)g.Bt + (size_t)nxt.pn * tstep : cB;
        const unsigned nHs = has_next ? ((Sched::HAS_HALF && nxt.half) ? 0u : (unsigned)hstep) : cHs;
        for (int t = 0; t < nt; t += 2) {
            const bool last = (t == nt - 2);
            const char* a1 = cA + (size_t)(t + 1) * kstep;
            const char* a2 = last ? nA : cA + (size_t)(t + 2) * kstep; const char* b2 = last ? nB : cB + (size_t)(t + 2) * kstep;
            const char* a3 = a2 + kstep; const char* b3 = b2 + kstep;
            const unsigned hs2 = last ? nHs : cHs;
            if (last && has_next) S.a_ready(nxt);
            if constexpr (SP2) {
            PG8_LDB(B0, 0, 0); PG8_LDB(B1, 0, 1); PG8_SCHED; PG8_LDA(At, 0, 0); PG8_STAGE(PG8_SA(1, 1), a1 + cHs, voffA);
            PG8_WAIT_V(8); PG8_WAIT_L(0); PG8_BAR; PG8_MMA(0, 0, At, B0); PG8_MMA(0, 1, At, B1); PG8_BAR; PG8_SCHED;
            PG8_LDA(At, 0, 1); PG8_STAGE(PG8_SB(0, 0), b2, voffB); PG8_STAGE(PG8_SB(0, 1), b2 + hstep, voffB); PG8_STAGE(PG8_SA(0, 0), a2, voffA);
            PG8_WAIT_V(8); PG8_WAIT_L(0); PG8_BAR; if (!(Sched::HAS_HALF && cur.half)) { PG8_MMA(1, 0, At, B0); PG8_MMA(1, 1, At, B1); } PG8_BAR; PG8_SCHED;
            PG8_LDB(B0, 1, 0); PG8_LDB(B1, 1, 1); PG8_SCHED; PG8_LDA(At, 1, 0); PG8_STAGE(PG8_SA(0, 1), a2 + hs2, voffA);
            PG8_WAIT_V(8); PG8_WAIT_L(0); PG8_BAR; PG8_MMA(0, 0, At, B0); PG8_MMA(0, 1, At, B1); PG8_BAR; PG8_SCHED;
            PG8_LDA(At, 1, 1); PG8_STAGE(PG8_SB(1, 0), b3, voffB); PG8_STAGE(PG8_SB(1, 1), b3 + hstep, voffB); PG8_STAGE(PG8_SA(1, 0), a3, voffA);
            PG8_WAIT_V(8); PG8_WAIT_L(0); PG8_BAR; if (!(Sched::HAS_HALF && cur.half)) { PG8_MMA(1, 0, At, B0); PG8_MMA(1, 1, At, B1); } PG8_BAR; PG8_SCHED;
            } else {
            PG8_LDB(B0, 0, 0); PG8_SCHED; PG8_LDA(At, 0, 0); PG8_STAGE(PG8_SA(1, 1), a1 + hstep, voffA);
            PG8_WAIT_L(8); PG8_BAR; PG8_WAIT_L(0); PG8_MMA(0, 0, At, B0); PG8_BAR; PG8_SCHED;
            PG8_LDB(B1, 0, 1); PG8_STAGE(PG8_SB(0, 0), b2, voffB);
            PG8_BAR; PG8_WAIT_L(0); PG8_MMA(0, 1, At, B1); PG8_BAR;
            PG8_LDA(At, 0, 1); PG8_STAGE(PG8_SA(0, 0), a2, voffA);
            PG8_BAR; PG8_WAIT_L(0); PG8_MMA(1, 0, At, B0); PG8_BAR; PG8_SCHED;
            PG8_STAGE(PG8_SB(0, 1), b2 + hstep, voffB);
            PG8_WAIT_V(6); PG8_BAR; PG8_MMA(1, 1, At, B1); PG8_BAR;
            PG8_LDB(B0, 1, 0); PG8_SCHED; PG8_LDA(At, 1, 0); PG8_STAGE(PG8_SA(0, 1), a2 + hstep, voffA);
            PG8_WAIT_L(8); PG8_BAR; PG8_WAIT_L(0); PG8_MMA(0, 0, At, B0); PG8_BAR; PG8_SCHED;
            PG8_LDB(B1, 1, 1); PG8_STAGE(PG8_SB(1, 0), b3, voffB);
            PG8_BAR; PG8_WAIT_L(0); PG8_MMA(0, 1, At, B1); PG8_BAR;
            PG8_LDA(At, 1, 1); PG8_STAGE(PG8_SA(1, 0), a3, voffA);
            PG8_BAR; PG8_WAIT_L(0); PG8_MMA(1, 0, At, B0); PG8_BAR; PG8_SCHED;
            PG8_STAGE(PG8_SB(1, 1), b3 + hstep, voffB);
            PG8_WAIT_V(6); PG8_BAR; PG8_MMA(1, 1, At, B1); PG8_BAR;
            }
        }
        if constexpr (ALIGN_EPI) { if (wr == 0) PG8_BAR; }
        if constexpr (!Epi::AFTER_DRAIN) { if constexpr (Epi::PRE) E(acc, cur, wr, wc, fr, fq, rs8); else E(acc, cur, wr, wc, fr, fq); S.done(cur); }
        if (!has_next) break;
#pragma unroll
        for (int a = 0; a < 2; ++a)
#pragma unroll
            for (int b = 0; b < 2; ++b)
#pragma unroll
                for (int m = 0; m < 4; ++m)
#pragma unroll
                    for (int n = 0; n < 2; ++n) acc[a][b][m][n] = (f32x4){0.f, 0.f, 0.f, 0.f};
        cur = nxt; cA = nA; cB = nB; cHs = nHs; ++ui;
        if constexpr (Epi::PRE) E.pre(cur, wr, fr, rs8);
        if constexpr (ALIGN_EPI) { if (wr == 1) PG8_BAR; }
    }
    PG8_WAIT_V(0);
    if constexpr (!ALIGN_EPI) { if (wr == 0) PG8_BAR; }
    PG8_BAR;
    if constexpr (Epi::AFTER_DRAIN) { E.fused(acc, cur, wr, wc, fr, fq, lds, wid, lane); S.done(cur); }
#undef PG8_SA
#undef PG8_SB
#undef PG8_STAGE
#undef PG8_LDA
#undef PG8_LDB
#undef PG8_MMA
#undef PG8_WAIT_V
#undef PG8_WAIT_L
#undef PG8_BAR
#undef PG8_SCHED
}
}
#ifndef PG8_SP2
#define PG8_SP2 true
#endif
#ifndef PG8_ALIGN
#define PG8_ALIGN true
#endif
constexpr int NWAVES = 8;
#ifndef MK_ONE_LAUNCH
#define MK_ONE_LAUNCH 1
#endif
#ifndef SB_FAST
#define SB_FAST 2
#endif
#ifndef IDX_FAST
#define IDX_FAST 1
#endif
#ifndef DSA_FAST
#define DSA_FAST 2
#endif
#ifndef DSA_WIDE
#define DSA_WIDE 1
#endif
#ifndef MASK_T
#define MASK_T 1
#endif
#ifndef P6_MINI
#define P6_MINI 0
#endif
#ifndef PROBE_IDX
#define PROBE_IDX 0
#endif
#ifndef PROBE_DSA
#define PROBE_DSA 0
#endif
#ifndef PROBE_REP
#define PROBE_REP -1
#endif
constexpr int NPH = 12;

constexpr int BATCH = 8, S = 2048, D = 1024, M = BATCH * S;
constexpr int EVEN_IN = 3072, ODD_IN = 2120, ODD_PAD = 2304, FF = 2816, GU = 2 * FF;
constexpr int TOPK = 256;
constexpr float C2 = 0.125f * 1.4426950408889634f;

constexpr size_t MiB = 1u << 20;
constexpr size_t WS_CTL = 0, CTL_ZERO_BYTES = MiB / 2;
constexpr size_t WS_W_IN0 = 1 * MiB, WS_W_OUT0 = 7 * MiB, WS_W_GU0 = 9 * MiB, WS_W_DN0 = 20 * MiB, WS_W_IN1 = 26 * MiB, WS_W_OUT1 = 31 * MiB, WS_W_GU1 = 33 * MiB, WS_W_DN1 = 44 * MiB;
constexpr size_t WS_XB = 50 * MiB;
constexpr size_t WS_ATT = 82 * MiB;
constexpr size_t WS_BIG = 114 * MiB;
constexpr size_t WS_PROJ0 = WS_BIG;
constexpr size_t WS_H = WS_BIG;
constexpr size_t WS_Q1 = WS_BIG, WS_K1 = WS_BIG + 32 * MiB, WS_V1 = WS_BIG + 40 * MiB, WS_QI = WS_BIG + 48 * MiB, WS_KI = WS_BIG + 64 * MiB, WS_WI = WS_BIG + 66 * MiB, WS_MASK = WS_BIG + 68 * MiB;
constexpr size_t WS_END = 256 * MiB;
static_assert(WS_W_DN1 + (size_t)D * FF * 2 <= WS_XB && WS_PROJ0 + (size_t)M * EVEN_IN * 2 <= WS_END && WS_MASK + (size_t)M * 256 <= WS_END, "d_ws map");
constexpr int CW_BAR = 4096;
constexpr int CW_SS = 65536;

#define GAS __attribute__((address_space(1)))
#define LAS __attribute__((address_space(3)))
typedef unsigned short bf16;
typedef unsigned v4u __attribute__((ext_vector_type(4)));
typedef float f32x4 __attribute__((ext_vector_type(4)));
typedef short bf16x8 __attribute__((ext_vector_type(8)));
typedef GAS unsigned gu32;
#define RLX_AGENT __ATOMIC_RELAXED, __HIP_MEMORY_SCOPE_AGENT
#define LDS_WAIT() asm volatile("s_waitcnt lgkmcnt(0)" ::: "memory")
#define VM_WAIT() asm volatile("s_waitcnt vmcnt(0)" ::: "memory")
__device__ __forceinline__ unsigned f2bf(float f) { unsigned u = __builtin_bit_cast(unsigned, f); return (u + 0x7fffu + ((u >> 16) & 1u)) >> 16; }
__device__ __forceinline__ unsigned pk2(float lo, float hi) { return f2bf(lo) | (f2bf(hi) << 16); }
__device__ __forceinline__ float bf2f(unsigned short b) { return __builtin_bit_cast(float, (unsigned)b << 16); }
__device__ __forceinline__ float bflo(unsigned w) { return __builtin_bit_cast(float, w << 16); }
__device__ __forceinline__ float bfhi(unsigned w) { return __builtin_bit_cast(float, w & 0xffff0000u); }
#define XB_TMO      128
#define XB_XCNT(j)  (256  + 64 * (j))
#define XB_XSUB(j)  (1280 + 64 * (j))
#define XB_XGEN(j)  (2304 + 64 * (j))
#define XB_TOP      3328
#define XB_TOPGEN   3392
#define XCD_BAR_WORDS 3456
#define XB_SPIN_CAP (1u << 18)

__device__ __forceinline__ unsigned xb_ld(unsigned* p)              { return __hip_atomic_load(p, __ATOMIC_RELAXED, __HIP_MEMORY_SCOPE_AGENT); }
__device__ __forceinline__ unsigned xb_add(unsigned* p, unsigned v) { return __hip_atomic_fetch_add(p, v, __ATOMIC_RELAXED, __HIP_MEMORY_SCOPE_AGENT); }
__device__ __forceinline__ unsigned xb_xcc_id() { return (unsigned)__builtin_amdgcn_s_getreg((3 << 11) | 20) & 0xFu; }
#define XB_SPIN(cond, bar) do { unsigned _sp = 0; while (cond) { __builtin_amdgcn_s_sleep(1); \
    if ((++_sp & 255u) == 0u) { if (xb_ld(&(bar)[XB_TMO])) break; if (_sp > XB_SPIN_CAP) { atomicAdd(&(bar)[XB_TMO], 1u); break; } } } } while (0)

struct XcdBarrier {
    unsigned* bar; unsigned x;
    volatile LAS unsigned* st;
};

__device__ __forceinline__ XcdBarrier xcd_barrier_post(unsigned* bar, volatile LAS unsigned* st) {
    XcdBarrier b; b.bar = bar; b.x = xb_xcc_id(); b.st = st;
    if (threadIdx.x == 0) (void)xb_add(&bar[XB_XCNT(b.x)], 1u);
    return b;
}
__device__ __forceinline__ void xcd_barrier_complete(unsigned* bar, unsigned x, unsigned& nloc, unsigned& nx) {
    const unsigned G = gridDim.x * gridDim.y * gridDim.z;
    unsigned sum, cnt, mine, sp = 0u;
    for (;;) {
        sum = 0u; cnt = 0u; mine = 0u;
#pragma unroll
        for (unsigned j = 0; j < 16; ++j) { const unsigned c = xb_ld(&bar[XB_XCNT(j)]); sum += c; cnt += (c > 0u) ? 1u : 0u; mine = (j == x) ? c : mine; }
        if (sum == G) break;
        __builtin_amdgcn_s_sleep(1);
        if ((++sp & 255u) == 0u) { if (xb_ld(&bar[XB_TMO])) break; if (sp > XB_SPIN_CAP) { atomicAdd(&bar[XB_TMO], 1u); break; } }
    }
    nloc = mine > 0u ? mine : 1u; nx = cnt > 0u ? cnt : 1u;
}

__device__ __forceinline__ void xcd_barrier(const XcdBarrier& b, const bool wb = true) {
    asm volatile("s_waitcnt vmcnt(0)" ::: "memory");
    __syncthreads();
    if (threadIdx.x == 0) {
        unsigned* bar = b.bar;
        __builtin_amdgcn_s_waitcnt(0);
        unsigned nloc = b.st[0], nx = b.st[1];
        if (nloc == 0u) { xcd_barrier_complete(bar, b.x, nloc, nx); b.st[0] = nloc; b.st[1] = nx; }
        const unsigned old = xb_add(&bar[XB_XSUB(b.x)], 1u);
        const unsigned gen = old / nloc;
        __builtin_amdgcn_fence(__ATOMIC_ACQUIRE, "agent");
        if (old + 1u == (gen + 1u) * nloc) {
            if (wb) __builtin_amdgcn_fence(__ATOMIC_RELEASE, "agent");
            asm volatile("s_waitcnt vmcnt(0)" ::: "memory");
            const unsigned og = xb_add(&bar[XB_TOP], 1u);
            const unsigned tg = og / nx;
            if (og + 1u == (tg + 1u) * nx) xb_add(&bar[XB_TOPGEN], 1u);
            else XB_SPIN(xb_ld(&bar[XB_TOPGEN]) == tg, bar);
            xb_add(&bar[XB_XGEN(b.x)], 1u);
            asm volatile("s_waitcnt vmcnt(0)" ::: "memory");
        } else {
            XB_SPIN(xb_ld(&bar[XB_XGEN(b.x)]) == gen, bar);
            asm volatile("s_waitcnt vmcnt(0)" ::: "memory");
        }
    }
    __syncthreads();
}
constexpr int RING_OFF = 0, RING_BYTES = 160 * 1024 - 256;
constexpr int MISC_OFF = 160 * 1024 - 256;
constexpr int LDS_BYTES = 160 * 1024;
struct Frame {
    LAS unsigned char* lds; volatile LAS unsigned* MISC; gu32* ctl;
    int tid, lane, wave, vcu, G;
    const float *x, *norm_mix, *norm_ffn, *ev_w_in, *ev_conv_w, *ev_w_out, *od_w_in, *od_q_gain, *od_k_gain, *od_w_out, *rel_bias, *w_gate, *w_up, *w_down;
    float* out; float* SS;
    bf16 *W_in0, *W_out0, *W_gu0, *W_dn0, *W_in1, *W_out1, *W_gu1, *W_dn1;
    bf16 *XB, *ATT, *PROJ0, *H, *Q1, *K1, *V1, *QI, *KI; float* WI; unsigned long long* MASK;
};
__device__ __forceinline__ float wave_sum(float v) {
#pragma unroll
    for (int o = 1; o < 64; o <<= 1) v += __shfl_xor(v, o);
    return v;
}
__device__ __forceinline__ float wave_max(float v) {
#pragma unroll
    for (int o = 1; o < 64; o <<= 1) v = fmaxf(v, __shfl_xor(v, o));
    return v;
}
typedef unsigned v2u_t __attribute__((ext_vector_type(2)));
__device__ __forceinline__ void wt16(const void* base, size_t byte_off, const v4u v) { __builtin_amdgcn_raw_buffer_store_b128(v, __builtin_amdgcn_make_buffer_rsrc((void*)base, (short)0, 0x7ffffff0, 0x00020000), (int)byte_off, 0, 16); }
__device__ __forceinline__ void wt8(const void* base, size_t byte_off, unsigned lo, unsigned hi) { const v2u_t v = {lo, hi}; __builtin_amdgcn_raw_buffer_store_b64(v, __builtin_amdgcn_make_buffer_rsrc((void*)base, (short)0, 0x7ffffff0, 0x00020000), (int)byte_off, 0, 16); }
__device__ __forceinline__ void tr_item(const float* W, int ldw, int sc0, int nvalid, const float* gain, int K, bf16* WT, int drow0, LAS float* scr, int kb, int lane) {
    const int k0 = 64 * kb, c = sc0 + (lane & 31); const bool ok = c < nvalid;
    float v[32];
#pragma unroll
    for (int i = 0; i < 32; ++i) v[i] = ok ? W[(size_t)(k0 + 2 * i + (lane >> 5)) * ldw + c] : 0.f;
    const int ch = lane & 7;
    f32x4 g0 = {1.f, 1.f, 1.f, 1.f}, g1 = g0;
    if (gain) { g0 = *(const f32x4*)(gain + k0 + 8 * ch); g1 = *(const f32x4*)(gain + k0 + 8 * ch + 4); }
#pragma unroll
    for (int i = 0; i < 32; ++i) scr[(2 * i + (lane >> 5)) * 33 + (lane & 31)] = v[i];
    LDS_WAIT(); asm volatile("" ::: "memory");
#pragma unroll
    for (int j = 0; j < 4; ++j) { const int n = (lane >> 3) + 8 * j; const LAS float* s = scr + (8 * ch) * 33 + n;
        v4u o; o.x = pk2(s[0 * 33] * g0[0], s[1 * 33] * g0[1]); o.y = pk2(s[2 * 33] * g0[2], s[3 * 33] * g0[3]); o.z = pk2(s[4 * 33] * g1[0], s[5 * 33] * g1[1]); o.w = pk2(s[6 * 33] * g1[2], s[7 * 33] * g1[3]);
        wt16(WT, ((size_t)(drow0 + n) * K + k0 + 8 * ch) * 2, o); }
    LDS_WAIT(); asm volatile("" ::: "memory");
}
constexpr int I_IN0 = 16 * (EVEN_IN / 32), I_OUT = 16 * 32, I_GU = 16 * (GU / 32), I_DN = (FF / 64) * 32, I_IN1 = 16 * (ODD_PAD / 32);
constexpr int N_P0 = I_IN0 + I_OUT;
constexpr int N_EARLY = I_IN0 + I_OUT + I_GU, NITEMS = N_EARLY + I_DN + I_IN1 + I_OUT + I_GU + I_DN;
__device__ __forceinline__ void gu_item(Frame& F, int L, int r, LAS float* scr) { const int nb = GU / 32, kb = r / nb, db = r % nb, pn = db >> 3, j = db & 7;
    const float* W = ((j < 4) ? F.w_gate : F.w_up) + (size_t)L * D * FF;
    tr_item(W, FF, 128 * pn + 32 * (j & 3), FF, F.norm_ffn + L * D, D, L ? F.W_gu1 : F.W_gu0, 32 * db, scr, kb, F.lane); }
__device__ __forceinline__ void weight_item(Frame& F, int r, LAS float* scr) {
    if (r < I_IN0) { const int nb = EVEN_IN / 32, kb = r / nb, db = r % nb; tr_item(F.ev_w_in, EVEN_IN, 32 * db, EVEN_IN, F.norm_mix, D, F.W_in0, 32 * db, scr, kb, F.lane); return; } r -= I_IN0;
    if (r < I_OUT) { const int kb = r / 32, db = r % 32; tr_item(F.ev_w_out, D, 32 * db, D, nullptr, D, F.W_out0, 32 * db, scr, kb, F.lane); return; } r -= I_OUT;
    if (r < I_GU) { gu_item(F, 0, r, scr); return; } r -= I_GU;
    if (r < I_DN) { const int kb = r / 32, db = r % 32; tr_item(F.w_down, D, 32 * db, D, nullptr, FF, F.W_dn0, 32 * db, scr, kb, F.lane); return; } r -= I_DN;
    if (r < I_IN1) { const int nb = ODD_PAD / 32, kb = r / nb, db = r % nb, pn = db >> 3, bj = (db >> 2) & 1, wc = db & 3;
        tr_item(F.od_w_in, ODD_IN, 256 * pn + 64 * wc + 32 * bj, ODD_IN, F.norm_mix + D, D, F.W_in1, 32 * db, scr, kb, F.lane); return; } r -= I_IN1;
    if (r < I_OUT) { const int kb = r / 32, db = r % 32; tr_item(F.od_w_out, D, 32 * db, D, nullptr, D, F.W_out1, 32 * db, scr, kb, F.lane); return; } r -= I_OUT;
    if (r < I_GU) { gu_item(F, 1, r, scr); return; } r -= I_GU;
    { const int kb = r / 32, db = r % 32; tr_item(F.w_down + (size_t)FF * D, D, 32 * db, D, nullptr, FF, F.W_dn1, 32 * db, scr, kb, F.lane); }
}
constexpr int N_MID = N_EARLY + I_DN + I_IN1 + I_OUT;
__device__ __forceinline__ void late_weights(Frame& F, int lo_it, int hi_it) {
    if (F.G != 256 || (int)blockIdx.x < 128) return;
    LAS float* scr = (LAS float*)(F.lds + RING_OFF + F.wave * 16384);
    for (int it = lo_it + ((int)blockIdx.x - 128) * NWAVES + F.wave; it < hi_it; it += 128 * NWAVES) weight_item(F, it, scr);
}
__device__ __forceinline__ void p2_weights(Frame& F) {
    if (F.G != 256) return;
    LAS float* scr = (LAS float*)(F.lds + RING_OFF + F.wave * 16384);
    for (int it = N_P0 + F.vcu * NWAVES + F.wave; it < N_EARLY; it += F.G * NWAVES) weight_item(F, it, scr);
}
__device__ __forceinline__ void p0_prologue(Frame& F) {
    LAS float* scr = (LAS float*)(F.lds + RING_OFF + F.wave * 16384);
    const int gw = F.vcu * NWAVES + F.wave, NGW = F.G * NWAVES;
    const int nit = (F.G == 256) ? N_P0 : NITEMS;
    for (int it = gw; it < nit; it += NGW) weight_item(F, it, scr);
    for (int m = gw; m < M; m += 2 * NGW) {
        const int m2 = m + NGW; const bool has2 = m2 < M;
        const GAS f32x4* xa = (const GAS f32x4*)(F.x + (size_t)m * D) + F.lane; const GAS f32x4* xb = (const GAS f32x4*)(F.x + (size_t)(has2 ? m2 : m) * D) + F.lane;
        f32x4 va[4], vb[4];
#pragma unroll
        for (int j = 0; j < 4; ++j) { va[j] = xa[64 * j]; vb[j] = xb[64 * j]; }
        GAS unsigned long long* oa = (GAS unsigned long long*)(F.XB + (size_t)m * D) + F.lane; GAS unsigned long long* ob = (GAS unsigned long long*)(F.XB + (size_t)m2 * D) + F.lane; float sa = 0.f, sb = 0.f;
#pragma unroll
        for (int j = 0; j < 4; ++j) { const f32x4 a = va[j], c = vb[j]; sa += (a.x * a.x + a.y * a.y) + (a.z * a.z + a.w * a.w); sb += (c.x * c.x + c.y * c.y) + (c.z * c.z + c.w * c.w);
            wt8(F.XB, ((size_t)m * D) * 2 + (size_t)(F.lane + 64 * j) * 8, pk2(a.x, a.y), pk2(a.z, a.w)); if (has2) wt8(F.XB, ((size_t)m2 * D) * 2 + (size_t)(F.lane + 64 * j) * 8, pk2(c.x, c.y), pk2(c.z, c.w)); }
        sa = wave_sum(sa); sb = wave_sum(sb); if (F.lane == 0) { const __amdgpu_buffer_rsrc_t rs_ = __builtin_amdgcn_make_buffer_rsrc((void*)F.SS, (short)0, 0x7ffffff0, 0x00020000); __builtin_amdgcn_raw_buffer_store_b32(__builtin_bit_cast(unsigned, sa), rs_, m * 4, 0, 16); if (has2) __builtin_amdgcn_raw_buffer_store_b32(__builtin_bit_cast(unsigned, sb), rs_, m2 * 4, 0, 16); }
    }
}
__device__ __forceinline__ void ld8(const bf16* p, float (&f)[8]) { const v4u w = *(const v4u*)p; f[0] = bflo(w.x); f[1] = bfhi(w.x); f[2] = bflo(w.y); f[3] = bfhi(w.y); f[4] = bflo(w.z); f[5] = bfhi(w.z); f[6] = bflo(w.w); f[7] = bfhi(w.w); }
__device__ __forceinline__ int rel_bucket(int dist) { if (dist < 16) return dist; const int l = 16 + (int)(logf((float)dist * (1.0f / 16.0f)) / logf(8.0f) * 16.0f); return l < 31 ? l : 31; }
__device__ __forceinline__ unsigned ord_key(float f) { unsigned u = __builtin_bit_cast(unsigned, f); if (u == 0x80000000u) u = 0u; return (u & 0x80000000u) ? ~u : (u | 0x80000000u); }
__device__ __forceinline__ void unpk8(const v4u w, float (&f)[8]) { f[0] = bflo(w.x); f[1] = bfhi(w.x); f[2] = bflo(w.y); f[3] = bfhi(w.y); f[4] = bflo(w.z); f[5] = bfhi(w.z); f[6] = bflo(w.w); f[7] = bfhi(w.w); }
__device__ __forceinline__ void conv_part(Frame& F) {
    const int gt = (F.vcu * NWAVES + F.wave) * 64 + F.lane, NT = F.G * NWAVES * 64;
    for (int it = gt; it < (M / 4) * 64; it += NT) { const int c8 = (it & 63) * 8, row0 = (it >> 6) * 4; const bool first = (row0 & (S - 1)) == 0;
        v4u bgw[4], cgw[6], uuw[6];
#pragma unroll
        for (int r = 0; r < 4; ++r) bgw[r] = *(const v4u*)(F.PROJ0 + (size_t)(row0 + r) * EVEN_IN + 1536 + c8);
#pragma unroll
        for (int r = 0; r < 6; ++r) { const int rr = (first && r < 2) ? row0 : row0 - 2 + r; const bf16* p = F.PROJ0 + (size_t)rr * EVEN_IN; cgw[r] = *(const v4u*)(p + 2048 + c8); uuw[r] = *(const v4u*)(p + 2560 + c8); }
        float w0[8], w1[8], w2[8];
#pragma unroll
        for (int i = 0; i < 8; ++i) { w0[i] = F.ev_conv_w[c8 + i]; w1[i] = F.ev_conv_w[512 + c8 + i]; w2[i] = F.ev_conv_w[1024 + c8 + i]; }
        float ga[8], gb[8], gc[8];
        { float c[8], u[8]; unpk8(cgw[0], c); unpk8(uuw[0], u);
#pragma unroll
          for (int i = 0; i < 8; ++i) ga[i] = first ? 0.f : c[i] * u[i];
          unpk8(cgw[1], c); unpk8(uuw[1], u);
#pragma unroll
          for (int i = 0; i < 8; ++i) gb[i] = first ? 0.f : c[i] * u[i]; }
#pragma unroll
        for (int r = 0; r < 4; ++r) { float c[8], u[8], bg[8], y[8]; unpk8(cgw[r + 2], c); unpk8(uuw[r + 2], u); unpk8(bgw[r], bg);
#pragma unroll
            for (int i = 0; i < 8; ++i) { gc[i] = c[i] * u[i]; y[i] = (w0[i] * ga[i] + w1[i] * gb[i]) + w2[i] * gc[i]; ga[i] = gb[i]; gb[i] = gc[i]; }
            v4u o; o.x = pk2(bg[0] * y[0], bg[1] * y[1]); o.y = pk2(bg[2] * y[2], bg[3] * y[3]); o.z = pk2(bg[4] * y[4], bg[5] * y[5]); o.w = pk2(bg[6] * y[6], bg[7] * y[7]);
            wt16(F.ATT, ((size_t)(row0 + r) * D + 512 + c8) * 2, o); }
    }
}
__device__ __forceinline__ void sb_naive(Frame& F) {
    const int gw = F.vcu * NWAVES + F.wave, NGW = F.G * NWAVES;
    for (int idx = gw; idx < M * 8; idx += NGW) { const int h = idx & 7, row = idx >> 3, t = row & (S - 1);
        const float qd = bf2f(F.PROJ0[(size_t)row * EVEN_IN + h * 64 + F.lane]); float o = 0.f, carry = 1.f;
        for (int s = t - 1; s >= 0; --s) { const bf16* p = F.PROJ0 + (size_t)(row - t + s) * EVEN_IN + h * 64 + F.lane;
            const float z2 = wave_sum(qd * bf2f(p[512])), e = __builtin_amdgcn_exp2f(z2), a = __builtin_amdgcn_rcpf(1.0f + e), beta = 1.0f - a;
            o += beta * carry * bf2f(p[1024]); carry *= a; if (carry < 7.8886091e-31f) break; }
        F.ATT[(size_t)row * D + h * 64 + F.lane] = (bf16)f2bf(o); }
}
#define TK_CNT8(ACC, B, OP, X) do { unsigned long long q0 = __ballot(key[(B) + 0] OP (X)), q1 = __ballot(key[(B) + 1] OP (X)), q2 = __ballot(key[(B) + 2] OP (X)), q3 = __ballot(key[(B) + 3] OP (X)), \
        q4 = __ballot(key[(B) + 4] OP (X)), q5 = __ballot(key[(B) + 5] OP (X)), q6 = __ballot(key[(B) + 6] OP (X)), q7 = __ballot(key[(B) + 7] OP (X)); \
        asm volatile("" : "+s"(q0), "+s"(q1), "+s"(q2), "+s"(q3), "+s"(q4), "+s"(q5), "+s"(q6), "+s"(q7)); \
        ACC += (__popcll(q0) + __popcll(q1)) + (__popcll(q2) + __popcll(q3)) + (__popcll(q4) + __popcll(q5)) + (__popcll(q6) + __popcll(q7)); } while (0)
#define tk_put(lo, hi, w, i) do { const unsigned long long w_ = (w); if (lane == (i)) { lo = (unsigned)w_; hi = (unsigned)(w_ >> 32); } } while (0)
__device__ __forceinline__ void topk_row(const LAS float* sc, int n, unsigned long long* mrow, int lane) {
    unsigned wlo = 0u, whi = 0u;
    if (n <= TOPK) {
#pragma unroll
        for (int i = 0; i < 4; ++i) tk_put(wlo, whi, __ballot(64 * i + lane < n), i);
    } else {
        unsigned key[32];
        const int noct = (n + 511) >> 9;
#pragma unroll
        for (int c = 0; c < 4; ++c) {
            if (c < noct) {
#pragma unroll
                for (int i = 8 * c; i < 8 * c + 8; ++i) { const float f = sc[64 * i + lane]; key[i] = (64 * i + lane < n) ? ord_key(f) : 0u; }
            } else {
#pragma unroll
                for (int i = 8 * c; i < 8 * c + 8; ++i) key[i] = 0u; } }
        unsigned prefix = 0u; bool exact = false;
        for (int bit = 31; bit >= 0; --bit) { const unsigned cand = prefix | (1u << bit); int lc = 0;
#pragma unroll
            for (int i = 0; i < 8; ++i) lc += (key[i] >= cand) ? 1 : 0;
            if (noct > 1) {
#pragma unroll
                for (int i = 8; i < 16; ++i) lc += (key[i] >= cand) ? 1 : 0; }
            if (noct > 2) {
#pragma unroll
                for (int i = 16; i < 24; ++i) lc += (key[i] >= cand) ? 1 : 0; }
            if (noct > 3) {
#pragma unroll
                for (int i = 24; i < 32; ++i) lc += (key[i] >= cand) ? 1 : 0; }
            lc += __builtin_amdgcn_update_dpp(0, lc, 0xB1, 0xf, 0xf, true); lc += __builtin_amdgcn_update_dpp(0, lc, 0x4E, 0xf, 0xf, true);
            lc += __builtin_amdgcn_update_dpp(0, lc, 0x141, 0xf, 0xf, true); lc += __builtin_amdgcn_update_dpp(0, lc, 0x140, 0xf, 0xf, true);
            const int cnt = (__builtin_amdgcn_readlane(lc, 0) + __builtin_amdgcn_readlane(lc, 16)) + (__builtin_amdgcn_readlane(lc, 32) + __builtin_amdgcn_readlane(lc, 48));
            if (cnt >= TOPK) { prefix = cand; if (cnt == TOPK) { exact = true; break; } } }
        if (exact) {
#pragma unroll
            for (int c = 0; c < 4; ++c) { if (c < noct) {
#pragma unroll
                for (int i = 8 * c; i < 8 * c + 8; ++i) tk_put(wlo, whi, __ballot(key[i] >= prefix), i); } }
        } else {
            int gt = 0;
            TK_CNT8(gt, 0, >, prefix); TK_CNT8(gt, 8, >, prefix); TK_CNT8(gt, 16, >, prefix); TK_CNT8(gt, 24, >, prefix);
            const int need = TOPK - gt; int base = 0; const unsigned long long lt = (1ull << lane) - 1ull;
#pragma unroll
            for (int i = 0; i < 32; ++i) { const bool eq = key[i] == prefix; const unsigned long long be = __ballot(eq); const int rank = base + __popcll(be & lt); base += __popcll(be);
                tk_put(wlo, whi, __ballot(key[i] > prefix || (eq && rank < need)), i); }
        }
    }
    if (lane < 32) mrow[lane] = ((unsigned long long)whi << 32) | wlo;
}
#define TK_LOADKEYS(KEY, SC, N) do { _Pragma("unroll") for (int c = 0; c < 4; ++c) { if (c < noct) { _Pragma("unroll") for (int i = 8 * c; i < 8 * c + 8; ++i) { const float f = (SC)[64 * i + lane]; KEY[i] = (lane < (N) - 64 * i) ? ord_key(f) : 0u; } }     \
        else { _Pragma("unroll") for (int i = 8 * c; i < 8 * c + 8; ++i) KEY[i] = 0u; } } } while (0)
#define TK_FINAL(KEY, PREFIX, EXACT, MROW) do { unsigned wlo = 0u, whi = 0u; \
        if (EXACT) { _Pragma("unroll") for (int c = 0; c < 4; ++c) { if (c < noct) { _Pragma("unroll") for (int i = 8 * c; i < 8 * c + 8; ++i) tk_put(wlo, whi, __ballot(KEY[i] >= (PREFIX)), i); } } } \
        else { const unsigned* key = KEY; int gt = 0; TK_CNT8(gt, 0, >, (PREFIX)); TK_CNT8(gt, 8, >, (PREFIX)); TK_CNT8(gt, 16, >, (PREFIX)); TK_CNT8(gt, 24, >, (PREFIX)); \
            const int need = TOPK - gt; int base = 0; const unsigned long long lt = (1ull << lane) - 1ull; \
            _Pragma("unroll") for (int i = 0; i < 32; ++i) { const bool eq = KEY[i] == (PREFIX); const unsigned long long be = __ballot(eq); const int rank = base + __popcll(be & lt); base += __popcll(be); \
                tk_put(wlo, whi, __ballot(KEY[i] > (PREFIX) || (eq && rank < need)), i); } } \
        if (lane < 32) (MROW)[lane] = ((unsigned long long)whi << 32) | wlo; } while (0)
#define TK_WSUM(X) do { X += __builtin_amdgcn_update_dpp(0, X, 0xB1, 0xf, 0xf, true); X += __builtin_amdgcn_update_dpp(0, X, 0x4E, 0xf, 0xf, true); \
        X += __builtin_amdgcn_update_dpp(0, X, 0x141, 0xf, 0xf, true); X += __builtin_amdgcn_update_dpp(0, X, 0x140, 0xf, 0xf, true); } while (0)
__device__ __forceinline__ unsigned pk_lt1(unsigned candp, unsigned x, unsigned one) { unsigned d, t; asm("v_pk_sub_u16 %0, %1, %2 clamp" : "=v"(d) : "v"(candp), "v"(x)); asm("v_pk_min_u16 %0, %1, %2" : "=v"(t) : "v"(d), "v"(one)); return t; }
__device__ __forceinline__ unsigned pk_add16(unsigned a, unsigned b2) { unsigned r; asm("v_pk_add_u16 %0, %1, %2" : "=v"(r) : "v"(a), "v"(b2)); return r; }
__device__ __forceinline__ unsigned pk_mul16(unsigned a, unsigned b2) { unsigned r; asm("v_pk_mul_lo_u16 %0, %1, %2" : "=v"(r) : "v"(a), "v"(b2)); return r; }
#define TK_PKCOUNT(PA, PB, CA, CB, CNTA, CNTB) do { const unsigned cpa_ = (CA) * 0x10001u, cpb_ = (CB) * 0x10001u; \
        unsigned a0_ = pk_lt1(cpa_, PA[0], one), b0_ = pk_lt1(cpb_, PB[0], one), a1_ = pk_lt1(cpa_, PA[1], one), b1_ = pk_lt1(cpb_, PB[1], one);     \
        a0_ = pk_add16(a0_, pk_lt1(cpa_, PA[2], one)); b0_ = pk_add16(b0_, pk_lt1(cpb_, PB[2], one)); a1_ = pk_add16(a1_, pk_lt1(cpa_, PA[3], one)); b1_ = pk_add16(b1_, pk_lt1(cpb_, PB[3], one)); \
        _Pragma("unroll") for (int c_ = 1; c_ < 4; ++c_) { if (c_ < noct) { \
            a0_ = pk_add16(a0_, pk_lt1(cpa_, PA[4 * c_], one)); b0_ = pk_add16(b0_, pk_lt1(cpb_, PB[4 * c_], one)); a1_ = pk_add16(a1_, pk_lt1(cpa_, PA[4 * c_ + 1], one)); b1_ = pk_add16(b1_, pk_lt1(cpb_, PB[4 * c_ + 1], one)); \
            a0_ = pk_add16(a0_, pk_lt1(cpa_, PA[4 * c_ + 2], one)); b0_ = pk_add16(b0_, pk_lt1(cpb_, PB[4 * c_ + 2], one)); a1_ = pk_add16(a1_, pk_lt1(cpa_, PA[4 * c_ + 3], one)); b1_ = pk_add16(b1_, pk_lt1(cpb_, PB[4 * c_ + 3], one)); } } \
        a0_ = pk_add16(a0_, a1_); b0_ = pk_add16(b0_, b1_); int lab_ = (int)(((a0_ & 0xffffu) + (a0_ >> 16)) + (((b0_ & 0xffffu) + (b0_ >> 16)) << 16)); TK_WSUM(lab_);     \
        const unsigned sab_ = (unsigned)((__builtin_amdgcn_readlane(lab_, 0) + __builtin_amdgcn_readlane(lab_, 16)) + (__builtin_amdgcn_readlane(lab_, 32) + __builtin_amdgcn_readlane(lab_, 48))); \
        CNTA = 512 * noct - (int)(sab_ & 0xffffu); CNTB = 512 * noct - (int)(sab_ >> 16); } while (0)
__device__ __forceinline__ void tk_or(LAS unsigned* p, unsigned v) { __hip_atomic_fetch_or(p, v, __ATOMIC_RELAXED, __HIP_MEMORY_SCOPE_WORKGROUP); }
__device__ __forceinline__ void topk_pair(const LAS float* scA, int nA, unsigned long long* mrowA, const LAS float* scB, int nB, unsigned long long* mrowB, int lane, LAS unsigned* orb = nullptr, int wave = 0) {
    const unsigned cA = 1u << (wave + 16 * ((lane >> 2) & 1)), cB = cA << 8;
    LAS unsigned* op = orb + ((lane >> 3) * 4 + (lane & 3));
    if (nB <= TOPK) {
        if (MASK_T) {
#pragma unroll
            for (int i = 0; i < 4; ++i) tk_or(op + 32 * i, ((lane < nA - 64 * i) ? cA : 0u) | ((lane < nB - 64 * i) ? cB : 0u));
            return; }
        topk_row(scA, nA, mrowA, lane); topk_row(scB, nB, mrowB, lane); return; }
    const int noct = (nB + 511) >> 9;
    unsigned keyA[32], keyB[32];
    TK_LOADKEYS(keyA, scA, nA); TK_LOADKEYS(keyB, scB, nB);
    const unsigned one = 0x00010001u;
    unsigned PA[16], PB[16];
#pragma unroll
    for (int j = 0; j < 16; ++j) { PA[j] = (keyA[2 * j] >> 16) | (keyA[2 * j + 1] & 0xffff0000u); PB[j] = (keyB[2 * j] >> 16) | (keyB[2 * j + 1] & 0xffff0000u); }
    unsigned hA = 0u, hB = 0u, prefA = 0u, prefB = 0u; bool exA = false, exB = false, doneA = false, doneB = false;
    for (int bit = 15; bit >= 0; --bit) { const unsigned candA = hA | (1u << bit), candB = hB | (1u << bit); int cntA, cntB;
        TK_PKCOUNT(PA, PB, candA, candB, cntA, cntB);
        if (!doneA && cntA >= TOPK) { hA = candA; if (cntA == TOPK) { exA = true; doneA = true; prefA = candA << 16; } }
        if (!doneB && cntB >= TOPK) { hB = candB; if (cntB == TOPK) { exB = true; doneB = true; prefB = candB << 16; } }
        if (doneA && doneB) break; }
    if (!(doneA && doneB)) {
        { const unsigned ppa = hA * 0x10001u, ppb = hB * 0x10001u;
#pragma unroll
          for (int j = 0; j < 16; ++j) { unsigned gt_, lt_, lo_;
              { unsigned d_; asm("v_pk_sub_u16 %0, %1, %2 clamp" : "=v"(d_) : "v"(PA[j]), "v"(ppa)); asm("v_pk_min_u16 %0, %1, %2" : "=v"(gt_) : "v"(d_), "v"(one)); } lt_ = pk_lt1(ppa, PA[j], one);
              lo_ = (keyA[2 * j] & 0xffffu) | (keyA[2 * j + 1] << 16); PA[j] = (lo_ | pk_mul16(gt_, 0xffffffffu)) & ~pk_mul16(lt_, 0xffffffffu);
              { unsigned d_; asm("v_pk_sub_u16 %0, %1, %2 clamp" : "=v"(d_) : "v"(PB[j]), "v"(ppb)); asm("v_pk_min_u16 %0, %1, %2" : "=v"(gt_) : "v"(d_), "v"(one)); } lt_ = pk_lt1(ppb, PB[j], one);
              lo_ = (keyB[2 * j] & 0xffffu) | (keyB[2 * j + 1] << 16); PB[j] = (lo_ | pk_mul16(gt_, 0xffffffffu)) & ~pk_mul16(lt_, 0xffffffffu); } }
        unsigned lA = 0u, lB = 0u;
        for (int bit = 15; bit >= 0; --bit) { const unsigned candA = lA | (1u << bit), candB = lB | (1u << bit); int cntA, cntB;
            TK_PKCOUNT(PA, PB, candA, candB, cntA, cntB);
            if (!doneA && cntA >= TOPK) { lA = candA; if (cntA == TOPK) { exA = true; doneA = true; prefA = (hA << 16) | candA; } }
            if (!doneB && cntB >= TOPK) { lB = candB; if (cntB == TOPK) { exB = true; doneB = true; prefB = (hB << 16) | candB; } }
            if (doneA && doneB) break; }
        if (!doneA) prefA = (hA << 16) | lA;
        if (!doneB) prefB = (hB << 16) | lB;
    }
    if (MASK_T) {
        if (exA && exB) {
#pragma unroll
            for (int c = 0; c < 4; ++c) { if (c < noct) {
#pragma unroll
                for (int i = 8 * c; i < 8 * c + 8; ++i) tk_or(op + 32 * i, ((keyA[i] >= prefA) ? cA : 0u) | ((keyB[i] >= prefB) ? cB : 0u)); } }
        } else {
            int needA = 0, needB = 0; const unsigned tA = exA ? prefA - 1u : prefA, tB = exB ? prefB - 1u : prefB;
            if (!exA) { const unsigned* key = keyA; int gt = 0; TK_CNT8(gt, 0, >, prefA); TK_CNT8(gt, 8, >, prefA); TK_CNT8(gt, 16, >, prefA); TK_CNT8(gt, 24, >, prefA); needA = TOPK - gt; }
            if (!exB) { const unsigned* key = keyB; int gt = 0; TK_CNT8(gt, 0, >, prefB); TK_CNT8(gt, 8, >, prefB); TK_CNT8(gt, 16, >, prefB); TK_CNT8(gt, 24, >, prefB); needB = TOPK - gt; }
            int baseA = 0, baseB = 0; const unsigned long long lt = (1ull << lane) - 1ull;
#pragma unroll
            for (int c = 0; c < 4; ++c) { if (c < noct) {
#pragma unroll
                for (int i = 8 * c; i < 8 * c + 8; ++i) {
                    const bool eqA = keyA[i] == tA; const unsigned long long beA = __ballot(eqA); const int rankA = baseA + __popcll(beA & lt); baseA += __popcll(beA);
                    const bool eqB = keyB[i] == tB; const unsigned long long beB = __ballot(eqB); const int rankB = baseB + __popcll(beB & lt); baseB += __popcll(beB);
                    tk_or(op + 32 * i, ((keyA[i] > tA || (eqA && rankA < needA)) ? cA : 0u) | ((keyB[i] > tB || (eqB && rankB < needB)) ? cB : 0u)); } } }
        }
        return; }
    TK_FINAL(keyA, prefA, exA, mrowA); TK_FINAL(keyB, prefB, exB, mrowB);
}
#undef TK_PKCOUNT
#undef TK_LOADKEYS
#undef TK_FINAL
#undef TK_WSUM
__device__ __forceinline__ void idx_naive(Frame& F) {
    LAS float* qs = (LAS float*)(F.lds + RING_OFF);
    LAS float* ws = qs + 512;
    LAS float* sc = qs + 1024;
    for (int row = blockIdx.x; row < M; row += F.G) { const int t = row & (S - 1), n = t + 1;
        if (n > TOPK) {
            qs[F.tid] = bf2f(F.QI[(size_t)row * 512 + F.tid]); if (F.tid < 8) ws[F.tid] = F.WI[(size_t)row * 8 + F.tid] * (0.125f * 0.35355339059327373f);
            __syncthreads();
            for (int s = F.tid; s < n; s += NWAVES * 64) { asm volatile("" ::: "memory"); const bf16* kp = F.KI + (size_t)(row - t + s) * 64; float kf[64];
#pragma unroll
                for (int c = 0; c < 8; ++c) { float f[8]; ld8(kp + 8 * c, f);
#pragma unroll
                    for (int i = 0; i < 8; ++i) kf[8 * c + i] = f[i]; }
                float acc = 0.f;
#pragma unroll
                for (int h = 0; h < 8; ++h) { float d = 0.f;
#pragma unroll
                    for (int i = 0; i < 64; ++i) d += qs[h * 64 + i] * kf[i];
                    acc += ws[h] * fmaxf(d, 0.f); }
                sc[s] = acc; }
            __syncthreads();
        }
        if (F.wave == 0) topk_row(sc, n, F.MASK + (size_t)row * 32, F.lane);
        __syncthreads();
    }
}
__device__ __forceinline__ void dsa_naive(Frame& F) {
    LAS int* idx = (LAS int*)(F.lds + RING_OFF);
    LAS float* qf = (LAS float*)(F.lds + RING_OFF + 1024);
    LAS float* pl = (LAS float*)(F.lds + RING_OFF + 8192) + F.wave * 256;
    LAS int* cntp = (LAS int*)(F.lds + RING_OFF + 6144);
    for (int row = blockIdx.x; row < M; row += F.G) { const int t = row & (S - 1);
        for (int i = F.tid; i < 1024; i += NWAVES * 64) qf[i] = bf2f(F.Q1[(size_t)row * 1024 + i]);
        if (F.wave == 0) { int base = 0; const unsigned long long lt = (1ull << F.lane) - 1ull;
            for (int w = 0; w < 32; ++w) { const unsigned long long word = F.MASK[(size_t)row * 32 + w]; if ((word >> F.lane) & 1ull) idx[base + __popcll(word & lt)] = 64 * w + F.lane; base += __popcll(word); }
            if (F.lane == 0) cntp[0] = base; }
        __syncthreads();
        const int cnt = cntp[0];
        for (int hd = F.wave; hd < 16; hd += NWAVES) { const int g = hd >> 2; float lg[4]; float mx = -INFINITY;
#pragma unroll
            for (int j = 0; j < 4; ++j) { asm volatile("" ::: "memory"); const int ki = j * 64 + F.lane; lg[j] = -INFINITY;
                if (ki < cnt) { const int s = idx[ki]; const bf16* kp = F.K1 + (size_t)(row - t + s) * 256 + g * 64; float d = 0.f;
#pragma unroll
                    for (int c = 0; c < 8; ++c) { float f[8]; ld8(kp + 8 * c, f);
#pragma unroll
                        for (int i = 0; i < 8; ++i) d += qf[hd * 64 + 8 * c + i] * f[i]; }
                    lg[j] = d + F.rel_bias[rel_bucket(t - s) * 16 + hd] * 1.4426950408889634f; }
                mx = fmaxf(mx, lg[j]); }
            mx = wave_max(mx); float l = 0.f;
#pragma unroll
            for (int j = 0; j < 4; ++j) { const float p = __builtin_amdgcn_exp2f(lg[j] - mx); l += p; pl[j * 64 + F.lane] = p; }
            l = wave_sum(l); LDS_WAIT(); asm volatile("" ::: "memory");
            float o = 0.f;
            for (int i = 0; i < cnt; ++i) o += pl[i] * bf2f(F.V1[(size_t)(row - t + idx[i]) * 256 + g * 64 + F.lane]);
            F.ATT[(size_t)row * D + hd * 64 + F.lane] = (bf16)f2bf(o / l);
            LDS_WAIT(); asm volatile("" ::: "memory"); }
        __syncthreads();
    }
}
typedef float f32x16 __attribute__((ext_vector_type(16)));
typedef short s16x4 __attribute__((ext_vector_type(4)));
typedef float f32x2_t __attribute__((ext_vector_type(2))); typedef __bf16 bf16x2_t __attribute__((ext_vector_type(2)));
__device__ __forceinline__ unsigned cvtpk(float lo, float hi) { f32x2_t v = {lo, hi}; bf16x2_t b = __builtin_convertvector(v, bf16x2_t); return __builtin_bit_cast(unsigned, b); }
__device__ __forceinline__ s16x4 vtr(const LAS unsigned char* p) { return __builtin_bit_cast(s16x4, __builtin_amdgcn_ds_read_tr16_b64_v4i16((LAS s16x4*)p)); }
__device__ __forceinline__ void load_kfrags(bf16x8 (&kf)[2][4], const bf16* kb, size_t pitch) {
#pragma unroll
    for (int kh = 0; kh < 2; ++kh)
#pragma unroll
        for (int d0 = 0; d0 < 4; ++d0) kf[kh][d0] = *(const bf16x8*)(kb + (size_t)kh * 32 * pitch + d0 * 16);
}
__device__ __forceinline__ void load_vpieces(v4u (&vv)[8], const bf16* vbase, size_t pitch, int lane) {
#pragma unroll
    for (int p = 0; p < 8; ++p) vv[p] = *(const v4u*)(vbase + (size_t)(16 * (p & 3) + (lane >> 2)) * pitch + 32 * (p >> 2) + (lane & 3) * 8);
}
__device__ __forceinline__ void store_vpieces(LAS unsigned char* vl, const v4u (&vv)[8], int lane) {
#pragma unroll
    for (int p = 0; p < 8; ++p) *(LAS v4u*)(vl + p * 1024 + lane * 16) = vv[p];
}
__device__ __forceinline__ void pv_mma(f32x16& o0, f32x16& o1, const LAS unsigned char* vb, const f32x16& p0, const f32x16& p1) {
    bf16x8 pa[4];
#pragma unroll
    for (int ks = 0; ks < 4; ++ks) { const f32x16& P = (ks < 2) ? p0 : p1; const int b = (ks & 1) * 8; v4u w; w.x = cvtpk(P[b], P[b + 1]); w.y = cvtpk(P[b + 2], P[b + 3]); w.z = cvtpk(P[b + 4], P[b + 5]); w.w = cvtpk(P[b + 6], P[b + 7]); pa[ks] = __builtin_bit_cast(bf16x8, w); }
#pragma unroll
    for (int ks = 0; ks < 4; ++ks) {
        const s16x4 l0 = vtr(vb + ks * 1024), h0 = vtr(vb + ks * 1024 + 512), l1 = vtr(vb + 4096 + ks * 1024), h1 = vtr(vb + 4096 + ks * 1024 + 512);
        o0 = __builtin_amdgcn_mfma_f32_32x32x16_bf16(pa[ks], (bf16x8){l0[0], l0[1], l0[2], l0[3], h0[0], h0[1], h0[2], h0[3]}, o0, 0, 0, 0);
        o1 = __builtin_amdgcn_mfma_f32_32x32x16_bf16(pa[ks], (bf16x8){l1[0], l1[1], l1[2], l1[3], h1[0], h1[1], h1[2], h1[3]}, o1, 0, 0, 0); }
}
__device__ __forceinline__ void store_o_wt(LAS unsigned char* stg, const f32x16& o0, const f32x16& o1, const float (&sc)[16], const bf16* base, size_t elem0, size_t pitch, int lane) {
    const int r32 = lane & 31, hi = lane >> 5; LAS unsigned short* s16 = (LAS unsigned short*)stg;
#pragma unroll
    for (int r = 0; r < 16; ++r) { const int orow = (r & 3) + 8 * (r >> 2) + 4 * hi; s16[orow * 64 + r32] = (unsigned short)f2bf(o0[r] * sc[r]); s16[orow * 64 + 32 + r32] = (unsigned short)f2bf(o1[r] * sc[r]); }
    LDS_WAIT(); asm volatile("" ::: "memory");
#pragma unroll
    for (int i = 0; i < 4; ++i) { const int row = i * 8 + (lane >> 3), ch = lane & 7; const v4u v = *(const LAS v4u*)(stg + row * 128 + ch * 16); wt16(base, (elem0 + (size_t)row * pitch + ch * 8) * 2, v); }
    LDS_WAIT(); asm volatile("" ::: "memory");
}
__device__ __forceinline__ void store_o(LAS unsigned char* stg, const f32x16& o0, const f32x16& o1, const float (&sc)[16], bf16* dst, size_t pitch, int lane) {
    const int r32 = lane & 31, hi = lane >> 5; LAS unsigned short* s16 = (LAS unsigned short*)stg;
#pragma unroll
    for (int r = 0; r < 16; ++r) { const int orow = (r & 3) + 8 * (r >> 2) + 4 * hi; s16[orow * 64 + r32] = (unsigned short)f2bf(o0[r] * sc[r]); s16[orow * 64 + 32 + r32] = (unsigned short)f2bf(o1[r] * sc[r]); }
    LDS_WAIT(); asm volatile("" ::: "memory");
#pragma unroll
    for (int i = 0; i < 4; ++i) { const int row = i * 8 + (lane >> 3), ch = lane & 7; const v4u v = *(const LAS v4u*)(stg + row * 128 + ch * 16); *(v4u*)(dst + (size_t)row * pitch + ch * 8) = v; }
    LDS_WAIT(); asm volatile("" ::: "memory");
}
constexpr int MIX_WAVE_LDS = 12544;
__device__ __forceinline__ void sb_fast(Frame& F) {
    const int lane = F.lane, r32 = lane & 31, hi = lane >> 5;
    LAS unsigned char* vl = F.lds + RING_OFF + F.wave * MIX_WAVE_LDS; LAS unsigned char* stg = vl + 8192;
    const LAS unsigned char* vb = vl + ((lane >> 4) & 1) * 32 + (lane & 3) * 8 + (4 * hi + ((lane & 15) >> 2)) * 64;
    const int gw = F.vcu * NWAVES + F.wave, NGW = F.G * NWAVES;
    for (int u = gw; u < BATCH * 8 * 64; u += NGW) {
        const int qb = u & 63, h = (u >> 6) & 7, b = u >> 9, q0 = qb * 32; const size_t rowbase = (size_t)b * S;
        const bf16* Pq = F.PROJ0 + (rowbase + q0 + r32) * EVEN_IN + h * 64 + hi * 8;
        bf16x8 qr[4];
#pragma unroll
        for (int d0 = 0; d0 < 4; ++d0) qr[d0] = *(const bf16x8*)(Pq + d0 * 16);
        f32x16 o0 = {}, o1 = {}; float C = 1.f; const int ktmax = (q0 + 30) >> 6, qpos = q0 + r32;
        for (int kt = ktmax; kt >= 0; --kt) {
            bf16x8 kf[2][4]; v4u vv[8];
            load_kfrags(kf, F.PROJ0 + (rowbase + 64 * kt + r32) * EVEN_IN + 512 + h * 64 + hi * 8, EVEN_IN);
            load_vpieces(vv, F.PROJ0 + (rowbase + 64 * kt) * EVEN_IN + 1024 + h * 64, EVEN_IN, lane);
            f32x16 p0 = {}, p1 = {};
#pragma unroll
            for (int d0 = 0; d0 < 4; ++d0) { p0 = __builtin_amdgcn_mfma_f32_32x32x16_bf16(kf[0][d0], qr[d0], p0, 0, 0, 0); p1 = __builtin_amdgcn_mfma_f32_32x32x16_bf16(kf[1][d0], qr[d0], p1, 0, 0, 0); }
            store_vpieces(vl, vv, lane);
#pragma unroll
            for (int r = 0; r < 16; ++r) { p0[r] = __builtin_amdgcn_rcpf(1.0f + __builtin_amdgcn_exp2f(p0[r])); p1[r] = __builtin_amdgcn_rcpf(1.0f + __builtin_amdgcn_exp2f(p1[r])); }
            if (kt == ktmax) {
                const int kb = 64 * kt + 4 * hi;
#pragma unroll
                for (int r = 0; r < 16; ++r) { const int key = kb + (r & 3) + 8 * (r >> 2); if (key >= qpos) p0[r] = 1.0f; if (key + 32 >= qpos) p1[r] = 1.0f; }
            }
            float TL[8], TU[8];
#pragma unroll
            for (int blk = 0; blk < 8; ++blk) { const f32x16& P = (blk < 4) ? p0 : p1; const int c = (blk & 3) * 4; const float T = (P[c] * P[c + 1]) * (P[c + 2] * P[c + 3]);
                auto rr = __builtin_amdgcn_permlane32_swap(__float_as_uint(T), __float_as_uint(T), false, false); TL[blk] = __uint_as_float(rr[0]); TU[blk] = __uint_as_float(rr[1]); }
#pragma unroll
            for (int blk = 7; blk >= 0; --blk) { f32x16& P = (blk < 4) ? p0 : p1; const int c = (blk & 3) * 4;
                const float cu = C * TU[blk]; float s = hi ? C : cu; C = cu * TL[blk];
                const float a3 = P[c + 3], a2 = P[c + 2], a1 = P[c + 1], a0 = P[c];
                P[c + 3] = (1.0f - a3) * s; s *= a3; P[c + 2] = (1.0f - a2) * s; s *= a2; P[c + 1] = (1.0f - a1) * s; s *= a1; P[c] = (1.0f - a0) * s; }
            pv_mma(o0, o1, vb, p0, p1);
            if (__all(C < 7.8886091e-31f)) break;
        }
        float one[16];
#pragma unroll
        for (int r = 0; r < 16; ++r) one[r] = 1.0f;
        store_o(stg, o0, o1, one, F.ATT + (rowbase + q0) * D + h * 64, D, lane);
    }
}
__device__ __forceinline__ void sb_fast32(Frame& F) {
    const int lane = F.lane, r32 = lane & 31, hi = lane >> 5;
    LAS unsigned char* vl = F.lds + RING_OFF + F.wave * MIX_WAVE_LDS; LAS unsigned char* stg = vl + 8192;
    const LAS unsigned char* vb = vl + ((lane >> 4) & 1) * 32 + (lane & 3) * 8 + (4 * hi + ((lane & 15) >> 2)) * 64;
    const int gw = F.vcu * NWAVES + F.wave, NGW = F.G * NWAVES;
    for (int u = gw; u < BATCH * 8 * 64; u += NGW) {
        const int qb = u & 63, h = (u >> 6) & 7, b = u >> 9, q0 = qb * 32; const size_t rowbase = (size_t)b * S;
        const bf16* Pq = F.PROJ0 + (rowbase + q0 + r32) * EVEN_IN + h * 64 + hi * 8;
        bf16x8 qr[4];
#pragma unroll
        for (int d0 = 0; d0 < 4; ++d0) qr[d0] = *(const bf16x8*)(Pq + d0 * 16);
        f32x16 o0 = {}, o1 = {}; float C = 1.f; const int ktmax = (q0 + 30) >> 5, qpos = q0 + r32;
        for (int kt = ktmax; kt >= 0; --kt) {
            bf16x8 kf[4]; v4u vv[4];
            { const bf16* kb = F.PROJ0 + (rowbase + 32 * kt + r32) * EVEN_IN + 512 + h * 64 + hi * 8;
#pragma unroll
              for (int d0 = 0; d0 < 4; ++d0) kf[d0] = *(const bf16x8*)(kb + d0 * 16); }
            { const bf16* vbase = F.PROJ0 + (rowbase + 32 * kt) * EVEN_IN + 1024 + h * 64;
#pragma unroll
              for (int pp = 0; pp < 4; ++pp) vv[pp] = *(const v4u*)(vbase + (size_t)(16 * (pp & 1) + (lane >> 2)) * EVEN_IN + 32 * (pp >> 1) + (lane & 3) * 8); }
            f32x16 p0 = {};
#pragma unroll
            for (int d0 = 0; d0 < 4; ++d0) p0 = __builtin_amdgcn_mfma_f32_32x32x16_bf16(kf[d0], qr[d0], p0, 0, 0, 0);
#pragma unroll
            for (int pp = 0; pp < 4; ++pp) *(LAS v4u*)(vl + pp * 1024 + lane * 16) = vv[pp];
#pragma unroll
            for (int r = 0; r < 16; ++r) p0[r] = __builtin_amdgcn_rcpf(1.0f + __builtin_amdgcn_exp2f(p0[r]));
            if (kt == ktmax) {
                const int kb = 32 * kt + 4 * hi;
#pragma unroll
                for (int r = 0; r < 16; ++r) { const int key = kb + (r & 3) + 8 * (r >> 2); if (key >= qpos) p0[r] = 1.0f; }
            }
            float TL[4], TU[4];
#pragma unroll
            for (int blk = 0; blk < 4; ++blk) { const int c = blk * 4; const float T = (p0[c] * p0[c + 1]) * (p0[c + 2] * p0[c + 3]);
                auto rr = __builtin_amdgcn_permlane32_swap(__float_as_uint(T), __float_as_uint(T), false, false); TL[blk] = __uint_as_float(rr[0]); TU[blk] = __uint_as_float(rr[1]); }
#pragma unroll
            for (int blk = 3; blk >= 0; --blk) { const int c = blk * 4;
                const float cu = C * TU[blk]; float s = hi ? C : cu; C = cu * TL[blk];
                const float a3 = p0[c + 3], a2 = p0[c + 2], a1 = p0[c + 1], a0 = p0[c];
                p0[c + 3] = (1.0f - a3) * s; s *= a3; p0[c + 2] = (1.0f - a2) * s; s *= a2; p0[c + 1] = (1.0f - a1) * s; s *= a1; p0[c] = (1.0f - a0) * s; }
            bf16x8 pa[2];
#pragma unroll
            for (int ks = 0; ks < 2; ++ks) { const int bb = ks * 8; v4u w; w.x = cvtpk(p0[bb], p0[bb + 1]); w.y = cvtpk(p0[bb + 2], p0[bb + 3]); w.z = cvtpk(p0[bb + 4], p0[bb + 5]); w.w = cvtpk(p0[bb + 6], p0[bb + 7]); pa[ks] = __builtin_bit_cast(bf16x8, w); }
#pragma unroll
            for (int ks = 0; ks < 2; ++ks) {
                const s16x4 l0 = vtr(vb + ks * 1024), h0 = vtr(vb + ks * 1024 + 512), l1 = vtr(vb + 2048 + ks * 1024), h1 = vtr(vb + 2048 + ks * 1024 + 512);
                o0 = __builtin_amdgcn_mfma_f32_32x32x16_bf16(pa[ks], (bf16x8){l0[0], l0[1], l0[2], l0[3], h0[0], h0[1], h0[2], h0[3]}, o0, 0, 0, 0);
                o1 = __builtin_amdgcn_mfma_f32_32x32x16_bf16(pa[ks], (bf16x8){l1[0], l1[1], l1[2], l1[3], h1[0], h1[1], h1[2], h1[3]}, o1, 0, 0, 0); }
            if (__all(C < 7.8886091e-31f)) break;
        }
        float one[16];
#pragma unroll
        for (int r = 0; r < 16; ++r) one[r] = 1.0f;
        store_o_wt(stg, o0, o1, one, F.ATT, (rowbase + q0) * D + h * 64, D, lane);
    }
}
constexpr int SC_PITCH = 2052;
template <int PMODE> __device__ __forceinline__ void idx_fast(Frame& F, unsigned long long* MOUT) {
    const int lane = F.lane, c16 = lane & 15, kq = lane >> 4;
    LAS float* scb = (LAS float*)(F.lds + RING_OFF);
    const int cb = (int)blockIdx.x, s6 = cb & 63;
    const int pitA = 16 * (s6 + 1) + 4, pitB = 16 * (128 - s6) + 4;
    LAS float* scA = scb; LAS float* scB = scb + 16 * pitA;
    LAS unsigned* orA = (LAS unsigned*)(F.lds + RING_OFF + 133120); LAS unsigned* orB = orA + 1024;
    if (MASK_T) { for (int i = F.tid; i < 2048; i += NWAVES * 64) orA[i] = 0u; }
    LAS unsigned char* QS = F.lds + RING_OFF + 141312; LAS float* WS = (LAS float*)(QS + 16 * 1040);
    bf16x8 bq[8][2]; float w[8]; v4u qgA0 = {}, qgA1 = {}, qgB0 = {}, qgB1 = {}; float wgA = 0.f, wgB = 0.f;
#define IDX_QG(G0, G1, WG, QB, RB) do { const bf16* src_ = F.QI + ((RB) + (size_t)(QB) * 16) * 512; G0 = *(const v4u*)(src_ + (size_t)F.tid * 8); G1 = *(const v4u*)(src_ + (size_t)(F.tid + 512) * 8); \
        WG = (F.tid < 128) ? F.WI[((RB) + (size_t)(QB) * 16) * 8 + F.tid] * (0.125f * 0.35355339059327373f) : 0.f; } while (0)
#define IDX_QW(G0, G1, WG) do { const int c0_ = F.tid, c1_ = F.tid + 512; *(LAS v4u*)(QS + (c0_ >> 6) * 1040 + (c0_ & 63) * 16) = G0; *(LAS v4u*)(QS + (c1_ >> 6) * 1040 + (c1_ & 63) * 16) = G1; if (F.tid < 128) WS[F.tid] = WG; } while (0)
#define IDX_QR() do { _Pragma("unroll") for (int h = 0; h < 8; ++h) { bq[h][0] = *(const LAS bf16x8*)(QS + c16 * 1040 + h * 128 + kq * 16); bq[h][1] = *(const LAS bf16x8*)(QS + c16 * 1040 + h * 128 + kq * 16 + 64); } \
        { const f32x4 w0_ = *(const LAS f32x4*)(WS + c16 * 8), w1_ = *(const LAS f32x4*)(WS + c16 * 8 + 4); w[0] = w0_[0]; w[1] = w0_[1]; w[2] = w0_[2]; w[3] = w0_[3]; w[4] = w1_[0]; w[5] = w1_[1]; w[6] = w1_[2]; w[7] = w1_[3]; } } while (0)
#define IDX_SCORES(BQ, W, UN, RB) do { const int qb = (UN) ? 127 - s6 : s6; LAS float* sc = (UN) ? scB : scA; const int pit = (UN) ? pitB : pitA; \
        const int w0 = (UN) ? ((F.wave - (s6 + 1)) & 7) : F.wave;     \
        if (qb * 16 + 16 > TOPK && w0 <= qb) {                        \
            const bf16* kp0 = F.KI + ((RB) + c16) * 64 + 8 * kq; \
            bf16x8 na0 = *(const bf16x8*)(kp0 + (size_t)(16 * w0) * 64), na1 = *(const bf16x8*)(kp0 + (size_t)(16 * w0) * 64 + 32);         \
            for (int j = w0; j <= qb; j += NWAVES) { \
                const bf16x8 a0 = na0, a1 = na1; \
                { const int jn = (j + NWAVES <= qb) ? j + NWAVES : j; na0 = *(const bf16x8*)(kp0 + (size_t)(16 * jn) * 64); na1 = *(const bf16x8*)(kp0 + (size_t)(16 * jn) * 64 + 32); } \
                f32x4 s4 = {0.f, 0.f, 0.f, 0.f}, dd[8];                     \
                _Pragma("unroll") for (int h = 0; h < 8; ++h) { const f32x4 z = {0.f, 0.f, 0.f, 0.f}; dd[h] = __builtin_amdgcn_mfma_f32_16x16x32_bf16(a0, BQ[h][0], z, 0, 0, 0); } \
                _Pragma("unroll") for (int h = 0; h < 8; ++h) dd[h] = __builtin_amdgcn_mfma_f32_16x16x32_bf16(a1, BQ[h][1], dd[h], 0, 0, 0); \
                __builtin_amdgcn_sched_barrier(0); \
                _Pragma("unroll") for (int h = 0; h < 8; ++h) _Pragma("unroll") for (int i = 0; i < 4; ++i) s4[i] += W[h] * __builtin_amdgcn_fmed3f(dd[h][i], 0.f, __builtin_inff()); \
                *(LAS f32x4*)(sc + c16 * pit + 16 * j + 4 * kq) = s4; } } } while (0)
    if (PMODE != 2) { const size_t rb0_ = (size_t)(2 * ((cb >> 6) & 3)) * S; if (s6 >= 16) IDX_QG(qgA0, qgA1, wgA, s6, rb0_); IDX_QG(qgB0, qgB1, wgB, 127 - s6, rb0_); }
    for (int pi = 0; pi < 2; ++pi) {
        const int b = 2 * ((cb >> 6) & 3) + pi; const size_t rowbase = (size_t)b * S;
        if (PMODE != 2) {
            if (s6 >= 16) { IDX_QW(qgA0, qgA1, wgA); __syncthreads(); IDX_QR(); __syncthreads();
                IDX_SCORES(bq, w, 0, rowbase); }
            IDX_QW(qgB0, qgB1, wgB); __syncthreads(); IDX_QR();
            IDX_SCORES(bq, w, 1, rowbase);
            if (pi == 0) { if (s6 >= 16) IDX_QG(qgA0, qgA1, wgA, s6, rowbase + S); IDX_QG(qgB0, qgB1, wgB, 127 - s6, rowbase + S); }
        }
        __syncthreads();
        if (PMODE != 1) {
            { const int q0 = s6 * 16; topk_pair(scA + F.wave * pitA, q0 + F.wave + 1, MOUT + (rowbase + q0 + F.wave) * 32, scA + (F.wave + 8) * pitA, q0 + F.wave + 9, MOUT + (rowbase + q0 + F.wave + 8) * 32, lane, orA, F.wave); }
            { const int q0 = (127 - s6) * 16; topk_pair(scB + F.wave * pitB, q0 + F.wave + 1, MOUT + (rowbase + q0 + F.wave) * 32, scB + (F.wave + 8) * pitB, q0 + F.wave + 9, MOUT + (rowbase + q0 + F.wave + 8) * 32, lane, orB, F.wave); }
        }
        __syncthreads();
        if (MASK_T && PMODE != 1) {
#pragma unroll 1
            for (int un = 0; un < 2; ++un) { const int qb = un ? 127 - s6 : s6; LAS unsigned* ob = un ? orB : orA;
                const int ndw = 32 * (((16 * qb + 15) >> 6) + 1);
                const __amdgpu_buffer_rsrc_t rm_ = __builtin_amdgcn_make_buffer_rsrc((void*)MOUT, (short)0, 0x7ffffff0, 0x00020000); const int d0_ = (int)((((size_t)(b * 64 + (qb >> 1)) * 2048) * 2 + (qb & 1)) * 2);
                for (int dw = F.tid; dw < ndw; dw += NWAVES * 64) { const unsigned v = ob[dw]; ob[dw] = 0u; __builtin_amdgcn_raw_buffer_store_b16((unsigned short)v, rm_, d0_ + 8 * dw, 0, 16); __builtin_amdgcn_raw_buffer_store_b16((unsigned short)(v >> 16), rm_, d0_ + 8 * dw + 4, 0, 16); } }
        }
    }
#undef IDX_QG
#undef IDX_QW
#undef IDX_QR
#undef IDX_SCORES
}
__device__ __forceinline__ void dsa_fast(Frame& F) {
    const int lane = F.lane, r32 = lane & 31, hi = lane >> 5;
    LAS unsigned char* vl = F.lds + RING_OFF + F.wave * MIX_WAVE_LDS; LAS unsigned char* stg = vl + 8192; LAS float* wsf = (LAS float*)(vl + 12288);
    LAS float* tb = (LAS float*)(F.lds + RING_OFF + NWAVES * MIX_WAVE_LDS);
    const LAS unsigned char* vb = vl + ((lane >> 4) & 1) * 32 + (lane & 3) * 8 + (4 * hi + ((lane & 15) >> 2)) * 64;
    { float mq = fabsf(F.od_q_gain[lane]), mk = fabsf(F.od_k_gain[lane]), mb = 0.f;
#pragma unroll
      for (int i = 0; i < 8; ++i) mb = fmaxf(mb, fabsf(F.rel_bias[64 * i + lane]));
      mq = wave_max(mq); mk = wave_max(mk); mb = wave_max(mb);
      const float shift2 = (8.0f * mq * mk + mb) * 1.4426950408889634f;
      for (int i = F.tid; i < 2048; i += NWAVES * 64) tb[i] = F.rel_bias[rel_bucket(i & 127) * 16 + (i >> 7)] * 1.4426950408889634f - shift2; }
    __syncthreads();
    const int v = F.vcu, hd = 8 * (v & 1) + F.wave, g = hd >> 2, s4 = (v >> 1) & 15, b = v >> 5; const size_t rowbase = (size_t)b * S;
    const LAS float* tbh = tb + hd * 128; const float cfar = tbh[127];
    for (int ui = 0; ui < 4; ++ui) {
        const int qb = (ui == 0) ? s4 : (ui == 1) ? 31 - s4 : (ui == 2) ? 32 + s4 : 63 - s4, q0 = qb * 32, qpos = q0 + r32;
        const bf16* Pq = F.Q1 + (rowbase + q0 + r32) * 1024 + hd * 64 + hi * 8;
        bf16x8 qr[4];
#pragma unroll
        for (int d0 = 0; d0 < 4; ++d0) qr[d0] = *(const bf16x8*)(Pq + d0 * 16);
        f32x16 o0 = {}, o1 = {}; float l = 0.f; const int ktmax = (q0 + 31) >> 6;
        for (int kt = 0; kt <= ktmax; ++kt) {
            bf16x8 kf[2][4]; v4u vv[8];
            load_kfrags(kf, F.K1 + (rowbase + 64 * kt + r32) * 256 + g * 64 + hi * 8, 256);
            load_vpieces(vv, F.V1 + (rowbase + 64 * kt) * 256 + g * 64, 256, lane);
            const unsigned long long mw = F.MASK[(rowbase + qpos) * 32 + kt];
            const bool far = (q0 - (64 * kt + 63)) >= 113;
            f32x16 p0, p1;
#pragma unroll
            for (int r = 0; r < 16; ++r) { p0[r] = far ? cfar : 0.f; p1[r] = far ? cfar : 0.f; }
#pragma unroll
            for (int d0 = 0; d0 < 4; ++d0) { p0 = __builtin_amdgcn_mfma_f32_32x32x16_bf16(kf[0][d0], qr[d0], p0, 0, 0, 0); p1 = __builtin_amdgcn_mfma_f32_32x32x16_bf16(kf[1][d0], qr[d0], p1, 0, 0, 0); }
            store_vpieces(vl, vv, lane);
            if (!far) {
                const int d00 = qpos - 64 * kt - 4 * hi;
#pragma unroll
                for (int r = 0; r < 16; ++r) { const int d = d00 - ((r & 3) + 8 * (r >> 2)); p0[r] += tbh[min(max(d, 0), 127)]; p1[r] += tbh[min(max(d - 32, 0), 127)]; }
            }
            const unsigned m0 = (unsigned)mw >> (4 * hi), m1 = (unsigned)(mw >> 32) >> (4 * hi);
#pragma unroll
            for (int r = 0; r < 16; ++r) { const int bit = (r & 3) + 8 * (r >> 2);
                const float e0 = ((m0 >> bit) & 1u) ? __builtin_amdgcn_exp2f(p0[r]) : 0.f, e1 = ((m1 >> bit) & 1u) ? __builtin_amdgcn_exp2f(p1[r]) : 0.f;
                l += e0 + e1; p0[r] = e0; p1[r] = e1; }
            pv_mma(o0, o1, vb, p0, p1);
        }
        { auto rr = __builtin_amdgcn_permlane32_swap(__float_as_uint(l), __float_as_uint(l), false, false); l = __uint_as_float(rr[0]) + __uint_as_float(rr[1]); }
        if (hi == 0) wsf[r32] = l;
        LDS_WAIT(); asm volatile("" ::: "memory");
        float rl[16];
#pragma unroll
        for (int r = 0; r < 16; ++r) rl[r] = __builtin_amdgcn_rcpf(wsf[(r & 3) + 8 * (r >> 2) + 4 * hi]);
        store_o(stg, o0, o1, rl, F.ATT + (rowbase + q0) * D + hd * 64, D, lane);
    }
}
__device__ __forceinline__ void glds16(const void* gsrc, unsigned lds_dst) { unsigned keep;
    asm volatile("s_mov_b32 %0, m0\n\ts_mov_b32 m0, %2\n\ts_nop 0\n\tglobal_load_lds_dwordx4 %1, off\n\ts_mov_b32 m0, %0" : "=&s"(keep) : "v"(gsrc), "s"(lds_dst) : "memory"); }
#define WAIT_BAR(N) asm volatile("s_waitcnt vmcnt(" #N ") lgkmcnt(0)\n\ts_barrier" ::: "memory")
typedef unsigned u32x16 __attribute__((ext_vector_type(16)));
#define CAS __attribute__((address_space(4)))
__device__ __forceinline__ void dsa_coop(Frame& F) {
    const int lane = F.lane, r32 = lane & 31, hi = lane >> 5, wave = F.wave;
    const unsigned* MT = (const unsigned*)F.MASK; u32x16 mk0 = {}, mk1 = {}, mk2 = {}, mk3 = {};
    LAS unsigned char* L = F.lds + RING_OFF;
    LAS unsigned char* stg = L + 32768 + wave * 4096; LAS float* wsf = (LAS float*)(L + 65536 + wave * 256); LAS float* tb = (LAS float*)(L + 69632); LAS unsigned long long* ml = (LAS unsigned long long*)(L + 77824 + wave * 8192);
    const unsigned l0 = (unsigned)(uintptr_t)L;
    for (int i = F.tid; i < 2048; i += NWAVES * 64) tb[i] = (F.rel_bias[rel_bucket(i & 127) * 16 + (i >> 7)] - F.rel_bias[31 * 16 + (i >> 7)]) * 1.4426950408889634f;
    __syncthreads();
    const int v = F.vcu, bg = v >> 3, b = bg >> 2, g = bg & 3, s3 = v & 7, hd = 4 * g + (wave & 3), qh = wave >> 2; const size_t rowbase = (size_t)b * S;
    const LAS float* tbh = tb + hd * 128;
    const bf16x8 ones8 = {0x3F80, 0x3F80, 0x3F80, 0x3F80, 0x3F80, 0x3F80, 0x3F80, 0x3F80};
    const bf16* ksrc = F.K1 + (rowbase + lane) * 256 + g * 64 + wave * 8;
    const bf16* vsrc = F.V1 + (rowbase + 16 * (wave & 3) + (lane >> 2)) * 256 + g * 64 + (wave >> 2) * 32 + (lane & 3) * 8;
    const unsigned kdst = (unsigned)__builtin_amdgcn_readfirstlane(l0 + wave * 1024), vdst = kdst + 16384;
    const LAS unsigned char* kp = L + hi * 1024 + r32 * 16;
    const LAS unsigned char* vb = L + 16384 + ((lane >> 4) & 1) * 32 + (lane & 3) * 8 + (4 * hi + ((lane & 15) >> 2)) * 64;
    bf16x8 qrn[4]; v4u mreg[8];
#define DSA_MLOAD(QB, KT) do { const CAS u32x16* mp_ = (const CAS u32x16*)(unsigned long long)(MT + ((size_t)(b * 64 + 2 * (QB) + qh) * 2048 + 64 * (KT))); mk0 = mp_[0]; mk1 = mp_[1]; mk2 = mp_[2]; mk3 = mp_[3]; } while (0)
#define DSA_MPAIR(V, IX) (((unsigned long long)(V)[(IX) + 1] << 32) | (V)[(IX)])
#define DSA_PREFETCH(UI) do { const int qb_ = ((UI) == 0) ? s3 : ((UI) == 1) ? 15 - s3 : ((UI) == 2) ? 16 + s3 : 31 - s3; const int qpos_ = qb_ * 64 + qh * 32 + r32; \
        glds16(ksrc, kdst); glds16(vsrc, vdst); \
        const bf16* Pq_ = F.Q1 + (rowbase + qpos_) * 1024 + hd * 64 + hi * 8; _Pragma("unroll") for (int d0 = 0; d0 < 4; ++d0) qrn[d0] = *(const bf16x8*)(Pq_ + d0 * 16); \
        if (MASK_T) DSA_MLOAD(qb_, 0); else { const v4u* mrow_ = (const v4u*)(F.MASK + (rowbase + qpos_) * 32 + 16 * hi); _Pragma("unroll") for (int i = 0; i < 8; ++i) mreg[i] = mrow_[i]; } } while (0)
    DSA_PREFETCH(0);
    for (int ui = 0; ui < 4; ++ui) {
        const int qb = (ui == 0) ? s3 : (ui == 1) ? 15 - s3 : (ui == 2) ? 16 + s3 : 31 - s3, q0 = qb * 64 + qh * 32, qpos = q0 + r32, nt = qb + 1;
        bf16x8 qr[4];
#pragma unroll
        for (int d0 = 0; d0 < 4; ++d0) qr[d0] = qrn[d0];
#pragma unroll
        for (int i = 0; i < 8; ++i) { if (MASK_T) break; const v4u w = mreg[i]; ml[(16 * hi + 2 * i) * 32 + r32] = ((unsigned long long)w.y << 32) | w.x; ml[(16 * hi + 2 * i + 1) * 32 + r32] = ((unsigned long long)w.w << 32) | w.z; }
        f32x16 o0 = {}, o1 = {}, o2 = {};
        WAIT_BAR(4);
        for (int kt = 0; kt < nt; ++kt) {
            const int cur = (kt & 1) * 8192; const unsigned long long mw = MASK_T ? 0ull : ml[kt * 32 + r32];
            if (kt + 1 < nt) { glds16(ksrc + (size_t)(kt + 1) * 64 * 256, kdst + (8192 - cur)); glds16(vsrc + (size_t)(kt + 1) * 64 * 256, vdst + (8192 - cur)); }
            const bool far = (q0 - (64 * kt + 63)) >= 113;
            const f32x16 z16 = {};
            f32x16 p0, p1;
#pragma unroll
            for (int d0 = 0; d0 < 4; ++d0) { const bf16x8 k0 = *(const LAS bf16x8*)(kp + cur + d0 * 2048), k1 = *(const LAS bf16x8*)(kp + cur + d0 * 2048 + 512);
                p0 = __builtin_amdgcn_mfma_f32_32x32x16_bf16(k0, qr[d0], d0 ? p0 : z16, 0, 0, 0); p1 = __builtin_amdgcn_mfma_f32_32x32x16_bf16(k1, qr[d0], d0 ? p1 : z16, 0, 0, 0); }
            if (!far) {
                const int d00 = qpos - 64 * kt - 4 * hi;
#pragma unroll
                for (int r = 0; r < 16; ++r) { const int d = d00 - ((r & 3) + 8 * (r >> 2)); p0[r] += tbh[min(max(d, 0), 127)]; p1[r] += tbh[min(max(d - 32, 0), 127)]; }
            }
            const unsigned m0 = (unsigned)mw >> (4 * hi), m1 = (unsigned)(mw >> 32) >> (4 * hi);
            bf16x8 pa[4];
            if (MASK_T) {
#pragma unroll
                for (int r = 0; r < 16; ++r) { const int ix = ((r >> 2) & 1) * 8 + 2 * (r & 3);
                    const unsigned long long ma = (r >> 3) ? DSA_MPAIR(mk1, ix) : DSA_MPAIR(mk0, ix), mb = (r >> 3) ? DSA_MPAIR(mk3, ix) : DSA_MPAIR(mk2, ix);
                    p0[r] = __builtin_amdgcn_inverse_ballot_w64(ma) ? p0[r] : -1e30f; p1[r] = __builtin_amdgcn_inverse_ballot_w64(mb) ? p1[r] : -1e30f; }
                DSA_MLOAD(qb, (kt + 1 < nt) ? kt + 1 : kt);
            }
#pragma unroll
            for (int ks = 0; ks < 4; ++ks) { const f32x16& P = (ks < 2) ? p0 : p1; const unsigned mm = (ks < 2) ? m0 : m1; const int bb = (ks & 1) * 8; v4u wv;
#pragma unroll
                for (int j = 0; j < 4; ++j) { const int r = bb + 2 * j, bit = (r & 3) + 8 * (r >> 2); unsigned n0, n1, m2;
                    if (MASK_T) { wv[j] = cvtpk(__builtin_amdgcn_exp2f(P[r]), __builtin_amdgcn_exp2f(P[r + 1])); continue; }
                    asm("v_bfe_i32 %0, %1, %2, 1" : "=v"(n0) : "v"(mm), "n"(bit)); asm("v_bfe_i32 %0, %1, %2, 1" : "=v"(n1) : "v"(mm), "n"(bit + 1));
                    asm("v_bfi_b32 %0, %1, %2, %3" : "=v"(m2) : "v"(0xffffu), "v"(n0), "v"(n1));
                    wv[j] = cvtpk(__builtin_amdgcn_exp2f(P[r]), __builtin_amdgcn_exp2f(P[r + 1])) & m2; }
                pa[ks] = __builtin_bit_cast(bf16x8, wv); }
            { const LAS unsigned char* vq = vb + cur;
#pragma unroll
              for (int ks = 0; ks < 4; ++ks) {
                const s16x4 l0 = vtr(vq + ks * 1024), h0 = vtr(vq + ks * 1024 + 512), l1 = vtr(vq + 4096 + ks * 1024), h1 = vtr(vq + 4096 + ks * 1024 + 512);
                o0 = __builtin_amdgcn_mfma_f32_32x32x16_bf16(pa[ks], (bf16x8){l0[0], l0[1], l0[2], l0[3], h0[0], h0[1], h0[2], h0[3]}, o0, 0, 0, 0);
                o1 = __builtin_amdgcn_mfma_f32_32x32x16_bf16(pa[ks], (bf16x8){l1[0], l1[1], l1[2], l1[3], h1[0], h1[1], h1[2], h1[3]}, o1, 0, 0, 0);
                o2 = __builtin_amdgcn_mfma_f32_32x32x16_bf16(pa[ks], ones8, o2, 0, 0, 0); } }
            WAIT_BAR(0);
        }
        if (ui == 0) DSA_PREFETCH(1); else if (ui == 1) DSA_PREFETCH(2); else if (ui == 2) DSA_PREFETCH(3);
        float rl[16];
#pragma unroll
        for (int r = 0; r < 16; ++r) rl[r] = __builtin_amdgcn_rcpf(o2[r]);
        store_o(stg, o0, o1, rl, F.ATT + (rowbase + q0) * D + hd * 64, D, lane);
    }
#undef DSA_PREFETCH
#undef DSA_MLOAD
#undef DSA_MPAIR
}
__device__ __forceinline__ void dsa_coop_t(Frame& F) {
    const int lane = F.lane, r32 = lane & 31, hi = lane >> 5, wave = F.wave;
    LAS unsigned char* L = F.lds + RING_OFF;
    LAS unsigned char* stg = L + 32768 + wave * 4096; LAS float* tb = (LAS float*)(L + 69632);
    const unsigned l0 = (unsigned)(uintptr_t)L;
    for (int i = F.tid; i < 2048; i += NWAVES * 64) tb[i] = (F.rel_bias[rel_bucket(i & 127) * 16 + (i >> 7)] - F.rel_bias[31 * 16 + (i >> 7)]) * 1.4426950408889634f;
    __syncthreads();
    const int v = F.vcu, bg = v >> 3, b = bg >> 2, g = bg & 3, s3 = v & 7, hd = 4 * g + (wave & 3), qh = wave >> 2; const size_t rowbase = (size_t)b * S;
    const LAS float* tbh = tb + hd * 128;
    const bf16x8 ones8 = {0x3F80, 0x3F80, 0x3F80, 0x3F80, 0x3F80, 0x3F80, 0x3F80, 0x3F80};
    const bf16* ksrc = F.K1 + (rowbase + lane) * 256 + g * 64 + wave * 8;
    const bf16* vsrc = F.V1 + (rowbase + 16 * (wave & 3) + (lane >> 2)) * 256 + g * 64 + (wave >> 2) * 32 + (lane & 3) * 8;
    const unsigned kdst = (unsigned)__builtin_amdgcn_readfirstlane(l0 + wave * 1024), vdst = kdst + 16384;
    const LAS unsigned char* kp = L + hi * 1024 + r32 * 16;
    const LAS unsigned char* vb = L + 16384 + ((lane >> 4) & 1) * 32 + (lane & 3) * 8 + (4 * hi + ((lane & 15) >> 2)) * 64;
    const unsigned* MT = (const unsigned*)F.MASK; u32x16 mk0 = {}, mk1 = {}, mk2 = {}, mk3 = {};
    bf16x8 qrn[4];
#define DSA_MLOAD(QB, KT) do { const CAS u32x16* mp_ = (const CAS u32x16*)(unsigned long long)(MT + ((size_t)(b * 64 + 2 * (QB) + qh) * 2048 + 64 * (KT))); mk0 = mp_[0]; mk1 = mp_[1]; mk2 = mp_[2]; mk3 = mp_[3]; } while (0)
#define DSA_MPAIR(V, IX) (((unsigned long long)(V)[(IX) + 1] << 32) | (V)[(IX)])
#define DSA_PREFETCH(UI) do { const int qb_ = ((UI) == 0) ? s3 : ((UI) == 1) ? 15 - s3 : ((UI) == 2) ? 16 + s3 : 31 - s3; const int qpos_ = qb_ * 64 + qh * 32 + r32; \
        glds16(ksrc, kdst); glds16(vsrc, vdst); \
        const bf16* Pq_ = F.Q1 + (rowbase + qpos_) * 1024 + hd * 64 + hi * 8; _Pragma("unroll") for (int d0 = 0; d0 < 4; ++d0) qrn[d0] = *(const bf16x8*)(Pq_ + d0 * 16); \
        DSA_MLOAD(qb_, 0); } while (0)
    DSA_PREFETCH(0);
    for (int ui = 0; ui < 4; ++ui) {
        const int qb = (ui == 0) ? s3 : (ui == 1) ? 15 - s3 : (ui == 2) ? 16 + s3 : 31 - s3, q0 = qb * 64 + qh * 32, qpos = q0 + r32, nt = qb + 1;
        bf16x8 qr[4];
#pragma unroll
        for (int d0 = 0; d0 < 4; ++d0) qr[d0] = qrn[d0];
        f32x16 o0 = {}, o1 = {}, o2 = {};
        WAIT_BAR(4);
        asm volatile("" : "+v"(qr[0]), "+v"(qr[1]), "+v"(qr[2]), "+v"(qr[3]));
        for (int kt = 0; kt < nt; ++kt) {
            const int cur = (kt & 1) * 8192;
            if (kt + 1 < nt) { glds16(ksrc + (size_t)(kt + 1) * 64 * 256, kdst + (8192 - cur)); glds16(vsrc + (size_t)(kt + 1) * 64 * 256, vdst + (8192 - cur)); }
            const bool far = (q0 - (64 * kt + 63)) >= 113;
            const f32x16 z16 = {};
            f32x16 p0, p1;
#pragma unroll
            for (int d0 = 0; d0 < 4; ++d0) { const bf16x8 k0 = *(const LAS bf16x8*)(kp + cur + d0 * 2048), k1 = *(const LAS bf16x8*)(kp + cur + d0 * 2048 + 512);
                p0 = __builtin_amdgcn_mfma_f32_32x32x16_bf16(k0, qr[d0], d0 ? p0 : z16, 0, 0, 0); p1 = __builtin_amdgcn_mfma_f32_32x32x16_bf16(k1, qr[d0], d0 ? p1 : z16, 0, 0, 0); }
            s16x4 vf[16];
            { const LAS unsigned char* vq = vb + cur;
#pragma unroll
              for (int ks = 0; ks < 4; ++ks) { vf[4 * ks] = vtr(vq + ks * 1024); vf[4 * ks + 1] = vtr(vq + ks * 1024 + 512); vf[4 * ks + 2] = vtr(vq + 4096 + ks * 1024); vf[4 * ks + 3] = vtr(vq + 4096 + ks * 1024 + 512); } }
            if (!far) {
                const int d00 = qpos - 64 * kt - 4 * hi;
#pragma unroll
                for (int r = 0; r < 16; ++r) { const int d = d00 - ((r & 3) + 8 * (r >> 2)); p0[r] += tbh[min(max(d, 0), 127)]; p1[r] += tbh[min(max(d - 32, 0), 127)]; }
            }
            asm volatile("" : "+v"(vf[0]), "+v"(vf[1]), "+v"(vf[2]), "+v"(vf[3]), "+v"(vf[4]), "+v"(vf[5]), "+v"(vf[6]), "+v"(vf[7]), "+v"(vf[8]), "+v"(vf[9]), "+v"(vf[10]), "+v"(vf[11]), "+v"(vf[12]), "+v"(vf[13]), "+v"(vf[14]), "+v"(vf[15]));
#pragma unroll
            for (int r = 0; r < 16; ++r) { const int ix = ((r >> 2) & 1) * 8 + 2 * (r & 3);
                const unsigned long long ma = (r >> 3) ? DSA_MPAIR(mk1, ix) : DSA_MPAIR(mk0, ix), mb = (r >> 3) ? DSA_MPAIR(mk3, ix) : DSA_MPAIR(mk2, ix);
                p0[r] = __builtin_amdgcn_inverse_ballot_w64(ma) ? p0[r] : -1e30f; p1[r] = __builtin_amdgcn_inverse_ballot_w64(mb) ? p1[r] : -1e30f; }
            __builtin_amdgcn_sched_barrier(0);
            DSA_MLOAD(qb, (kt + 1 < nt) ? kt + 1 : kt);
            __builtin_amdgcn_sched_barrier(0);
            bf16x8 pa[4];
#pragma unroll
            for (int ks = 0; ks < 4; ++ks) { const f32x16& P = (ks < 2) ? p0 : p1; const int bb = (ks & 1) * 8; v4u wv;
#pragma unroll
                for (int j = 0; j < 4; ++j) { const int r = bb + 2 * j; wv[j] = cvtpk(__builtin_amdgcn_exp2f(P[r]), __builtin_amdgcn_exp2f(P[r + 1])); }
                pa[ks] = __builtin_bit_cast(bf16x8, wv); }
#pragma unroll
            for (int ks = 0; ks < 4; ++ks) { const s16x4 l0 = vf[4 * ks], h0 = vf[4 * ks + 1], l1 = vf[4 * ks + 2], h1 = vf[4 * ks + 3];
                o0 = __builtin_amdgcn_mfma_f32_32x32x16_bf16(pa[ks], (bf16x8){l0[0], l0[1], l0[2], l0[3], h0[0], h0[1], h0[2], h0[3]}, o0, 0, 0, 0);
                o1 = __builtin_amdgcn_mfma_f32_32x32x16_bf16(pa[ks], (bf16x8){l1[0], l1[1], l1[2], l1[3], h1[0], h1[1], h1[2], h1[3]}, o1, 0, 0, 0);
                o2 = __builtin_amdgcn_mfma_f32_32x32x16_bf16(pa[ks], ones8, o2, 0, 0, 0); }
            asm volatile("s_waitcnt vmcnt(0)\n\ts_barrier" ::: "memory");
        }
        if (ui == 0) DSA_PREFETCH(1); else if (ui == 1) DSA_PREFETCH(2); else if (ui == 2) DSA_PREFETCH(3);
        float rl[16];
#pragma unroll
        for (int r = 0; r < 16; ++r) rl[r] = __builtin_amdgcn_rcpf(o2[r]);
        store_o(stg, o0, o1, rl, F.ATT + (rowbase + q0) * D + hd * 64, D, lane);
    }
#undef DSA_PREFETCH
#undef DSA_MLOAD
#undef DSA_MPAIR
}
__device__ __forceinline__ void dsa_coop_w(Frame& F) {
    const int lane = F.lane, r32 = lane & 31, hi = lane >> 5, wave = F.wave;
    LAS unsigned char* L = F.lds + RING_OFF;
    LAS unsigned char* stg = L + 32768 + wave * 4096; LAS float* tb = (LAS float*)(L + 69632);
    const unsigned l0 = (unsigned)(uintptr_t)L;
    for (int i = F.tid; i < 2048; i += NWAVES * 64) tb[i] = (F.rel_bias[rel_bucket(i & 127) * 16 + (i >> 7)] - F.rel_bias[31 * 16 + (i >> 7)]) * 1.4426950408889634f;
    __syncthreads();
    const int v = F.vcu, bg = v >> 3, b = bg >> 2, g = bg & 3, s3 = v & 7, hd = 4 * g + (wave & 3), qh = wave >> 2; const size_t rowbase = (size_t)b * S;
    const LAS float* tbh = tb + hd * 128;
    const bf16x8 ones8 = {0x3F80, 0x3F80, 0x3F80, 0x3F80, 0x3F80, 0x3F80, 0x3F80, 0x3F80};
    const int j4 = wave & 3;
    const bf16* dsrc = (wave < 4) ? F.K1 + (rowbase + (lane & 31)) * 256 + g * 64 + (2 * j4 + (lane >> 5)) * 8
                                  : F.V1 + (rowbase + 16 * (j4 & 1) + (lane >> 2)) * 256 + g * 64 + (j4 >> 1) * 32 + (lane & 3) * 8;
    const unsigned ddst = (unsigned)__builtin_amdgcn_readfirstlane(l0 + (wave < 4 ? 0 : 8192) + j4 * 1024);
    const LAS unsigned char* kp = L + hi * 512 + r32 * 16;
    const LAS unsigned char* vb = L + 8192 + ((lane >> 4) & 1) * 32 + (lane & 3) * 8 + (4 * hi + ((lane & 15) >> 2)) * 64;
    const unsigned* MT = (const unsigned*)F.MASK; u32x16 mk0 = {}, mk1 = {}, mk2 = {}, mk3 = {};
    bf16x8 qr[2][4];
#define DSA_MLOAD(RB32, KT) do { const CAS u32x16* mp_ = (const CAS u32x16*)(unsigned long long)(MT + ((size_t)(b * 64 + (RB32)) * 2048 + 32 * (KT))); mk0 = mp_[0]; mk1 = mp_[1]; mk2 = mp_[128]; mk3 = mp_[129]; } while (0)
#define DSA_MPAIR(V, IX) (((unsigned long long)(V)[(IX) + 1] << 32) | (V)[(IX)])
#define DSA_PREFETCH(U) do { const int rb_ = 4 * (U) + 2 * qh; glds16(dsrc, ddst); \
        _Pragma("unroll") for (int rb = 0; rb < 2; ++rb) { const bf16* Pq_ = F.Q1 + (rowbase + 32 * (rb_ + rb) + r32) * 1024 + hd * 64 + hi * 8; _Pragma("unroll") for (int d0 = 0; d0 < 4; ++d0) qr[rb][d0] = *(const bf16x8*)(Pq_ + d0 * 16); } \
        DSA_MLOAD(rb_, 0); } while (0)
    DSA_PREFETCH(s3);
#pragma unroll 1
    for (int ui = 0; ui < 2; ++ui) {
        const int u = ui ? 15 - s3 : s3, rb0 = 4 * u + 2 * qh, q0 = 32 * rb0, nt = 4 * (u + 1), ntw = 4 * u + 2 * qh + 2;
        f32x16 o0[2] = {}, o1[2] = {}, o2[2] = {};
        WAIT_BAR(8);
        asm volatile("" : "+v"(qr[0][0]), "+v"(qr[0][1]), "+v"(qr[0][2]), "+v"(qr[0][3]), "+v"(qr[1][0]), "+v"(qr[1][1]), "+v"(qr[1][2]), "+v"(qr[1][3]));
        for (int kt = 0; kt < nt; ++kt) {
            const int cur = (kt & 1) * 4096;
            if (kt + 1 < nt) glds16(dsrc + (size_t)(kt + 1) * 32 * 256, ddst + (4096 - cur));
            if (kt < ntw) {
                const bool far = (q0 - (32 * kt + 31)) >= 113;
                bf16x8 kf[4]; s16x4 vf[8];
#pragma unroll
                for (int d0 = 0; d0 < 4; ++d0) kf[d0] = *(const LAS bf16x8*)(kp + cur + d0 * 1024);
                { const LAS unsigned char* vq = vb + cur;
#pragma unroll
                  for (int ks = 0; ks < 2; ++ks) { vf[4 * ks] = vtr(vq + ks * 1024); vf[4 * ks + 1] = vtr(vq + ks * 1024 + 512); vf[4 * ks + 2] = vtr(vq + 2048 + ks * 1024); vf[4 * ks + 3] = vtr(vq + 2048 + ks * 1024 + 512); } }
                f32x16 p[2]; const f32x16 z16 = {};
#pragma unroll
                for (int d0 = 0; d0 < 4; ++d0) { p[0] = __builtin_amdgcn_mfma_f32_32x32x16_bf16(kf[d0], qr[0][d0], d0 ? p[0] : z16, 0, 0, 0); p[1] = __builtin_amdgcn_mfma_f32_32x32x16_bf16(kf[d0], qr[1][d0], d0 ? p[1] : z16, 0, 0, 0); }
                if (!far) {
#pragma unroll
                    for (int rb = 0; rb < 2; ++rb) { const int d00 = q0 + 32 * rb + r32 - 32 * kt - 4 * hi;
#pragma unroll
                        for (int r = 0; r < 16; ++r) { const int d = d00 - ((r & 3) + 8 * (r >> 2)); p[rb][r] += tbh[min(max(d, 0), 127)]; } }
                }
                asm volatile("" : "+v"(vf[0]), "+v"(vf[1]), "+v"(vf[2]), "+v"(vf[3]), "+v"(vf[4]), "+v"(vf[5]), "+v"(vf[6]), "+v"(vf[7]));
#pragma unroll
                for (int r = 0; r < 16; ++r) { const int ix = ((r >> 2) & 1) * 8 + 2 * (r & 3);
                    const unsigned long long ma = (r >> 3) ? DSA_MPAIR(mk1, ix) : DSA_MPAIR(mk0, ix), mb = (r >> 3) ? DSA_MPAIR(mk3, ix) : DSA_MPAIR(mk2, ix);
                    p[0][r] = __builtin_amdgcn_inverse_ballot_w64(ma) ? p[0][r] : -1e30f; p[1][r] = __builtin_amdgcn_inverse_ballot_w64(mb) ? p[1][r] : -1e30f; }
                __builtin_amdgcn_sched_barrier(0);
                DSA_MLOAD(rb0, (kt + 1 < ntw) ? kt + 1 : kt);
                __builtin_amdgcn_sched_barrier(0);
                bf16x8 pa[2][2];
#pragma unroll
                for (int rb = 0; rb < 2; ++rb)
#pragma unroll
                    for (int ks = 0; ks < 2; ++ks) { const int bb = ks * 8; v4u wv;
#pragma unroll
                        for (int j = 0; j < 4; ++j) { const int r = bb + 2 * j; wv[j] = cvtpk(__builtin_amdgcn_exp2f(p[rb][r]), __builtin_amdgcn_exp2f(p[rb][r + 1])); }
                        pa[rb][ks] = __builtin_bit_cast(bf16x8, wv); }
#pragma unroll
                for (int ks = 0; ks < 2; ++ks) { const s16x4 l0 = vf[4 * ks], h0 = vf[4 * ks + 1], l1 = vf[4 * ks + 2], h1 = vf[4 * ks + 3];
                    const bf16x8 va = {l0[0], l0[1], l0[2], l0[3], h0[0], h0[1], h0[2], h0[3]}, vc = {l1[0], l1[1], l1[2], l1[3], h1[0], h1[1], h1[2], h1[3]};
#pragma unroll
                    for (int rb = 0; rb < 2; ++rb) {
                        o0[rb] = __builtin_amdgcn_mfma_f32_32x32x16_bf16(pa[rb][ks], va, o0[rb], 0, 0, 0);
                        o1[rb] = __builtin_amdgcn_mfma_f32_32x32x16_bf16(pa[rb][ks], vc, o1[rb], 0, 0, 0);
                        o2[rb] = __builtin_amdgcn_mfma_f32_32x32x16_bf16(pa[rb][ks], ones8, o2[rb], 0, 0, 0); } }
            }
            asm volatile("s_waitcnt vmcnt(0)\n\ts_barrier" ::: "memory");
        }
        if (ui == 0) DSA_PREFETCH(15 - s3);
#pragma unroll
        for (int rb = 0; rb < 2; ++rb) { float rl[16];
#pragma unroll
            for (int r = 0; r < 16; ++r) rl[r] = __builtin_amdgcn_rcpf(o2[rb][r]);
            store_o_wt(stg, o0[rb], o1[rb], rl, F.ATT, (rowbase + q0 + 32 * rb) * D + hd * 64, D, lane); }
    }
#undef DSA_PREFETCH
#undef DSA_MLOAD
#undef DSA_MPAIR
}
__device__ __forceinline__ void dsa_pipe(Frame& F) {
    const int lane = F.lane, r32 = lane & 31, hi = lane >> 5, wave = F.wave;
    LAS unsigned char* L = F.lds + RING_OFF;
    LAS unsigned char* stg = L + 32768 + wave * 4096; LAS float* wsf = (LAS float*)(L + 65536 + wave * 256); LAS float* tb = (LAS float*)(L + 69632); LAS unsigned long long* ml = (LAS unsigned long long*)(L + 77824 + wave * 8192);
    const unsigned l0 = (unsigned)(uintptr_t)L;
    { float mq = fabsf(F.od_q_gain[lane]), mk = fabsf(F.od_k_gain[lane]), mb = 0.f;
#pragma unroll
      for (int i = 0; i < 8; ++i) mb = fmaxf(mb, fabsf(F.rel_bias[64 * i + lane]));
      mq = wave_max(mq); mk = wave_max(mk); mb = wave_max(mb);
      const float shift2 = (8.0f * mq * mk + mb) * 1.4426950408889634f;
      for (int i = F.tid; i < 2048; i += NWAVES * 64) tb[i] = F.rel_bias[rel_bucket(i & 127) * 16 + (i >> 7)] * 1.4426950408889634f - shift2; }
    __syncthreads();
    const int v = F.vcu, bg = v >> 3, b = bg >> 2, g = bg & 3, s3 = v & 7, hd = 4 * g + (wave & 3), qh = wave >> 2; const size_t rowbase = (size_t)b * S;
    const LAS float* tbh = tb + hd * 128; const float cfar = tbh[127];
    const bf16* ksrc = F.K1 + (rowbase + lane) * 256 + g * 64 + wave * 8;
    const bf16* vsrc = F.V1 + (rowbase + 16 * (wave & 3) + (lane >> 2)) * 256 + g * 64 + (wave >> 2) * 32 + (lane & 3) * 8;
    const unsigned kdst = (unsigned)__builtin_amdgcn_readfirstlane(l0 + wave * 1024), vdst = kdst + 16384;
    const LAS unsigned char* kp = L + hi * 1024 + r32 * 16;
    const LAS unsigned char* vb = L + 16384 + ((lane >> 4) & 1) * 32 + (lane & 3) * 8 + (4 * hi + ((lane & 15) >> 2)) * 64;
#define DSA_QK(N0, N1, KOFF) do { _Pragma("unroll") for (int d0 = 0; d0 < 4; ++d0) { const bf16x8 k0 = *(const LAS bf16x8*)(kp + (KOFF) + d0 * 2048), k1 = *(const LAS bf16x8*)(kp + (KOFF) + d0 * 2048 + 512); \
        N0 = __builtin_amdgcn_mfma_f32_32x32x16_bf16(k0, qr[d0], N0, 0, 0, 0); N1 = __builtin_amdgcn_mfma_f32_32x32x16_bf16(k1, qr[d0], N1, 0, 0, 0); } } while (0)
#define DSA_STEP(QKF, NEARF) do { const int cur = (kt & 1) * 8192; \
        if (kt + 2 < nt) glds16(ksrc + (size_t)(kt + 2) * 64 * 256, kdst + cur); \
        if (kt + 1 < nt) glds16(vsrc + (size_t)(kt + 1) * 64 * 256, vdst + (8192 - cur)); \
        const unsigned long long mw = ml[kt * 32 + r32]; \
        f32x16 N0 = {}, N1 = {}; \
        if (QKF) { const float ci = (kt + 1 < kt_near) ? cfar : 0.f; _Pragma("unroll") for (int r = 0; r < 16; ++r) { N0[r] = ci; N1[r] = ci; } DSA_QK(N0, N1, 8192 - cur); } \
        if (NEARF) { const int d00 = qpos - 64 * kt - 4 * hi; \
            _Pragma("unroll") for (int r = 0; r < 16; ++r) { const int d = d00 - ((r & 3) + 8 * (r >> 2)); S0[r] += tbh[min(max(d, 0), 127)]; S1[r] += tbh[min(max(d - 32, 0), 127)]; } } \
        { const unsigned m0 = (unsigned)mw >> (4 * hi), m1 = (unsigned)(mw >> 32) >> (4 * hi); \
          _Pragma("unroll") for (int r = 0; r < 16; ++r) { const int bit = (r & 3) + 8 * (r >> 2); unsigned k0, k1; \
              asm("v_bfe_i32 %0, %1, %2, 1" : "=v"(k0) : "v"(m0), "n"(bit)); asm("v_bfe_i32 %0, %1, %2, 1" : "=v"(k1) : "v"(m1), "n"(bit)); \
              const float e0 = __uint_as_float(__float_as_uint(__builtin_amdgcn_exp2f(S0[r])) & k0), e1 = __uint_as_float(__float_as_uint(__builtin_amdgcn_exp2f(S1[r])) & k1); \
              l += e0 + e1; S0[r] = e0; S1[r] = e1; } } \
        if (QKF) { _Pragma("unroll") for (int i = 0; i < 8; ++i) { __builtin_amdgcn_sched_group_barrier(0x100, 1, 0); __builtin_amdgcn_sched_group_barrier(0x008, 1, 0); __builtin_amdgcn_sched_group_barrier(0x402, 20, 0); } } \
        pv_mma(o0, o1, vb + cur, S0, S1); \
        WAIT_BAR(0); \
        S0 = N0; S1 = N1; } while (0)
    for (int ui = 0; ui < 4; ++ui) {
        const int qb = (ui == 0) ? s3 : (ui == 1) ? 15 - s3 : (ui == 2) ? 16 + s3 : 31 - s3, q0 = qb * 64 + qh * 32, qpos = q0 + r32, nt = qb + 1;
        int kt_near = (q0 - 175 + 63) >> 6; kt_near = kt_near < 0 ? 0 : kt_near;
        const bf16* Pq = F.Q1 + (rowbase + qpos) * 1024 + hd * 64 + hi * 8;
        bf16x8 qr[4];
#pragma unroll
        for (int d0 = 0; d0 < 4; ++d0) qr[d0] = *(const bf16x8*)(Pq + d0 * 16);
        glds16(ksrc, kdst); glds16(vsrc, vdst); if (nt > 1) glds16(ksrc + (size_t)64 * 256, kdst + 8192);
        { const v4u* mrow = (const v4u*)(F.MASK + (rowbase + qpos) * 32 + 16 * hi);
#pragma unroll
          for (int i = 0; i < 8; ++i) { const v4u w = mrow[i]; ml[(16 * hi + 2 * i) * 32 + r32] = ((unsigned long long)w.y << 32) | w.x; ml[(16 * hi + 2 * i + 1) * 32 + r32] = ((unsigned long long)w.w << 32) | w.z; } }
        f32x16 o0 = {}, o1 = {}, S0, S1; float l = 0.f;
        WAIT_BAR(0);
        { const float ci = (0 < kt_near) ? cfar : 0.f;
#pragma unroll
          for (int r = 0; r < 16; ++r) { S0[r] = ci; S1[r] = ci; }
          DSA_QK(S0, S1, 0); }
        WAIT_BAR(0);
        for (int kt = 0; kt < nt; ++kt) {
            const bool hasqk = kt + 1 < nt;
            if (kt >= kt_near) { if (hasqk) DSA_STEP(1, 1); else DSA_STEP(0, 1); }
            else DSA_STEP(1, 0);
        }
        { auto rr = __builtin_amdgcn_permlane32_swap(__float_as_uint(l), __float_as_uint(l), false, false); l = __uint_as_float(rr[0]) + __uint_as_float(rr[1]); }
        if (hi == 0) wsf[r32] = l;
        LDS_WAIT(); asm volatile("" ::: "memory");
        float rl[16];
#pragma unroll
        for (int r = 0; r < 16; ++r) rl[r] = __builtin_amdgcn_rcpf(wsf[(r & 3) + 8 * (r >> 2) + 4 * hi]);
        store_o(stg, o0, o1, rl, F.ATT + (rowbase + q0) * D + hd * 64, D, lane);
    }
#undef DSA_QK
#undef DSA_STEP
}
template <int PMODE> __device__ __forceinline__ void dsa_pp(Frame& F, bf16* OUT) {
    const int lane = F.lane, r32 = lane & 31, hi = lane >> 5, wave = F.wave;
    LAS unsigned char* L = F.lds + RING_OFF;
    LAS unsigned char* stg = L + 49152 + wave * 4096; LAS float* wsf = (LAS float*)(L + 81920 + wave * 256); LAS float* tb = (LAS float*)(L + 83968); LAS unsigned long long* ml = (LAS unsigned long long*)(L + 92160 + wave * 8192);
    const unsigned l0 = (unsigned)(uintptr_t)L;
    { float mq = fabsf(F.od_q_gain[lane]), mk = fabsf(F.od_k_gain[lane]), mb = 0.f;
#pragma unroll
      for (int i = 0; i < 8; ++i) mb = fmaxf(mb, fabsf(F.rel_bias[64 * i + lane]));
      mq = wave_max(mq); mk = wave_max(mk); mb = wave_max(mb);
      const float shift2 = (8.0f * mq * mk + mb) * 1.4426950408889634f;
      for (int i = F.tid; i < 2048; i += NWAVES * 64) tb[i] = F.rel_bias[rel_bucket(i & 127) * 16 + (i >> 7)] * 1.4426950408889634f - shift2; }
    __syncthreads();
    const int v = F.vcu, bg = v >> 3, b = bg >> 2, g = bg & 3, s3 = v & 7, hd = 4 * g + (wave & 3), role = wave >> 2, qh = role; const size_t rowbase = (size_t)b * S;
    const LAS float* tbh = tb + hd * 128; const float cfar = tbh[127];
    const bf16* ksrc = F.K1 + (rowbase + lane) * 256 + g * 64 + wave * 8;
    const bf16* vsrc = F.V1 + (rowbase + 16 * (wave & 3) + (lane >> 2)) * 256 + g * 64 + (wave >> 2) * 32 + (lane & 3) * 8;
    const unsigned kdst = (unsigned)__builtin_amdgcn_readfirstlane(l0 + wave * 1024), vdst = kdst + 24576;
    const LAS unsigned char* kp = L + hi * 1024 + r32 * 16;
    const LAS unsigned char* vb = L + 24576 + ((lane >> 4) & 1) * 32 + (lane & 3) * 8 + (4 * hi + ((lane & 15) >> 2)) * 64;
    for (int ui = 0; ui < 4; ++ui) {
        const int qb = (ui == 0) ? s3 : (ui == 1) ? 15 - s3 : (ui == 2) ? 16 + s3 : 31 - s3, q0 = qb * 64 + qh * 32, qpos = q0 + r32, nt = qb + 1;
        int kt_near = (q0 - 175 + 63) >> 6; kt_near = kt_near < 0 ? 0 : kt_near;
        const bf16* Pq = F.Q1 + (rowbase + qpos) * 1024 + hd * 64 + hi * 8;
        bf16x8 qr[4];
#pragma unroll
        for (int d0 = 0; d0 < 4; ++d0) qr[d0] = *(const bf16x8*)(Pq + d0 * 16);
        glds16(ksrc, kdst); glds16(vsrc, vdst); if (nt > 1) glds16(ksrc + (size_t)64 * 256, kdst + 8192);
        { const v4u* mrow = (const v4u*)(F.MASK + (rowbase + qpos) * 32 + 16 * hi);
#pragma unroll
          for (int i = 0; i < 8; ++i) { const v4u w = mrow[i]; ml[(16 * hi + 2 * i) * 32 + r32] = ((unsigned long long)w.y << 32) | w.x; ml[(16 * hi + 2 * i + 1) * 32 + r32] = ((unsigned long long)w.w << 32) | w.z; } }
        f32x16 o0 = {}, o1 = {}, S0 = {}, S1 = {}; float l = 0.f; bf16x8 Pp[4] = {};
        WAIT_BAR(0);
        int nfly = 0;
        for (int h = 0; h <= 2 * nt + 1; ++h) {
            if (!(h & 1)) { const int t = h >> 1;
                nfly = 0;
                if (t + 2 < nt && PMODE != 4) { glds16(ksrc + (size_t)(t + 2) * 64 * 256, kdst + ((t + 2) % 3) * 8192); ++nfly; }
                if (t + 1 < nt && PMODE != 4) { glds16(vsrc + (size_t)(t + 1) * 64 * 256, vdst + ((t + 1) % 3) * 8192); ++nfly; } }
            const int j = h - role;
            if (j >= 0 && j <= 2 * nt) {
                const int t = j >> 1;
                if (!(j & 1)) {
                    if (t >= 1 && PMODE != 3) { const LAS unsigned char* vq = vb + ((t - 1) % 3) * 8192;
#pragma unroll
                        for (int ks = 0; ks < 4; ++ks) { const s16x4 a0 = vtr(vq + ks * 1024), b0 = vtr(vq + ks * 1024 + 512), a1 = vtr(vq + 4096 + ks * 1024), b1 = vtr(vq + 4096 + ks * 1024 + 512);
                            o0 = __builtin_amdgcn_mfma_f32_32x32x16_bf16(Pp[ks], (bf16x8){a0[0], a0[1], a0[2], a0[3], b0[0], b0[1], b0[2], b0[3]}, o0, 0, 0, 0);
                            o1 = __builtin_amdgcn_mfma_f32_32x32x16_bf16(Pp[ks], (bf16x8){a1[0], a1[1], a1[2], a1[3], b1[0], b1[1], b1[2], b1[3]}, o1, 0, 0, 0); } }
                    if (t < nt && PMODE != 3) { const float ci = (t < kt_near) ? cfar : 0.f; const LAS unsigned char* kq = kp + (t % 3) * 8192;
#pragma unroll
                        for (int r = 0; r < 16; ++r) { S0[r] = ci; S1[r] = ci; }
#pragma unroll
                        for (int d0 = 0; d0 < 4; ++d0) { const bf16x8 k0 = *(const LAS bf16x8*)(kq + d0 * 2048), k1 = *(const LAS bf16x8*)(kq + d0 * 2048 + 512);
                            S0 = __builtin_amdgcn_mfma_f32_32x32x16_bf16(k0, qr[d0], S0, 0, 0, 0); S1 = __builtin_amdgcn_mfma_f32_32x32x16_bf16(k1, qr[d0], S1, 0, 0, 0); } }
                } else if (PMODE != 2) {
                    const unsigned long long mw = ml[t * 32 + r32];
                    if (t >= kt_near) { const int d00 = qpos - 64 * t - 4 * hi;
#pragma unroll
                        for (int r = 0; r < 16; ++r) { const int d = d00 - ((r & 3) + 8 * (r >> 2)); S0[r] += tbh[min(max(d, 0), 127)]; S1[r] += tbh[min(max(d - 32, 0), 127)]; } }
                    const unsigned m0 = (unsigned)mw >> (4 * hi), m1 = (unsigned)(mw >> 32) >> (4 * hi);
#pragma unroll
                    for (int r = 0; r < 16; ++r) { const int bit = (r & 3) + 8 * (r >> 2); unsigned k0, k1;
                        asm("v_bfe_i32 %0, %1, %2, 1" : "=v"(k0) : "v"(m0), "n"(bit)); asm("v_bfe_i32 %0, %1, %2, 1" : "=v"(k1) : "v"(m1), "n"(bit));
                        const float e0 = __uint_as_float(__float_as_uint(__builtin_amdgcn_exp2f(S0[r])) & k0), e1 = __uint_as_float(__float_as_uint(__builtin_amdgcn_exp2f(S1[r])) & k1);
                        l += e0 + e1; S0[r] = e0; S1[r] = e1; }
#pragma unroll
                    for (int ks = 0; ks < 4; ++ks) { const f32x16& P = (ks < 2) ? S0 : S1; const int bb = (ks & 1) * 8; v4u w; w.x = cvtpk(P[bb], P[bb + 1]); w.y = cvtpk(P[bb + 2], P[bb + 3]);
                        w.z = cvtpk(P[bb + 4], P[bb + 5]); w.w = cvtpk(P[bb + 6], P[bb + 7]); Pp[ks] = __builtin_bit_cast(bf16x8, w); }
                }
            }
            if (nfly == 2) WAIT_BAR(2); else if (nfly == 1) WAIT_BAR(1); else WAIT_BAR(0);
        }
        { auto rr = __builtin_amdgcn_permlane32_swap(__float_as_uint(l), __float_as_uint(l), false, false); l = __uint_as_float(rr[0]) + __uint_as_float(rr[1]); }
        if (hi == 0) wsf[r32] = l;
        LDS_WAIT(); asm volatile("" ::: "memory");
        float rl[16];
#pragma unroll
        for (int r = 0; r < 16; ++r) rl[r] = __builtin_amdgcn_rcpf(wsf[(r & 3) + 8 * (r >> 2) + 4 * hi]);
        store_o(stg, o0, o1, rl, OUT + (rowbase + q0) * D + hd * 64, D, lane);
    }
}
template <int PMODE> __device__ __forceinline__ void dsa_hand(Frame& F, bf16* OUT) {
    const int lane = F.lane, r32 = lane & 31, hi = lane >> 5, wave = F.wave;
    LAS unsigned char* L = F.lds + RING_OFF;
    LAS unsigned char* stg = L + 32768 + wave * 4096; LAS float* wsf = (LAS float*)(L + 65536 + wave * 256); LAS float* tb = (LAS float*)(L + 69632); LAS unsigned long long* ml = (LAS unsigned long long*)(L + 77824 + wave * 8192);
    const unsigned l0 = (unsigned)(uintptr_t)L;
    for (int i = F.tid; i < 2048; i += NWAVES * 64) tb[i] = (F.rel_bias[rel_bucket(i & 127) * 16 + (i >> 7)] - F.rel_bias[31 * 16 + (i >> 7)]) * 1.4426950408889634f;
    __syncthreads();
    const int v = F.vcu, bg = v >> 3, b = bg >> 2, g = bg & 3, s3 = v & 7, hd = 4 * g + (wave & 3), qh = wave >> 2; const size_t rowbase = (size_t)b * S;
    const LAS float* tbh = tb + hd * 128;
    const bf16* ksrc = F.K1 + (rowbase + lane) * 256 + g * 64 + wave * 8;
    const bf16* vsrc = F.V1 + (rowbase + 16 * (wave & 3) + (lane >> 2)) * 256 + g * 64 + (wave >> 2) * 32 + (lane & 3) * 8;
    const unsigned kdst = (unsigned)__builtin_amdgcn_readfirstlane(l0 + wave * 1024), vdst = kdst + 16384;
    const LAS unsigned char* kp = L + hi * 1024 + r32 * 16;
    const LAS unsigned char* vb = L + 16384 + ((lane >> 4) & 1) * 32 + (lane & 3) * 8 + (4 * hi + ((lane & 15) >> 2)) * 64;
#define SBAR0() __builtin_amdgcn_sched_barrier(0)
#define DH_SM4(E) do {   \
        if (PMODE != 2) { unsigned ka, kb2, kc, kd; asm("v_bfe_i32 %0, %1, %2, 1" : "=v"(ka) : "v"(m0), "n"(((2 * (E)) & 3) + 8 * ((2 * (E)) >> 2))); asm("v_bfe_i32 %0, %1, %2, 1" : "=v"(kb2) : "v"(m0), "n"(((2 * (E) + 1) & 3) + 8 * ((2 * (E) + 1) >> 2))); \
          asm("v_bfe_i32 %0, %1, %2, 1" : "=v"(kc) : "v"(m1), "n"(((2 * (E)) & 3) + 8 * ((2 * (E)) >> 2))); asm("v_bfe_i32 %0, %1, %2, 1" : "=v"(kd) : "v"(m1), "n"(((2 * (E) + 1) & 3) + 8 * ((2 * (E) + 1) >> 2))); \
          const float ea = __uint_as_float(__float_as_uint(__builtin_amdgcn_exp2f(S0[2 * (E)])) & ka), eb = __uint_as_float(__float_as_uint(__builtin_amdgcn_exp2f(S0[2 * (E) + 1])) & kb2); \
          const float ec = __uint_as_float(__float_as_uint(__builtin_amdgcn_exp2f(S1[2 * (E)])) & kc), ed = __uint_as_float(__float_as_uint(__builtin_amdgcn_exp2f(S1[2 * (E) + 1])) & kd); \
          S0[2 * (E)] = ea; S0[2 * (E) + 1] = eb; S1[2 * (E)] = ec; S1[2 * (E) + 1] = ed; la += ea; lb += eb; la += ec; lb += ed; } \
        asm volatile("" : "+v"(S0), "+v"(S1), "+v"(la), "+v"(lb)); } while (0)
    for (int ui = 0; ui < 4; ++ui) {
        const int qb = (ui == 0) ? s3 : (ui == 1) ? 15 - s3 : (ui == 2) ? 16 + s3 : 31 - s3, q0 = qb * 64 + qh * 32, qpos = q0 + r32, nt = qb + 1;
        int kt_near = (q0 - 175 + 63) >> 6; kt_near = kt_near < 0 ? 0 : kt_near;
        const bf16* Pq = F.Q1 + (rowbase + qpos) * 1024 + hd * 64 + hi * 8;
        bf16x8 qr[4];
#pragma unroll
        for (int d0 = 0; d0 < 4; ++d0) qr[d0] = *(const bf16x8*)(Pq + d0 * 16);
        glds16(ksrc, kdst); glds16(vsrc, vdst); if (nt > 1) glds16(ksrc + (size_t)64 * 256, kdst + 8192);
        { const v4u* mrow = (const v4u*)(F.MASK + (rowbase + qpos) * 32 + 16 * hi);
#pragma unroll
          for (int i = 0; i < 8; ++i) { const v4u w = mrow[i]; ml[(16 * hi + 2 * i) * 32 + r32] = ((unsigned long long)w.y << 32) | w.x; ml[(16 * hi + 2 * i + 1) * 32 + r32] = ((unsigned long long)w.w << 32) | w.z; } }
        f32x16 o0 = {}, o1 = {}, S0 = {}, S1 = {}; float la = 0.f, lb = 0.f;
        WAIT_BAR(0);
#pragma unroll
        for (int d0 = 0; d0 < 4; ++d0) { const bf16x8 k0 = *(const LAS bf16x8*)(kp + d0 * 2048), k1 = *(const LAS bf16x8*)(kp + d0 * 2048 + 512);
            S0 = __builtin_amdgcn_mfma_f32_32x32x16_bf16(k0, qr[d0], S0, 0, 0, 0); S1 = __builtin_amdgcn_mfma_f32_32x32x16_bf16(k1, qr[d0], S1, 0, 0, 0); }
        WAIT_BAR(0);
        for (int kt = 0; kt < nt; ++kt) {
            const int cur = (kt & 1) * 8192;
            if (kt + 2 < nt) glds16(ksrc + (size_t)(kt + 2) * 64 * 256, kdst + cur);
            if (kt + 1 < nt) glds16(vsrc + (size_t)(kt + 1) * 64 * 256, vdst + (8192 - cur));
            const unsigned long long mw = ml[kt * 32 + r32];
            if (kt >= kt_near && PMODE != 4) { const int d00 = qpos - 64 * kt - 4 * hi;
#pragma unroll
                for (int r = 0; r < 16; ++r) { const int d = d00 - ((r & 3) + 8 * (r >> 2)); S0[r] += tbh[min(max(d, 0), 127)]; S1[r] += tbh[min(max(d - 32, 0), 127)]; } }
            const unsigned m0 = (unsigned)mw >> (4 * hi), m1 = (unsigned)(mw >> 32) >> (4 * hi);
            f32x16 N0 = {}, N1 = {};
            if (kt + 1 < nt && PMODE != 5) {
                const LAS unsigned char* kq = kp + (8192 - cur);
                bf16x8 kf[8];
#pragma unroll
                for (int i = 0; i < 8; ++i) kf[i] = *(const LAS bf16x8*)(kq + (i >> 1) * 2048 + (i & 1) * 512);
                SBAR0();
                N0 = __builtin_amdgcn_mfma_f32_32x32x16_bf16(kf[0], qr[0], N0, 0, 0, 0); DH_SM4(0); SBAR0();
                N1 = __builtin_amdgcn_mfma_f32_32x32x16_bf16(kf[1], qr[0], N1, 0, 0, 0); DH_SM4(1); SBAR0();
                N0 = __builtin_amdgcn_mfma_f32_32x32x16_bf16(kf[2], qr[1], N0, 0, 0, 0); DH_SM4(2); SBAR0();
                N1 = __builtin_amdgcn_mfma_f32_32x32x16_bf16(kf[3], qr[1], N1, 0, 0, 0); DH_SM4(3); SBAR0();
                N0 = __builtin_amdgcn_mfma_f32_32x32x16_bf16(kf[4], qr[2], N0, 0, 0, 0); DH_SM4(4); SBAR0();
                N1 = __builtin_amdgcn_mfma_f32_32x32x16_bf16(kf[5], qr[2], N1, 0, 0, 0); DH_SM4(5); SBAR0();
                N0 = __builtin_amdgcn_mfma_f32_32x32x16_bf16(kf[6], qr[3], N0, 0, 0, 0); DH_SM4(6); SBAR0();
                N1 = __builtin_amdgcn_mfma_f32_32x32x16_bf16(kf[7], qr[3], N1, 0, 0, 0); DH_SM4(7); SBAR0();
            } else { DH_SM4(0); DH_SM4(1); DH_SM4(2); DH_SM4(3); DH_SM4(4); DH_SM4(5); DH_SM4(6); DH_SM4(7); }
            if (PMODE != 3) pv_mma(o0, o1, vb + cur, S0, S1);
            WAIT_BAR(0);
            S0 = N0; S1 = N1;
        }
        float l = la + lb;
        { auto rr = __builtin_amdgcn_permlane32_swap(__float_as_uint(l), __float_as_uint(l), false, false); l = __uint_as_float(rr[0]) + __uint_as_float(rr[1]); }
        if (hi == 0) wsf[r32] = l;
        LDS_WAIT(); asm volatile("" ::: "memory");
        float rl[16];
#pragma unroll
        for (int r = 0; r < 16; ++r) rl[r] = __builtin_amdgcn_rcpf(wsf[(r & 3) + 8 * (r >> 2) + 4 * hi]);
        store_o(stg, o0, o1, rl, OUT + (rowbase + q0) * D + hd * 64, D, lane);
    }
#undef DH_SM4
#undef SBAR0
}
__device__ __forceinline__ void p6_mini(Frame& F) {
    const int lane = F.lane, c16 = lane & 15, kq = lane >> 4, mt = F.wave & 3, ns = F.wave >> 2;
    for (int blk = (int)blockIdx.x; blk < M / 64; blk += F.G) {
        const int r0 = blk * 64 + mt * 16;
        const bf16* ap = F.XB + (size_t)(r0 + c16) * D + 8 * kq;
        const int nb0 = ns ? 2176 : 2048, nb1 = ns ? 2192 : 2064, nb2 = 2080;
        const bf16* b0 = F.W_in1 + (size_t)(nb0 + c16) * D + 8 * kq; const bf16* b1 = F.W_in1 + (size_t)(nb1 + c16) * D + 8 * kq; const bf16* b2 = F.W_in1 + (size_t)(nb2 + c16) * D + 8 * kq;
        f32x4 a0 = {0.f, 0.f, 0.f, 0.f}, a1 = a0, a2 = a0;
#pragma unroll 4
        for (int ks = 0; ks < 32; ++ks) { const bf16x8 av = *(const bf16x8*)(ap + 32 * ks), v0 = *(const bf16x8*)(b0 + 32 * ks), v1 = *(const bf16x8*)(b1 + 32 * ks);
            a0 = __builtin_amdgcn_mfma_f32_16x16x32_bf16(av, v0, a0, 0, 0, 0); a1 = __builtin_amdgcn_mfma_f32_16x16x32_bf16(av, v1, a1, 0, 0, 0);
            if (!ns) { const bf16x8 v2 = *(const bf16x8*)(b2 + 32 * ks); a2 = __builtin_amdgcn_mfma_f32_16x16x32_bf16(av, v2, a2, 0, 0, 0); } }
#pragma unroll
        for (int i = 0; i < 4; ++i) { const int row = r0 + 4 * kq + i; const float sc = pg8::row_rstd(F.SS + 2 * M, row);
            F.KI[(size_t)row * 64 + (ns ? 32 : 0) + c16] = (bf16)f2bf(a0[i] * sc); F.KI[(size_t)row * 64 + (ns ? 48 : 16) + c16] = (bf16)f2bf(a1[i] * sc);
            if (!ns && c16 < 8) F.WI[(size_t)row * 8 + c16] = a2[i] * sc; }
    }
}
struct Args { const float* in[14]; float* out; unsigned char* ws; int ph_lo, ph_hi, li, pad; };
__global__ void __launch_bounds__(NWAVES * 64, 2) hybrid_fwd(Args args) {
    extern __shared__ __attribute__((aligned(16))) unsigned char lds[];
    Frame F;
    F.lds = (LAS unsigned char*)lds;
    F.MISC = (volatile LAS unsigned*)(F.lds + MISC_OFF);
    F.tid = threadIdx.x; F.lane = F.tid & 63; F.wave = __builtin_amdgcn_readfirstlane(F.tid >> 6);
    F.G = gridDim.x; { const int bx = blockIdx.x; F.vcu = (F.G % 8 == 0) ? (bx % 8) * (F.G / 8) + bx / 8 : bx; }
    unsigned char* ws = args.ws;
    F.ctl = (gu32*)(ws + WS_CTL);
    F.x = args.in[0]; F.norm_mix = args.in[1]; F.norm_ffn = args.in[2]; F.ev_w_in = args.in[3]; F.ev_conv_w = args.in[4]; F.ev_w_out = args.in[5]; F.od_w_in = args.in[6];
    F.od_q_gain = args.in[7]; F.od_k_gain = args.in[8]; F.od_w_out = args.in[9]; F.rel_bias = args.in[10]; F.w_gate = args.in[11]; F.w_up = args.in[12]; F.w_down = args.in[13];
    F.out = args.out; F.SS = (float*)(ws + WS_CTL) + CW_SS;
    F.W_in0 = (bf16*)(ws + WS_W_IN0); F.W_out0 = (bf16*)(ws + WS_W_OUT0); F.W_gu0 = (bf16*)(ws + WS_W_GU0); F.W_dn0 = (bf16*)(ws + WS_W_DN0);
    F.W_in1 = (bf16*)(ws + WS_W_IN1); F.W_out1 = (bf16*)(ws + WS_W_OUT1); F.W_gu1 = (bf16*)(ws + WS_W_GU1); F.W_dn1 = (bf16*)(ws + WS_W_DN1);
    F.XB = (bf16*)(ws + WS_XB); F.ATT = (bf16*)(ws + WS_ATT); F.PROJ0 = (bf16*)(ws + WS_PROJ0); F.H = (bf16*)(ws + WS_H);
    F.Q1 = (bf16*)(ws + WS_Q1); F.K1 = (bf16*)(ws + WS_K1); F.V1 = (bf16*)(ws + WS_V1); F.QI = (bf16*)(ws + WS_QI); F.KI = (bf16*)(ws + WS_KI); F.WI = (float*)(ws + WS_WI); F.MASK = (unsigned long long*)(ws + WS_MASK);
    if (F.tid < 64) ((LAS unsigned*)(F.lds + MISC_OFF))[F.tid] = 0u;
    __syncthreads();
    const int lo = args.ph_lo, hi = args.ph_hi;
    const bool use_bar = (hi - lo) > 1;
    XcdBarrier bar; bar.bar = (unsigned*)(F.ctl + CW_BAR) + args.li * XCD_BAR_WORDS; bar.x = 0; bar.st = nullptr;
    if (use_bar) bar = xcd_barrier_post((unsigned*)(F.ctl + CW_BAR) + args.li * XCD_BAR_WORDS, F.MISC + 8);
#define IN(k) (lo <= (k) && (k) < hi)
#define SEAM(k) do { if (IN(k) && IN((k) + 1)) xcd_barrier(bar, F.G != 256); } while (0)
#define GEMM_PHASE(EPI, A_, B_, N_, K_, E_) do { pg8::Gemm g{A_, B_, M, N_, K_}; pg8::StaticOrder So; So.init(M, N_, F.G, (int)blockIdx.x); \
        pg8::gemm_phase<EPI, pg8::StaticOrder, PG8_ALIGN, PG8_SP2>(F.lds + RING_OFF, g, So, E_); } while (0)
#define GEMM_PHASE_T(EPI, A_, B_, N_, K_, E_) do { pg8::Gemm g{A_, B_, M, N_, K_}; pg8::TailOrder So; So.init(M, N_, F.G, (int)blockIdx.x); \
        pg8::gemm_phase<EPI, pg8::TailOrder, PG8_ALIGN, PG8_SP2>(F.lds + RING_OFF, g, So, E_); } while (0)

    if (IN(0)) { for (int rep = 0; rep < (PROBE_REP == 0 ? 2 : 1); ++rep) p0_prologue(F); } SEAM(0);
    if (IN(1)) { pg8::EpiIn0 E{F.PROJ0, F.SS, C2}; GEMM_PHASE(pg8::EpiIn0, F.XB, F.W_in0, EVEN_IN, D, E); if (PROBE_REP == 1) { GEMM_PHASE(pg8::EpiIn0, F.XB, F.W_in0, EVEN_IN, D, E); } } SEAM(1);
    if (IN(2)) { for (int rep = 0; rep < (PROBE_REP == 2 ? 2 : 1); ++rep) { conv_part(F); if (SB_FAST == 2) sb_fast32(F); else if (SB_FAST) sb_fast(F); else sb_naive(F); __syncthreads(); p2_weights(F); } } SEAM(2);
    if (IN(3)) { pg8::EpiRes E{F.XB, nullptr, F.SS + M}; GEMM_PHASE(pg8::EpiRes, F.ATT, F.W_out0, D, D, E); } SEAM(3);
    if (IN(4)) { pg8::EpiGU E{F.H, F.SS + M}; GEMM_PHASE(pg8::EpiGU, F.XB, F.W_gu0, GU, D, E); late_weights(F, N_EARLY, N_MID); } SEAM(4);
    if (IN(5)) { pg8::EpiRes E{F.XB, nullptr, F.SS + 2 * M}; GEMM_PHASE(pg8::EpiRes, F.H, F.W_dn0, D, FF, E); } SEAM(5);
    if (IN(6)) { LAS float* gl = (LAS float*)(F.lds + 131072 + 1024); if (F.tid < 64) { gl[F.tid] = F.od_q_gain[F.tid]; gl[64 + F.tid] = F.od_k_gain[F.tid]; } __syncthreads();
        pg8::EpiIn1 E{F.Q1, F.K1, F.V1, F.QI, F.KI, F.WI, F.SS + 2 * M, gl, gl + 64, C2}; GEMM_PHASE_T(pg8::EpiIn1, F.XB, F.W_in1, (P6_MINI ? 2048 : ODD_PAD), D, E); if (P6_MINI) p6_mini(F); late_weights(F, N_MID, NITEMS); } SEAM(6);
    if (IN(7)) { for (int rep = 0; rep < (PROBE_REP == 7 ? 2 : 1); ++rep) { if (IDX_FAST && F.G == 256) { idx_fast<0>(F, F.MASK); if (PROBE_IDX) { __syncthreads(); idx_fast<PROBE_IDX>(F, (unsigned long long*)F.XB); } } else idx_naive(F); } } SEAM(7);
    if (IN(8)) { for (int rep = 0; rep < (PROBE_REP == 8 ? 2 : 1); ++rep) { if (F.G != 256) dsa_naive(F); else if (DSA_FAST == 5) { dsa_hand<0>(F, F.ATT); if (PROBE_DSA) { __syncthreads(); dsa_hand<PROBE_DSA>(F, F.XB); } } else if (DSA_FAST == 4) { dsa_pp<0>(F, F.ATT); if (PROBE_DSA) { __syncthreads(); dsa_pp<PROBE_DSA>(F, F.XB); } } else if (DSA_FAST == 3) dsa_pipe(F); else if (DSA_FAST == 2) { if (MASK_T) { if (DSA_WIDE) dsa_coop_w(F); else dsa_coop_t(F); } else dsa_coop(F); } else if (DSA_FAST) dsa_fast(F); else dsa_naive(F); __syncthreads(); } } SEAM(8);
    if (IN(9)) { pg8::EpiRes E{F.XB, nullptr, F.SS + 3 * M}; GEMM_PHASE(pg8::EpiRes, F.ATT, F.W_out1, D, D, E); } SEAM(9);
    if (IN(10)) { pg8::EpiGU E{F.H, F.SS + 3 * M}; GEMM_PHASE_T(pg8::EpiGU, F.XB, F.W_gu1, GU, D, E); } SEAM(10);
    if (IN(11)) { pg8::EpiRes E{F.XB, F.out, nullptr}; GEMM_PHASE(pg8::EpiRes, F.H, F.W_dn1, D, FF, E); }
#undef IN
#undef SEAM
#undef GEMM_PHASE
#undef GEMM_PHASE_T
}

extern "C" void kernel_launch(void* const* d_in, const int* in_sizes, int n_in, void* d_out, int out_size, void* d_ws, size_t ws_size, hipStream_t stream) {
    static int grid = 0;
    if (grid == 0) {
        if (n_in != 14 || in_sizes[0] != M * D || out_size != M * D || ws_size < WS_END) { fprintf(stderr, "kernel_launch: unexpected shapes (n_in %d, in0 %d, out %d, ws %zu); nothing launched\n", n_in, n_in > 0 ? in_sizes[0] : -1, out_size, ws_size); grid = -1; return; }
        int dev = 0, cus = 0, per_cu = 0;
        if (hipGetDevice(&dev) != hipSuccess || hipDeviceGetAttribute(&cus, hipDeviceAttributeMultiprocessorCount, dev) != hipSuccess) { grid = -1; return; }
        if (hipFuncSetAttribute((const void*)hybrid_fwd, hipFuncAttributeMaxDynamicSharedMemorySize, LDS_BYTES) != hipSuccess) { fprintf(stderr, "kernel_launch: hipFuncSetAttribute failed\n"); grid = -1; return; }
        if (hipOccupancyMaxActiveBlocksPerMultiprocessor(&per_cu, (const void*)hybrid_fwd, NWAVES * 64, LDS_BYTES) != hipSuccess || per_cu < 1) fprintf(stderr, "kernel_launch: note: occupancy query reports %d workgroups per CU\n", per_cu);
        (void)hipGetLastError();
        grid = cus;
    }
    if (grid < 0) return;
    if (hipMemsetAsync((char*)d_ws + WS_CTL, 0, CTL_ZERO_BYTES, stream) != hipSuccess) return;
    Args a{};
    for (int i = 0; i < 14; ++i) a.in[i] = (const float*)d_in[i];
    a.out = (float*)d_out; a.ws = (unsigned char*)d_ws;
#if MK_ONE_LAUNCH
    a.ph_lo = 0; a.ph_hi = NPH; a.li = 0;
    hipLaunchKernelGGL(hybrid_fwd, dim3(grid), dim3(NWAVES * 64), LDS_BYTES, stream, a);
#else
    for (int p = 0; p < NPH; ++p) { a.ph_lo = p; a.ph_hi = p + 1; a.li = p; hipLaunchKernelGGL(hybrid_fwd, dim3(grid), dim3(NWAVES * 64), LDS_BYTES, stream, a); }
#endif
}
```
